# Optimizing an MI355X kernel written in HIP

```python
import math
import jax
import jax.numpy as jnp
from jax import lax
import numpy as np

D_MODEL = 2048
BATCH = 1
SEQ = 8192
DEPTH = 4

GLA_HEADS = 8
GLA_DK = 64
GLA_DV = 128
GLA_GATE_RANK = 16
GLA_GATE_NORM = 16.0
MOBA_HEADS = 8
MOBA_HEAD_DIM = 128
MOBA_BLOCK = 256
MOBA_TOPK = 3
MOBA_Q_CHUNK = 64
GDN_HEADS = 8
GDN_HEAD_DIM = 128
GDN_CONV = 4
S5_CHANNELS = 1024
S5_GROUP_CH = 16
S5_GROUPS = S5_CHANNELS // S5_GROUP_CH
S5_STATE = 64
LIN_CHUNK = 64
D_FF = 5632
FFN_CONV = 3
DEEPNORM_ALPHA = (2 * DEPTH) ** 0.25
DEEPNORM_BETA = (8 * DEPTH) ** -0.25
N_EVEN = (DEPTH + 1) // 2
N_ODD = DEPTH // 2
EVEN_SIZES = (GLA_HEADS * GLA_DK, GLA_HEADS * GLA_DK, GLA_HEADS * GLA_DV, GLA_GATE_RANK, GLA_HEADS * GLA_DV,
              MOBA_HEADS * MOBA_HEAD_DIM, MOBA_HEADS * MOBA_HEAD_DIM, MOBA_HEADS * MOBA_HEAD_DIM)
ODD_SIZES = (3 * GDN_HEADS * GDN_HEAD_DIM, GDN_HEADS * GDN_HEAD_DIM, GDN_HEADS, GDN_HEADS, S5_CHANNELS)
EVEN_IN = sum(EVEN_SIZES)
ODD_IN = sum(ODD_SIZES)
EVEN_OUT = GLA_HEADS * GLA_DV + MOBA_HEADS * MOBA_HEAD_DIM
ODD_OUT = GDN_HEADS * GDN_HEAD_DIM + S5_CHANNELS
LN_EPS = 1e-5
RMS_EPS = 1e-6

kernel_name = "hybrid_gla_moba_gdn_s5_deepnorm"


def split_cols(h, sizes):
    return jnp.split(h, np.cumsum(sizes)[:-1].tolist(), axis=-1)


def layer_norm(x, g, b):
    xf = x.astype(jnp.float32)
    mu = jnp.mean(xf, -1, keepdims=True)
    var = jnp.mean(jnp.square(xf - mu), -1, keepdims=True)
    return ((xf - mu) * lax.rsqrt(var + LN_EPS) * g.astype(jnp.float32) + b.astype(jnp.float32)).astype(x.dtype)


def rms_norm(x, g):
    return x * lax.rsqrt(jnp.mean(jnp.square(x), -1, keepdims=True) + RMS_EPS) * g.astype(jnp.float32)


def l2_normalize(x):
    return x * lax.rsqrt(jnp.sum(jnp.square(x), -1, keepdims=True) + RMS_EPS)


def causal_depthwise_conv(x, w):
    width, seq = w.shape[0], x.shape[1]
    xp = jnp.pad(x, ((0, 0), (width - 1, 0), (0, 0)))
    return sum(xp[:, j:j + seq] * w[j] for j in range(width))


def to_chunks(t, chunk):
    b, s, h = t.shape[:3]
    t = jnp.moveaxis(t, 2, 1)
    return t.reshape((b, h, s // chunk, chunk) + t.shape[3:])


def alibi_slopes(n_heads):
    return jnp.exp2(-8.0 * jnp.arange(1, n_heads + 1, dtype=jnp.float32) / n_heads)


def gla_chunked(q, k, v, log_a):
    bsz, seq, n_heads, dk = q.shape
    dv = v.shape[-1]
    q, k, v, log_a = (to_chunks(t, LIN_CHUNK) for t in (q, k, v, log_a))
    cum = jnp.cumsum(log_a, axis=3)
    q_e = q * jnp.exp(cum)
    k_e = k * jnp.exp(-cum)
    causal = jnp.tril(jnp.ones((LIN_CHUNK, LIN_CHUNK), bool))
    attn = jnp.where(causal, jnp.einsum('bhncd,bhnsd->bhncs', q_e, k_e), 0.0)
    cum_last = cum[:, :, :, -1]
    kv = jnp.einsum('bhncd,bhncv->bhndv', k * jnp.exp(cum_last[:, :, :, None] - cum), v)

    def step(state, inp):
        decay, kv_n = inp
        return state * decay[..., None] + kv_n, state

    _, s_prev = lax.scan(step, jnp.zeros((bsz, n_heads, dk, dv), jnp.float32),
                         (jnp.moveaxis(jnp.exp(cum_last), 2, 0), jnp.moveaxis(kv, 2, 0)))
    o = jnp.einsum('bhncs,bhnsv->bhncv', attn, v) + jnp.einsum('bhncd,nbhdv->bhncv', q_e, s_prev)
    return o.transpose(0, 2, 3, 1, 4).reshape(bsz, seq, n_heads, dv)


def gated_delta_chunked(q, k, v, g, beta):
    bsz, seq, n_heads, dk = q.shape
    dv = v.shape[-1]
    q, k, v, g, beta = (to_chunks(t, LIN_CHUNK) for t in (q * dk ** -0.5, k, v, g, beta))
    gc = jnp.cumsum(g, axis=-1)
    causal = jnp.tril(jnp.ones((LIN_CHUNK, LIN_CHUNK), bool))
    strict = jnp.tril(jnp.ones((LIN_CHUNK, LIN_CHUNK), bool), -1)
    diff = gc[..., :, None] - gc[..., None, :]
    decay = jnp.where(causal, jnp.exp(jnp.where(causal, diff, 0.0)), 0.0)
    k_beta = k * beta[..., None]
    lower = jnp.where(strict, jnp.einsum('bhncd,bhnsd->bhncs', k_beta, k) * decay, 0.0)
    rhs = jnp.concatenate([v * beta[..., None], k_beta * jnp.exp(gc)[..., None]], axis=-1)
    sol = lax.linalg.triangular_solve(lower + jnp.eye(LIN_CHUNK, dtype=jnp.float32), rhs,
                                      left_side=True, lower=True, unit_diagonal=True)
    u, w = sol[..., :dv], sol[..., dv:]
    attn = jnp.einsum('bhncd,bhnsd->bhncs', q, k) * decay
    q_dec = q * jnp.exp(gc)[..., None]
    g_last = gc[..., -1]
    k_dec = k * jnp.exp(g_last[..., None] - gc)[..., None]

    def step(state, inp):
        q_n, k_n, u_n, w_n, a_n, gl = inp
        v_new = u_n - jnp.einsum('bhcd,bhdv->bhcv', w_n, state)
        o = jnp.einsum('bhcd,bhdv->bhcv', q_n, state) + jnp.einsum('bhcs,bhsv->bhcv', a_n, v_new)
        state = state * jnp.exp(gl)[..., None, None] + jnp.einsum('bhcd,bhcv->bhdv', k_n, v_new)
        return state, o

    xs = tuple(jnp.moveaxis(t, 2, 0) for t in (q_dec, k_dec, u, w, attn, g_last))
    _, o = lax.scan(step, jnp.zeros((bsz, n_heads, dk, dv), jnp.float32), xs)
    return o.transpose(1, 0, 3, 2, 4).reshape(bsz, seq, n_heads, dv)


def moba_attention(q, k, v):
    bsz, seq, n_heads, hd = q.shape
    blk_len, q_len = MOBA_BLOCK, MOBA_Q_CHUNK
    n_blk = -(-seq // blk_len)
    s_pad = n_blk * blk_len
    pad = ((0, 0), (0, s_pad - seq), (0, 0), (0, 0))
    q, k, v = (jnp.pad(t, pad).transpose(0, 2, 1, 3) for t in (q, k, v))
    scale = hd ** -0.5
    slopes = alibi_slopes(n_heads)
    k_blocks = k.reshape(bsz, n_heads, n_blk, blk_len, hd)
    v_blocks = v.reshape(bsz, n_heads, n_blk, blk_len, hd)
    k_mean = jnp.mean(k_blocks.astype(jnp.float32), axis=3)
    gate = jnp.einsum('bhsd,bhnd->bhsn', q.astype(jnp.float32), k_mean)
    q_blk = jnp.arange(s_pad) // blk_len
    gate = jnp.where(jnp.arange(n_blk)[None, :] < q_blk[:, None], gate, -jnp.inf)
    n_sel = min(MOBA_TOPK, n_blk)
    _, sel = lax.top_k(gate, n_sel)
    n_qc = s_pad // q_len
    q_c = q.reshape(bsz, n_heads, n_qc, q_len, hd).transpose(2, 0, 1, 3, 4)
    sel_c = sel.reshape(bsz, n_heads, n_qc, q_len, n_sel).transpose(2, 0, 1, 3, 4)
    b_idx = jnp.arange(bsz)[:, None, None, None]
    h_idx = jnp.arange(n_heads)[None, :, None, None]
    offs = jnp.arange(blk_len)

    def attend(args):
        qc, sc, c = args
        t = c * q_len + jnp.arange(q_len)
        own = (c * q_len) // blk_len
        k_sel = k_blocks[b_idx, h_idx, sc]
        v_sel = v_blocks[b_idx, h_idx, sc]
        s_sel = jnp.einsum('bhqd,bhqnld->bhqnl', qc, k_sel).astype(jnp.float32) * scale
        dist_sel = (t[:, None, None] - (sc[..., None] * blk_len + offs)).astype(jnp.float32)
        s_sel = s_sel - slopes[:, None, None, None] * dist_sel
        s_sel = jnp.where((jnp.arange(n_sel) < own)[:, None], s_sel, -jnp.inf)
        k_own = lax.dynamic_slice_in_dim(k, own * blk_len, blk_len, axis=2)
        v_own = lax.dynamic_slice_in_dim(v, own * blk_len, blk_len, axis=2)
        s_own = jnp.einsum('bhqd,bhld->bhql', qc, k_own).astype(jnp.float32) * scale
        dist_own = t[:, None] - (own * blk_len + offs)[None, :]
        s_own = jnp.where(dist_own >= 0, s_own - slopes[:, None, None] * dist_own.astype(jnp.float32), -jnp.inf)
        scores = jnp.concatenate([s_sel.reshape(bsz, n_heads, q_len, n_sel * blk_len), s_own], axis=-1)
        p = jax.nn.softmax(scores, axis=-1).astype(v.dtype)
        p_sel = p[..., :n_sel * blk_len].reshape(bsz, n_heads, q_len, n_sel, blk_len)
        return (jnp.einsum('bhqnl,bhqnld->bhqd', p_sel, v_sel)
                + jnp.einsum('bhql,bhld->bhqd', p[..., n_sel * blk_len:], v_own))

    o = lax.map(attend, (q_c, sel_c, jnp.arange(n_qc)))
    return o.transpose(1, 0, 3, 2, 4).reshape(bsz, s_pad, n_heads, hd)[:, :seq]


def complex_affine_combine(e1, e2):
    a1r, a1i, b1r, b1i = e1
    a2r, a2i, b2r, b2i = e2
    return (a2r * a1r - a2i * a1i, a2r * a1i + a2i * a1r,
            a2r * b1r - a2i * b1i + b2r, a2r * b1i + a2i * b1r + b2i)


def s5_ssm(u, a_re, a_im, b_re, b_im, c_re, c_im, d, log_step):
    a_re, a_im, b_re, b_im, c_re, c_im, d = (t.astype(jnp.float32) for t in (a_re, a_im, b_re, b_im, c_re, c_im, d))
    step = jnp.exp(log_step.astype(jnp.float32))[:, None]
    mag = jnp.exp(a_re * step)
    ab_re = mag * jnp.cos(a_im * step)
    ab_im = mag * jnp.sin(a_im * step)
    den = jnp.square(a_re) + jnp.square(a_im)
    z_re = ((ab_re - 1.0) * a_re + ab_im * a_im) / den
    z_im = (ab_im * a_re - (ab_re - 1.0) * a_im) / den
    bb_re = z_re[..., None] * b_re - z_im[..., None] * b_im
    bb_im = z_re[..., None] * b_im + z_im[..., None] * b_re
    bu_re = jnp.einsum('gpc,bsgc->bsgp', bb_re, u)
    bu_im = jnp.einsum('gpc,bsgc->bsgp', bb_im, u)
    elems = (jnp.broadcast_to(ab_re, bu_re.shape), jnp.broadcast_to(ab_im, bu_im.shape), bu_re, bu_im)
    _, _, x_re, x_im = lax.associative_scan(complex_affine_combine, elems, axis=1)
    return (jnp.einsum('gcp,bsgp->bsgc', c_re, x_re) - jnp.einsum('gcp,bsgp->bsgc', c_im, x_im) + d * u)


def even_mixer(x, w_in, w_gate2, b_gate, norm_g, w_out):
    bsz, seq, _ = x.shape
    gq, gk, gv, g_lr, gr, mq, mk, mv = split_cols(x @ w_in, EVEN_SIZES)
    kshape = (bsz, seq, GLA_HEADS, GLA_DK)
    vshape = (bsz, seq, GLA_HEADS, GLA_DV)
    log_a = jax.nn.log_sigmoid((g_lr @ w_gate2 + b_gate).astype(jnp.float32)).reshape(kshape) / GLA_GATE_NORM
    o = gla_chunked(gq.reshape(kshape).astype(jnp.float32) * GLA_DK ** -0.5, gk.reshape(kshape).astype(jnp.float32),
                    gv.reshape(vshape).astype(jnp.float32), log_a)
    o = rms_norm(o, norm_g) * jax.nn.silu(gr.reshape(vshape).astype(jnp.float32))
    gla_out = o.reshape(bsz, seq, GLA_HEADS * GLA_DV).astype(x.dtype)
    mshape = (bsz, seq, MOBA_HEADS, MOBA_HEAD_DIM)
    moba_out = moba_attention(mq.reshape(mshape), mk.reshape(mshape), mv.reshape(mshape))
    moba_out = moba_out.reshape(bsz, seq, MOBA_HEADS * MOBA_HEAD_DIM).astype(x.dtype)
    return jnp.concatenate([gla_out, moba_out], axis=-1) @ w_out


def odd_mixer(x, w_in, conv_w, a_log, dt_bias, norm_g, a_re, a_im, b_re, b_im, c_re, c_im, d, log_step,
              glu_w, glu_b, w_out):
    bsz, seq, _ = x.shape
    qkv, z, beta_in, decay_in, u = split_cols(x @ w_in, ODD_SIZES)
    qkv = jax.nn.silu(causal_depthwise_conv(qkv, conv_w))
    q, k, v = jnp.split(qkv, 3, axis=-1)
    hs = (bsz, seq, GDN_HEADS, GDN_HEAD_DIM)
    q = l2_normalize(q.reshape(hs).astype(jnp.float32))
    k = l2_normalize(k.reshape(hs).astype(jnp.float32))
    v = v.reshape(hs).astype(jnp.float32)
    beta = jax.nn.sigmoid(beta_in.astype(jnp.float32))
    g = -jnp.exp(a_log.astype(jnp.float32)) * jax.nn.softplus(decay_in.astype(jnp.float32) + dt_bias.astype(jnp.float32))
    o = gated_delta_chunked(q, k, v, g, beta)
    o = rms_norm(o, norm_g) * jax.nn.silu(z.reshape(hs).astype(jnp.float32))
    gdn_out = o.reshape(bsz, seq, GDN_HEADS * GDN_HEAD_DIM).astype(x.dtype)
    y = s5_ssm(u.reshape(bsz, seq, S5_GROUPS, S5_GROUP_CH).astype(jnp.float32),
               a_re, a_im, b_re, b_im, c_re, c_im, d, log_step)
    y = jax.nn.gelu(y.reshape(bsz, seq, S5_CHANNELS)).astype(x.dtype)
    s5_out = y * jax.nn.sigmoid(y @ glu_w + glu_b)
    return jnp.concatenate([gdn_out, s5_out], axis=-1) @ w_out


def conv_ffn(x, w_up, conv_w, w_down):
    h = causal_depthwise_conv(x @ w_up, conv_w)
    gate, val = jnp.split(h, 2, axis=-1)
    return (jax.nn.silu(gate) * val) @ w_down


def setup_inputs(seed: int = 0) -> dict:
    key = jax.random.key(seed)
    keys = iter(jax.random.split(key, 40))

    def normal(shape, scale):
        return jax.random.normal(next(keys), shape, jnp.float32) * scale

    def uniform(shape, lo, hi):
        return jax.random.uniform(next(keys), shape, jnp.float32, lo, hi)

    dt = jnp.exp(uniform((N_ODD, GDN_HEADS), math.log(1e-3), math.log(1e-1)))
    return {
        "x": normal((BATCH, SEQ, D_MODEL), 1.0),
        "even_w_in": normal((N_EVEN, D_MODEL, EVEN_IN), D_MODEL ** -0.5),
        "gla_w_gate2": normal((N_EVEN, GLA_GATE_RANK, GLA_HEADS * GLA_DK), GLA_GATE_RANK ** -0.5),
        "gla_b_gate": normal((N_EVEN, GLA_HEADS * GLA_DK), 0.02),
        "gla_norm_g": 1.0 + normal((N_EVEN, GLA_DV), 0.02),
        "even_w_out": normal((N_EVEN, EVEN_OUT, D_MODEL), DEEPNORM_BETA * EVEN_OUT ** -0.5),
        "odd_w_in": normal((N_ODD, D_MODEL, ODD_IN), D_MODEL ** -0.5),
        "gdn_conv_w": normal((N_ODD, GDN_CONV, 3 * GDN_HEADS * GDN_HEAD_DIM), GDN_CONV ** -0.5),
        "gdn_a_log": jnp.log(uniform((N_ODD, GDN_HEADS), 1.0, 16.0)),
        "gdn_dt_bias": dt + jnp.log(-jnp.expm1(-dt)),
        "gdn_norm_g": 1.0 + normal((N_ODD, GDN_HEAD_DIM), 0.02),
        "s5_a_re": -0.5 + normal((N_ODD, S5_GROUPS, S5_STATE), 0.01),
        "s5_a_im": math.pi * jnp.arange(S5_STATE, dtype=jnp.float32) + normal((N_ODD, S5_GROUPS, S5_STATE), 0.01),
        "s5_b_re": normal((N_ODD, S5_GROUPS, S5_STATE, S5_GROUP_CH), (2 * S5_GROUP_CH) ** -0.5),
        "s5_b_im": normal((N_ODD, S5_GROUPS, S5_STATE, S5_GROUP_CH), (2 * S5_GROUP_CH) ** -0.5),
        "s5_c_re": normal((N_ODD, S5_GROUPS, S5_GROUP_CH, S5_STATE), S5_STATE ** -0.25),
        "s5_c_im": normal((N_ODD, S5_GROUPS, S5_GROUP_CH, S5_STATE), S5_STATE ** -0.25),
        "s5_d": normal((N_ODD, S5_GROUPS, S5_GROUP_CH), 0.5),
        "s5_log_step": uniform((N_ODD, S5_GROUPS), math.log(1e-3), math.log(1e-1)),
        "s5_glu_w": normal((N_ODD, S5_CHANNELS, S5_CHANNELS), S5_CHANNELS ** -0.5),
        "s5_glu_b": normal((N_ODD, S5_CHANNELS), 0.02),
        "odd_w_out": normal((N_ODD, ODD_OUT, D_MODEL), DEEPNORM_BETA * ODD_OUT ** -0.5),
        "ln_mix_g": 1.0 + normal((DEPTH, D_MODEL), 0.02),
        "ln_mix_b": normal((DEPTH, D_MODEL), 0.02),
        "ffn_w_up": normal((DEPTH, D_MODEL, 2 * D_FF), D_MODEL ** -0.5),
        "ffn_conv_w": normal((DEPTH, FFN_CONV, 2 * D_FF), FFN_CONV ** -0.5),
        "ffn_w_down": normal((DEPTH, D_FF, D_MODEL), DEEPNORM_BETA * D_FF ** -0.5),
        "ln_ffn_g": 1.0 + normal((DEPTH, D_MODEL), 0.02),
        "ln_ffn_b": normal((DEPTH, D_MODEL), 0.02),
    }


def reference(x, even_w_in, gla_w_gate2, gla_b_gate, gla_norm_g, even_w_out, odd_w_in, gdn_conv_w, gdn_a_log,
              gdn_dt_bias, gdn_norm_g, s5_a_re, s5_a_im, s5_b_re, s5_b_im, s5_c_re, s5_c_im, s5_d, s5_log_step,
              s5_glu_w, s5_glu_b, odd_w_out, ln_mix_g, ln_mix_b, ffn_w_up, ffn_conv_w, ffn_w_down, ln_ffn_g, ln_ffn_b):
    for i in range(DEPTH):
        j = i // 2
        if i % 2 == 0:
            mix = even_mixer(x, even_w_in[j], gla_w_gate2[j], gla_b_gate[j], gla_norm_g[j], even_w_out[j])
        else:
            mix = odd_mixer(x, odd_w_in[j], gdn_conv_w[j], gdn_a_log[j], gdn_dt_bias[j], gdn_norm_g[j],
                            s5_a_re[j], s5_a_im[j], s5_b_re[j], s5_b_im[j], s5_c_re[j], s5_c_im[j], s5_d[j],
                            s5_log_step[j], s5_glu_w[j], s5_glu_b[j], odd_w_out[j])
        x = layer_norm(DEEPNORM_ALPHA * x + mix, ln_mix_g[i], ln_mix_b[i])
        x = layer_norm(DEEPNORM_ALPHA * x + conv_ffn(x, ffn_w_up[i], ffn_conv_w[i], ffn_w_down[i]),
                       ln_ffn_g[i], ln_ffn_b[i])
    return x
```

```cpp
#ifdef EMU
#include "emu.h"
#else
#include <hip/hip_runtime.h>
#include <hip/hip_cooperative_groups.h>
#include <cstdio>
namespace cg = cooperative_groups;
#endif

typedef unsigned short bf16_t;
typedef short bf16x8 __attribute__((ext_vector_type(8)));
typedef float f32x4 __attribute__((ext_vector_type(4)));
typedef float f32x2 __attribute__((ext_vector_type(2)));
typedef unsigned u32x4 __attribute__((ext_vector_type(4)));
typedef unsigned u32x2 __attribute__((ext_vector_type(2)));

#ifdef EMU_SMALL
constexpr int SEQ = EMU_SEQ, DM = 256, DEPTH = 2, GLA_H = 2, MOBA_H = 2, GDN_H = 2, S5_CH = 256, DFF = 512;
constexpr float ALPHA = 1.4142135623730951f;
#else
constexpr int SEQ = 8192, DM = 2048, DEPTH = 4, GLA_H = 8, MOBA_H = 8, GDN_H = 8, S5_CH = 1024, DFF = 5632;
constexpr float ALPHA = 1.681792830507429f;
#endif
constexpr int N_EVEN = (DEPTH + 1) / 2, N_ODD = DEPTH / 2;
constexpr int NCH = SEQ / 64, NBLK = SEQ / 256;
constexpr int S5_G = S5_CH / 16, S5_P = 64;
constexpr int EV_GQ = 0, EV_GK = GLA_H * 64, EV_GV = 2 * GLA_H * 64, EV_GLR = EV_GV + GLA_H * 128, EV_GR = EV_GLR + 16,
              EV_MQ = EV_GR + GLA_H * 128, EV_MK = EV_MQ + MOBA_H * 128, EV_MV = EV_MK + MOBA_H * 128, EVEN_IN = EV_MV + MOBA_H * 128;
constexpr int EV_LD = EV_MQ;
constexpr int OD_QKV = 0, OD_Z = 3 * GDN_H * 128, OD_BETA = OD_Z + GDN_H * 128, OD_DEC = OD_BETA + GDN_H, OD_U = OD_DEC + GDN_H, ODD_IN = OD_U + S5_CH;
constexpr int OD_LD = ODD_IN;
constexpr int EVEN_OUT = GLA_H * 128 + MOBA_H * 128, ODD_OUT = GDN_H * 128 + S5_CH;
constexpr int EVEN_NP = ((EVEN_IN + 255) / 256) * 256, ODD_NP = ((ODD_IN + 255) / 256) * 256;
constexpr int MQ_LD = MOBA_H * 128;
constexpr int STEPS_PER_LAYER = 11, N_STEPS = 1 + DEPTH * STEPS_PER_LAYER;
constexpr int LDS_BYTES = 131072;

constexpr size_t al256(size_t x) { return (x + 255) & ~(size_t)255; }
constexpr size_t cmax(size_t a, size_t b) { return a > b ? a : b; }
constexpr size_t SZ_WINE = al256((size_t)EVEN_NP * DM * 2), SZ_WOUTE = al256((size_t)DM * EVEN_OUT * 2), SZ_WINO = al256((size_t)ODD_NP * DM * 2),
                 SZ_WGLU = al256((size_t)S5_CH * S5_CH * 2), SZ_WOUTO = al256((size_t)DM * ODD_OUT * 2), SZ_WUP = al256((size_t)2 * DFF * DM * 2), SZ_WDN = al256((size_t)DM * DFF * 2);
constexpr size_t OFF_WINE = 0, OFF_WOUTE = OFF_WINE + N_EVEN * SZ_WINE, OFF_WINO = OFF_WOUTE + N_EVEN * SZ_WOUTE, OFF_WGLU = OFF_WINO + N_ODD * SZ_WINO,
                 OFF_WOUTO = OFF_WGLU + N_ODD * SZ_WGLU, OFF_WUP = OFF_WOUTO + N_ODD * SZ_WOUTO, OFF_WDN = OFF_WUP + DEPTH * SZ_WUP, OFF_ACT = OFF_WDN + DEPTH * SZ_WDN;
constexpr size_t SZ_XB = al256((size_t)SEQ * DM * 2), SZ_X32 = al256((size_t)SEQ * DM * 4), SZ_H32 = al256((size_t)SEQ * cmax(EV_LD, OD_LD) * 4),
                 SZ_CAT = al256((size_t)SEQ * cmax(EVEN_OUT, ODD_OUT) * 2), SZ_STATS = al256((size_t)DEPTH * 2 * SEQ * 2 * 4),
                 SZ_S5C1 = al256((size_t)36 * S5_G * S5_P * 4), SZ_KMEAN = al256((size_t)MOBA_H * NBLK * 128 * 4);
constexpr size_t OFF_XB = OFF_ACT, OFF_X32 = OFF_XB + SZ_XB, OFF_Y32 = OFF_X32 + SZ_X32, OFF_H32 = OFF_Y32 + SZ_X32, OFF_CAT = OFF_H32 + SZ_H32, OFF_STATS = OFF_CAT + SZ_CAT,
                 OFF_S5C = OFF_STATS + SZ_STATS, OFF_KMEAN = OFF_S5C + N_ODD * SZ_S5C1, OFF_SCR = OFF_KMEAN + SZ_KMEAN;
constexpr size_t SZ_H16 = al256((size_t)SEQ * 2 * DFF * 2), SZ_G16 = al256((size_t)SEQ * DFF * 2);
constexpr size_t OFF_H16 = OFF_SCR, OFF_G16 = OFF_H16 + SZ_H16, END_FFN = OFF_G16 + SZ_G16;
constexpr size_t SZ_MQ = al256((size_t)SEQ * MQ_LD * 2), SZ_KVS = al256((size_t)GLA_H * NCH * 64 * 128 * 4), SZ_DEC = al256((size_t)GLA_H * NCH * 64 * 4);
constexpr size_t OFF_MQ = OFF_SCR, OFF_MK = OFF_MQ + SZ_MQ, OFF_MVT = OFF_MK + SZ_MQ, OFF_KVS = OFF_MVT + SZ_MQ, OFF_DEC = OFF_KVS + SZ_KVS, END_EVEN = OFF_DEC + SZ_DEC;
constexpr size_t SZ_GD = al256((size_t)GDN_H * NCH * 64 * 128 * 4), SZ_ATT = al256((size_t)GDN_H * NCH * 64 * 64 * 4), SZ_EGL = al256((size_t)GDN_H * NCH * 4),
                 SZ_O32 = al256((size_t)SEQ * GDN_H * 128 * 4), SZ_XEND = al256((size_t)NCH * S5_G * S5_P * 2 * 4), SZ_YS = al256((size_t)SEQ * S5_CH * 2);
constexpr size_t OFF_GU = OFF_SCR, OFF_GW = OFF_GU + SZ_GD, OFF_GQD = OFF_GW + SZ_GD, OFF_GKD = OFF_GQD + SZ_GD, OFF_ATT = OFF_GKD + SZ_GD, OFF_EGL = OFF_ATT + SZ_ATT,
                 OFF_O32 = OFF_EGL + SZ_EGL, OFF_XEND = OFF_O32 + SZ_O32, OFF_YS = OFF_XEND + SZ_XEND, END_ODD = OFF_YS + SZ_YS;
constexpr size_t WS_NEEDED = cmax(END_FFN, cmax(END_EVEN, END_ODD));

struct Params {
  const float *x, *even_w_in, *gla_w_gate2, *gla_b_gate, *gla_norm_g, *even_w_out, *odd_w_in, *gdn_conv_w, *gdn_a_log, *gdn_dt_bias, *gdn_norm_g,
      *s5_a_re, *s5_a_im, *s5_b_re, *s5_b_im, *s5_c_re, *s5_c_im, *s5_d, *s5_log_step, *s5_glu_w, *s5_glu_b, *odd_w_out, *ln_mix_g, *ln_mix_b,
      *ffn_w_up, *ffn_conv_w, *ffn_w_down, *ln_ffn_g, *ln_ffn_b;
  float* out; char* ws; int step_begin, step_end;
};

#ifdef EMU
__device__ __forceinline__ int tid_() { return threadIdx.x; }
#define LAUNDER_S(x)
#else
__device__ __forceinline__ int tid_() { int t = threadIdx.x; asm volatile("" : "+v"(t)); return t; }
#define LAUNDER_S(x) asm volatile("" : "+s"(x))
#endif

__device__ __forceinline__ bf16_t f2bf(float f) { unsigned u = __float_as_uint(f); u += 0x7FFFu + ((u >> 16) & 1u); return (bf16_t)(u >> 16); }
__device__ __forceinline__ float bf2f(bf16_t b) { return __uint_as_float(((unsigned)b) << 16); }
__device__ __forceinline__ unsigned pack2(float lo, float hi) { return (unsigned)f2bf(lo) | ((unsigned)f2bf(hi) << 16); }
__device__ __forceinline__ float sigmoidf_(float x) { return 1.f / (1.f + __expf(-x)); }
__device__ __forceinline__ float siluf_(float x) { return x / (1.f + __expf(-x)); }
__device__ __forceinline__ float softplusf_(float x) { return fmaxf(x, 0.f) + log1pf(__expf(-fabsf(x))); }
__device__ __forceinline__ float geluf_(float x) { float u = 0.7978845608028654f * (x + 0.044715f * x * x * x); float e = __expf(2.f * u); float th = 1.f - 2.f / (e + 1.f); return 0.5f * x * (1.f + th); }
__device__ __forceinline__ f32x4 shfl_xor4(f32x4 v, int m) {
#ifdef EMU
  return __shfl_xor(v, m);
#else
  f32x4 r; r[0] = __shfl_xor(v[0], m); r[1] = __shfl_xor(v[1], m); r[2] = __shfl_xor(v[2], m); r[3] = __shfl_xor(v[3], m); return r;
#endif
}
__device__ __forceinline__ f32x4 f4zero() { return (f32x4){0.f, 0.f, 0.f, 0.f}; }

namespace pg8 {
constexpr int BM = 256, BK = 64, HALF = 128, HTB = HALF * BK * 2, STAGE_BYTES = 8 * HTB, NXCD = 8, WGM = 8;
__host__ __device__ __forceinline__ int lds_byte(int r, int c) { const int st = (r >> 4) * 2 + (c >> 5), rr = r & 15, cc = c & 31, ob = rr * 64 + cc * 2; return st * 1024 + (ob ^ (((ob >> 9) & 1) << 5)); }
__host__ __device__ __forceinline__ void stage_rc(int b, int& R, int& C) { const int st = b / 1024, sb = b % 1024, swz = sb ^ (((sb >> 9) & 1) << 5); R = (st >> 1) * 16 + swz / 64; C = (st & 1) * 32 + (swz % 64) / 2; }
struct Unit { int pm, pn; };
struct Gemm { const bf16_t* A; const bf16_t* Bt; int M, N, K; };
struct StaticOrder {
  int nM, nN, nwg, G, c;
  __host__ __device__ void init(int M, int N, int G_, int c_) { nM = M / BM; nN = N / BM; nwg = nM * nN; G = G_; c = c_; }
  __host__ __device__ bool next(int i, Unit& u) const {
    const long L = (long)i * G + c; if (L >= nwg) return false;
    int wgid = (int)L; { const int q = nwg / NXCD, r = nwg % NXCD, xcd = wgid % NXCD, off = wgid / NXCD; wgid = (xcd < r ? xcd * (q + 1) : r * (q + 1) + (xcd - r) * q) + off; }
    const int nig = WGM * nN, gid = wgid / nig, fm = gid * WGM, gsz = (nM - fm) < WGM ? (nM - fm) : WGM;
    u.pm = fm + ((wgid % nig) % gsz); u.pn = (wgid % nig) / gsz; return true;
  }
};
#ifndef EMU
#define PG8_LAS __attribute__((address_space(3)))
template <class Epi>
__device__ __forceinline__ void gemm_phase(char* smem, const Gemm g, const StaticOrder& S, const Epi& E) {
  PG8_LAS unsigned char* lds = (PG8_LAS unsigned char*)smem;
  const int tid = tid_(), wid = __builtin_amdgcn_readfirstlane(tid >> 6), lane = tid & 63, wr = wid >> 2, wc = wid & 3, fr = lane & 15, fq = lane >> 4;
  const int K = g.K, nt = K / BK;
  unsigned voffA[2], voffB[2];
#pragma unroll
  for (int i = 0; i < 2; ++i) { int R, C; stage_rc(tid * 16 + i * 8192, R, C); voffA[i] = (unsigned)(R * K + C) * 2u; voffB[i] = voffA[i]; }
  const size_t kstep = (size_t)(BK * 2);
  const size_t hstep = (size_t)HALF * K * 2;
  const size_t tstep = 2 * hstep;
  const unsigned ldsw = (unsigned)wid * 1024u;
  const int aoff = lds_byte(wr * 64 + fr, fq * 8), boff = lds_byte(wc * 32 + fr, fq * 8);
#define PG8_SA(b, h) (((b) * 2 + (h)) * HTB)
#define PG8_SB(b, h) ((4 + (b) * 2 + (h)) * HTB)
#define PG8_STAGE(bufoff, gbase, voff) do { _Pragma("unroll") for (int _i = 0; _i < 2; ++_i) \
    __builtin_amdgcn_global_load_lds((const unsigned*)((const char*)(gbase) + (voff)[_i]), (PG8_LAS unsigned*)(lds + (bufoff) + ldsw + _i * 8192), 16, 0, 0); } while (0)
#define PG8_LDA(dst, b, h) do { _Pragma("unroll") for (int m = 0; m < 4; ++m) _Pragma("unroll") for (int k = 0; k < 2; ++k) dst[m][k] = *(const PG8_LAS bf16x8*)(lds + PG8_SA(b, h) + aoff + m * 2048 + k * 1024); } while (0)
#define PG8_LDB(dst, b, h) do { _Pragma("unroll") for (int n = 0; n < 2; ++n) _Pragma("unroll") for (int k = 0; k < 2; ++k) dst[n][k] = *(const PG8_LAS bf16x8*)(lds + PG8_SB(b, h) + boff + n * 2048 + k * 1024); } while (0)
#define PG8_MMA(ai, bj, At, Bt) do { __builtin_amdgcn_s_setprio(1); _Pragma("unroll") for (int m = 0; m < 4; ++m) _Pragma("unroll") for (int n = 0; n < 2; ++n) _Pragma("unroll") for (int k = 0; k < 2; ++k) \
    acc[ai][bj][m][n] = __builtin_amdgcn_mfma_f32_16x16x32_bf16(Bt[n][k], At[m][k], acc[ai][bj][m][n], 0, 0, 0); __builtin_amdgcn_s_setprio(0); } while (0)
#define PG8_WAIT_V(n) asm volatile("s_waitcnt vmcnt(" #n ")" ::: "memory")
#define PG8_WAIT_L(n) asm volatile("s_waitcnt lgkmcnt(" #n ")" ::: "memory")
#define PG8_BAR __builtin_amdgcn_s_barrier()
#define PG8_SCHED __builtin_amdgcn_sched_barrier(0)
  Unit cur, nxt; int ui = 0;
  if (!S.next(0, cur)) return;
  f32x4 acc[2][2][4][2];
#pragma unroll
  for (int a = 0; a < 2; ++a)
#pragma unroll
    for (int b = 0; b < 2; ++b)
#pragma unroll
      for (int m = 0; m < 4; ++m)
#pragma unroll
        for (int n = 0; n < 2; ++n) acc[a][b][m][n] = (f32x4){0.f, 0.f, 0.f, 0.f};
  bf16x8 At[4][2], B0[2][2], B1[2][2];
  const char* cA = (const char*)g.A + (size_t)cur.pm * tstep; const char* cB = (const char*)g.Bt + (size_t)cur.pn * tstep;
  PG8_STAGE(PG8_SB(0, 0), cB, voffB); PG8_STAGE(PG8_SA(0, 0), cA, voffA); PG8_STAGE(PG8_SB(0, 1), cB + hstep, voffB); PG8_STAGE(PG8_SA(0, 1), cA + hstep, voffA);
  if (wr == 1) PG8_BAR;
  PG8_WAIT_V(4); PG8_BAR;
  PG8_STAGE(PG8_SB(1, 0), cB + kstep, voffB); PG8_STAGE(PG8_SA(1, 0), cA + kstep, voffA); PG8_STAGE(PG8_SB(1, 1), cB + hstep + kstep, voffB);
  PG8_WAIT_V(6); PG8_BAR;
  for (;;) {
    const bool has_next = S.next(ui + 1, nxt);
    const char* nA = has_next ? (const char*)g.A + (size_t)nxt.pm * tstep : cA; const char* nB = has_next ? (const char*)g.Bt + (size_t)nxt.pn * tstep : cB;
    for (int t = 0; t < nt; t += 2) {
      const bool last = (t == nt - 2);
      const char* a1 = cA + (size_t)(t + 1) * kstep;
      const char* a2 = last ? nA : cA + (size_t)(t + 2) * kstep; const char* b2 = last ? nB : cB + (size_t)(t + 2) * kstep;
      const char* a3 = a2 + kstep; const char* b3 = b2 + kstep;
      PG8_LDB(B0, 0, 0); PG8_SCHED; PG8_LDA(At, 0, 0); PG8_STAGE(PG8_SA(1, 1), a1 + hstep, voffA);
      PG8_WAIT_L(8); PG8_BAR; PG8_WAIT_L(0); PG8_MMA(0, 0, At, B0); PG8_BAR; PG8_SCHED;
      PG8_LDB(B1, 0, 1); PG8_STAGE(PG8_SB(0, 0), b2, voffB);
      PG8_BAR; PG8_WAIT_L(0); PG8_MMA(0, 1, At, B1); PG8_BAR;
      PG8_LDA(At, 0, 1); PG8_STAGE(PG8_SA(0, 0), a2, voffA);
      PG8_BAR; PG8_WAIT_L(0); PG8_MMA(1, 0, At, B0); PG8_BAR; PG8_SCHED;
      PG8_STAGE(PG8_SB(0, 1), b2 + hstep, voffB);
      PG8_WAIT_V(6); PG8_BAR; PG8_MMA(1, 1, At, B1); PG8_BAR;
      PG8_LDB(B0, 1, 0); PG8_SCHED; PG8_LDA(At, 1, 0); PG8_STAGE(PG8_SA(0, 1), a2 + hstep, voffA);
      PG8_WAIT_L(8); PG8_BAR; PG8_WAIT_L(0); PG8_MMA(0, 0, At, B0); PG8_BAR; PG8_SCHED;
      PG8_LDB(B1, 1, 1); PG8_STAGE(PG8_SB(1, 0), b3, voffB);
      PG8_BAR; PG8_WAIT_L(0); PG8_MMA(0, 1, At, B1); PG8_BAR;
      PG8_LDA(At, 1, 1); PG8_STAGE(PG8_SA(1, 0), a3, voffA);
      PG8_BAR; PG8_WAIT_L(0); PG8_MMA(1, 0, At, B0); PG8_BAR; PG8_SCHED;
      PG8_STAGE(PG8_SB(1, 1), b3 + hstep, voffB);
      PG8_WAIT_V(6); PG8_BAR; PG8_MMA(1, 1, At, B1); PG8_BAR;
    }
    E(acc, cur, wr, wc, fr, fq);
    if (!has_next) break;
#pragma unroll
    for (int a = 0; a < 2; ++a)
#pragma unroll
      for (int b = 0; b < 2; ++b)
#pragma unroll
        for (int m = 0; m < 4; ++m)
#pragma unroll
          for (int n = 0; n < 2; ++n) acc[a][b][m][n] = (f32x4){0.f, 0.f, 0.f, 0.f};
    cur = nxt; cA = nA; cB = nB; ++ui;
  }
  PG8_WAIT_V(0);
  if (wr == 0) PG8_BAR;
  PG8_BAR;
#undef PG8_SA
#undef PG8_SB
#undef PG8_STAGE
#undef PG8_LDA
#undef PG8_LDB
#undef PG8_MMA
#undef PG8_WAIT_V
#undef PG8_WAIT_L
#undef PG8_BAR
#undef PG8_SCHED
}
#else
template <class Epi>
void gemm_phase(char* smem, const Gemm g, const StaticOrder& S, const Epi& E) {
  const int tid = tid_(), wid = tid >> 6, lane = tid & 63, wr = wid >> 2, wc = wid & 3, fr = lane & 15, fq = lane >> 4;
  Unit u;
  for (int i = 0; S.next(i, u); ++i) {
    f32x4 acc[2][2][4][2];
    for (int ai = 0; ai < 2; ++ai) for (int bj = 0; bj < 2; ++bj) for (int m = 0; m < 4; ++m) for (int n = 0; n < 2; ++n) for (int j = 0; j < 4; ++j) {
      int row = u.pm * 256 + ai * 128 + wr * 64 + m * 16 + fr, col = u.pn * 256 + bj * 128 + wc * 32 + n * 16 + fq * 4 + j;
      const bf16_t* a = g.A + (size_t)row * g.K; const bf16_t* b = g.Bt + (size_t)col * g.K; float s = 0.f;
      for (int k = 0; k < g.K; ++k) s += bf2f(a[k]) * bf2f(b[k]);
      acc[ai][bj][m][n][j] = s;
    }
    E(acc, u, wr, wc, fr, fq);
  }
}
#endif
}
using pg8::Unit;

#define EPI_LOOP_BEGIN _Pragma("unroll") for (int ai = 0; ai < 2; ++ai) _Pragma("unroll") for (int m = 0; m < 4; ++m) { const int row = u.pm * 256 + ai * 128 + wr * 64 + m * 16 + fr;
#define EPI_FRAG_LOOP _Pragma("unroll") for (int bj = 0; bj < 2; ++bj) _Pragma("unroll") for (int n = 0; n < 2; ++n) { const int col = u.pn * 256 + bj * 128 + wc * 32 + n * 16 + fq * 4; const f32x4 v = acc[ai][bj][m][n];
struct EpiEvenIn {
  float* H32; bf16_t *MQ, *MK, *MVT;
  __device__ __forceinline__ void operator()(const f32x4 (&acc)[2][2][4][2], const Unit& u, int wr, int wc, int fr, int fq) const {
    EPI_LOOP_BEGIN
      EPI_FRAG_LOOP
        if (col < EV_MQ) *(f32x4*)(H32 + (size_t)row * EV_LD + col) = v;
        else if (col < EV_MK) *(u32x2*)(MQ + (size_t)row * MQ_LD + (col - EV_MQ)) = (u32x2){pack2(v[0], v[1]), pack2(v[2], v[3])};
        else if (col < EV_MV) *(u32x2*)(MK + (size_t)row * MQ_LD + (col - EV_MK)) = (u32x2){pack2(v[0], v[1]), pack2(v[2], v[3])};
        else if (col < EVEN_IN) { bf16_t* d = MVT + (size_t)(col - EV_MV) * SEQ + row; d[0] = f2bf(v[0]); d[SEQ] = f2bf(v[1]); d[2 * (size_t)SEQ] = f2bf(v[2]); d[3 * (size_t)SEQ] = f2bf(v[3]); }
      }
    }
  }
};
struct EpiOddIn {
  float* H32;
  __device__ __forceinline__ void operator()(const f32x4 (&acc)[2][2][4][2], const Unit& u, int wr, int wc, int fr, int fq) const {
    EPI_LOOP_BEGIN
      EPI_FRAG_LOOP
        if (col < ODD_IN) *(f32x4*)(H32 + (size_t)row * OD_LD + col) = v;
      }
    }
  }
};
struct EpiBf16 {
  bf16_t* O; int ld;
  __device__ __forceinline__ void operator()(const f32x4 (&acc)[2][2][4][2], const Unit& u, int wr, int wc, int fr, int fq) const {
    EPI_LOOP_BEGIN
      EPI_FRAG_LOOP
        *(u32x2*)(O + (size_t)row * ld + col) = (u32x2){pack2(v[0], v[1]), pack2(v[2], v[3])};
      }
    }
  }
};
struct EpiRes {
  const float* res; float* Y; float* stats;
  __device__ __forceinline__ void operator()(const f32x4 (&acc)[2][2][4][2], const Unit& u, int wr, int wc, int fr, int fq) const {
    EPI_LOOP_BEGIN
      float s = 0.f, ss = 0.f;
      EPI_FRAG_LOOP
        const f32x4 r = *(const f32x4*)(res + (size_t)row * DM + col);
        const f32x4 y = r * ALPHA + v;
        *(f32x4*)(Y + (size_t)row * DM + col) = y;
        s += y[0] + y[1] + y[2] + y[3]; ss += y[0] * y[0] + y[1] * y[1] + y[2] * y[2] + y[3] * y[3];
      }
      s += __shfl_xor(s, 16); ss += __shfl_xor(ss, 16); s += __shfl_xor(s, 32); ss += __shfl_xor(ss, 32);
      if (fq == 0) { atomicAdd(stats + (size_t)row * 2, s); atomicAdd(stats + (size_t)row * 2 + 1, ss); }
    }
  }
};
struct EpiGlu {
  const bf16_t* YS; const float* bias; bf16_t* CAT;
  __device__ __forceinline__ void operator()(const f32x4 (&acc)[2][2][4][2], const Unit& u, int wr, int wc, int fr, int fq) const {
    EPI_LOOP_BEGIN
      EPI_FRAG_LOOP
        const u32x2 yy = *(const u32x2*)(YS + (size_t)row * S5_CH + col);
        const f32x4 b = *(const f32x4*)(bias + col);
        float y0 = __uint_as_float(yy[0] << 16), y1 = __uint_as_float(yy[0] & 0xffff0000u), y2 = __uint_as_float(yy[1] << 16), y3 = __uint_as_float(yy[1] & 0xffff0000u);
        y0 *= sigmoidf_(v[0] + b[0]); y1 *= sigmoidf_(v[1] + b[1]); y2 *= sigmoidf_(v[2] + b[2]); y3 *= sigmoidf_(v[3] + b[3]);
        *(u32x2*)(CAT + (size_t)row * ODD_OUT + GDN_H * 128 + col) = (u32x2){pack2(y0, y1), pack2(y2, y3)};
      }
    }
  }
};

template <class Epi> __device__ __forceinline__ void run_gemm(char* smem, const bf16_t* A, const bf16_t* Bt, int N, int K, const Epi& E, int bid, int nb) {
  pg8::Gemm g{A, Bt, SEQ, N, K}; pg8::StaticOrder S; S.init(SEQ, N, nb, bid);
  pg8::gemm_phase<Epi>(smem, g, S, E);
}

__device__ void transpose_convert(const float* src, bf16_t* dst, int K, int N, int Np, char* smem, int bid, int nb) {
  float* T = (float*)smem;
  const int tk = K / 64, tn = Np / 64, ntile = tk * tn, tid = tid_();
  for (int t = bid; t < ntile; t += nb) {
    const int k0 = (t % tk) * 64, n0 = (t / tk) * 64;
#pragma unroll
    for (int i = 0; i < 8; ++i) { const int r = (tid >> 6) + 8 * i, c = tid & 63, n = n0 + c; T[c * 65 + r] = (n < N) ? src[(size_t)(k0 + r) * N + n] : 0.f; }
    __syncthreads();
    { const int n = tid >> 3, ks = (tid & 7) * 8; const float* tp = T + n * 65 + ks;
      u32x4 o; o[0] = pack2(tp[0], tp[1]); o[1] = pack2(tp[2], tp[3]); o[2] = pack2(tp[4], tp[5]); o[3] = pack2(tp[6], tp[7]);
      *(u32x4*)(dst + (size_t)(n0 + n) * K + k0 + ks) = o; }
    __syncthreads();
  }
}
__device__ void step_prep(const Params& p, char* smem, int bid, int nb) {
  char* ws = p.ws;
  for (int j = 0; j < N_EVEN; ++j) {
    transpose_convert(p.even_w_in + (size_t)j * DM * EVEN_IN, (bf16_t*)(ws + OFF_WINE + j * SZ_WINE), DM, EVEN_IN, EVEN_NP, smem, bid, nb);
    transpose_convert(p.even_w_out + (size_t)j * EVEN_OUT * DM, (bf16_t*)(ws + OFF_WOUTE + j * SZ_WOUTE), EVEN_OUT, DM, DM, smem, bid, nb);
  }
  for (int j = 0; j < N_ODD; ++j) {
    transpose_convert(p.odd_w_in + (size_t)j * DM * ODD_IN, (bf16_t*)(ws + OFF_WINO + j * SZ_WINO), DM, ODD_IN, ODD_NP, smem, bid, nb);
    transpose_convert(p.s5_glu_w + (size_t)j * S5_CH * S5_CH, (bf16_t*)(ws + OFF_WGLU + j * SZ_WGLU), S5_CH, S5_CH, S5_CH, smem, bid, nb);
    transpose_convert(p.odd_w_out + (size_t)j * ODD_OUT * DM, (bf16_t*)(ws + OFF_WOUTO + j * SZ_WOUTO), ODD_OUT, DM, DM, smem, bid, nb);
  }
  for (int i = 0; i < DEPTH; ++i) {
    transpose_convert(p.ffn_w_up + (size_t)i * DM * 2 * DFF, (bf16_t*)(ws + OFF_WUP + i * SZ_WUP), DM, 2 * DFF, 2 * DFF, smem, bid, nb);
    transpose_convert(p.ffn_w_down + (size_t)i * DFF * DM, (bf16_t*)(ws + OFF_WDN + i * SZ_WDN), DFF, DM, DM, smem, bid, nb);
  }
  const size_t gt = (size_t)bid * 512 + tid_(), gn = (size_t)nb * 512;
  { bf16_t* XB = (bf16_t*)(ws + OFF_XB);
    for (size_t e = gt; e < (size_t)SEQ * DM / 4; e += gn) { const f32x4 v = *(const f32x4*)(p.x + e * 4); *(u32x2*)(XB + e * 4) = (u32x2){pack2(v[0], v[1]), pack2(v[2], v[3])}; } }
  { float* st = (float*)(ws + OFF_STATS); for (size_t e = gt; e < (size_t)DEPTH * 2 * SEQ * 2; e += gn) st[e] = 0.f; }
  for (size_t e = gt; e < (size_t)N_ODD * S5_G * S5_P; e += gn) {
    const int j = (int)(e / (S5_G * S5_P)), gp = (int)(e % (S5_G * S5_P)), g = gp / S5_P;
    float* C = (float*)(ws + OFF_S5C + j * SZ_S5C1);
    const float are = p.s5_a_re[(size_t)j * S5_G * S5_P + gp], aim = p.s5_a_im[(size_t)j * S5_G * S5_P + gp];
    const float step = expf(p.s5_log_step[j * S5_G + g]);
    const float mag = expf(are * step), abr = mag * cosf(aim * step), abi = mag * sinf(aim * step);
    const float den = are * are + aim * aim;
    const float zr = ((abr - 1.f) * are + abi * aim) / den, zi = (abi * are - (abr - 1.f) * aim) / den;
    C[gp] = abr; C[S5_G * S5_P + gp] = abi;
    float pr = abr, pi = abi;
    for (int k = 0; k < 6; ++k) { const float nr = pr * pr - pi * pi, ni = 2.f * pr * pi; pr = nr; pi = ni; }
    C[2 * S5_G * S5_P + gp] = pr; C[3 * S5_G * S5_P + gp] = pi;
    float* BBR = C + 4 * S5_G * S5_P + (size_t)gp * 16; float* BBI = C + 20 * S5_G * S5_P + (size_t)gp * 16;
    for (int c = 0; c < 16; ++c) { const float br = p.s5_b_re[((size_t)j * S5_G * S5_P + gp) * 16 + c], bi = p.s5_b_im[((size_t)j * S5_G * S5_P + gp) * 16 + c];
      BBR[c] = zr * br - zi * bi; BBI[c] = zr * bi + zi * br; }
  }
}

__device__ void step_ln(const float* Y, const float* stats, const float* g, const float* b, float* X32, bf16_t* XB, int bid, int nb) {
  const int w = tid_() >> 6, lane = tid_() & 63;
  for (int row = bid * 8 + w; row < SEQ; row += nb * 8) {
    const float mu = stats[(size_t)row * 2] * (1.f / DM); const float var = stats[(size_t)row * 2 + 1] * (1.f / DM) - mu * mu; const float rs = rsqrtf(fmaxf(var, 0.f) + 1e-5f);
    for (int c = lane * 4; c < DM; c += 256) {
      const f32x4 y = *(const f32x4*)(Y + (size_t)row * DM + c), gg = *(const f32x4*)(g + c), bb = *(const f32x4*)(b + c);
      const f32x4 o = (y - mu) * rs * gg + bb;
      *(f32x4*)(X32 + (size_t)row * DM + c) = o;
      *(u32x2*)(XB + (size_t)row * DM + c) = (u32x2){pack2(o[0], o[1]), pack2(o[2], o[3])};
    }
  }
}

__device__ void step_ffn_conv(const bf16_t* H16, const float* cw, bf16_t* G16, int bid, int nb) {
  constexpr int CG = DFF / 8, RB = 32;
  const size_t total = (size_t)(SEQ / RB) * CG;
  for (size_t it = (size_t)bid * 512 + tid_(); it < total; it += (size_t)nb * 512) {
    const int cg8 = (int)(it % CG) * 8, t0 = (int)(it / CG) * RB;
    float wg[3][8], wv[3][8];
#pragma unroll
    for (int i = 0; i < 3; ++i) {
#pragma unroll
      for (int k = 0; k < 8; k += 4) { const f32x4 a = *(const f32x4*)(cw + (size_t)i * 2 * DFF + cg8 + k), b = *(const f32x4*)(cw + (size_t)i * 2 * DFF + DFF + cg8 + k);
        wg[i][k] = a[0]; wg[i][k + 1] = a[1]; wg[i][k + 2] = a[2]; wg[i][k + 3] = a[3]; wv[i][k] = b[0]; wv[i][k + 1] = b[1]; wv[i][k + 2] = b[2]; wv[i][k + 3] = b[3]; }
    }
    float g0[8], g1[8], v0[8], v1[8];
#pragma unroll
    for (int k = 0; k < 8; ++k) { g0[k] = g1[k] = v0[k] = v1[k] = 0.f; }
    if (t0 >= 2) {
      const u32x4 a = *(const u32x4*)(H16 + (size_t)(t0 - 2) * 2 * DFF + cg8), b = *(const u32x4*)(H16 + (size_t)(t0 - 2) * 2 * DFF + DFF + cg8);
      const u32x4 c = *(const u32x4*)(H16 + (size_t)(t0 - 1) * 2 * DFF + cg8), d = *(const u32x4*)(H16 + (size_t)(t0 - 1) * 2 * DFF + DFF + cg8);
#pragma unroll
      for (int k = 0; k < 4; ++k) { g0[2 * k] = __uint_as_float(a[k] << 16); g0[2 * k + 1] = __uint_as_float(a[k] & 0xffff0000u); v0[2 * k] = __uint_as_float(b[k] << 16); v0[2 * k + 1] = __uint_as_float(b[k] & 0xffff0000u);
        g1[2 * k] = __uint_as_float(c[k] << 16); g1[2 * k + 1] = __uint_as_float(c[k] & 0xffff0000u); v1[2 * k] = __uint_as_float(d[k] << 16); v1[2 * k + 1] = __uint_as_float(d[k] & 0xffff0000u); }
    }
#pragma unroll 2
    for (int t = t0; t < t0 + RB; ++t) {
      const u32x4 a = *(const u32x4*)(H16 + (size_t)t * 2 * DFF + cg8), b = *(const u32x4*)(H16 + (size_t)t * 2 * DFF + DFF + cg8);
      float g2[8], v2[8], o[8];
#pragma unroll
      for (int k = 0; k < 4; ++k) { g2[2 * k] = __uint_as_float(a[k] << 16); g2[2 * k + 1] = __uint_as_float(a[k] & 0xffff0000u); v2[2 * k] = __uint_as_float(b[k] << 16); v2[2 * k + 1] = __uint_as_float(b[k] & 0xffff0000u); }
#pragma unroll
      for (int k = 0; k < 8; ++k) { const float gg = wg[0][k] * g0[k] + wg[1][k] * g1[k] + wg[2][k] * g2[k]; const float vv = wv[0][k] * v0[k] + wv[1][k] * v1[k] + wv[2][k] * v2[k];
        o[k] = siluf_(gg) * vv; g0[k] = g1[k]; g1[k] = g2[k]; v0[k] = v1[k]; v1[k] = v2[k]; }
      u32x4 ov; ov[0] = pack2(o[0], o[1]); ov[1] = pack2(o[2], o[3]); ov[2] = pack2(o[4], o[5]); ov[3] = pack2(o[6], o[7]);
      *(u32x4*)(G16 + (size_t)t * DFF + cg8) = ov;
    }
  }
}

__device__ void gla_logcum(const Params& p, int j, int h, int n, float* CUM, const float* H32) {
  const int tid = tid_();
  const float* w2 = p.gla_w_gate2 + (size_t)j * 16 * (GLA_H * 64); const float* bg = p.gla_b_gate + (size_t)j * GLA_H * 64;
  for (int e = tid; e < 4096; e += 512) {
    const int t = e >> 6, d = e & 63; const float* g = H32 + (size_t)(n * 64 + t) * EV_LD + EV_GLR; float x = bg[h * 64 + d];
#pragma unroll
    for (int r = 0; r < 16; ++r) x += g[r] * w2[r * (GLA_H * 64) + h * 64 + d];
    CUM[e] = (fminf(x, 0.f) - log1pf(__expf(-fabsf(x)))) * (1.f / 16.f);
  }
  __syncthreads();
  if (tid < 64) { float c = 0.f; for (int t = 0; t < 64; ++t) { c += CUM[t * 64 + tid]; CUM[t * 64 + tid] = c; } }
  __syncthreads();
}
__device__ void gla_kv_item(const Params& p, int j, int h, int n, char* smem) {
  const float* H32 = (const float*)(p.ws + OFF_H32); float* KVS = (float*)(p.ws + OFF_KVS); float* DEC = (float*)(p.ws + OFF_DEC);
  float* CUM = (float*)smem; float* KD = CUM + 4096; float* VS = KD + 4096;
  const int tid = tid_();
  gla_logcum(p, j, h, n, CUM, H32);
  for (int e = tid; e < 4096; e += 512) { const int t = e >> 6, d = e & 63; KD[e] = H32[(size_t)(n * 64 + t) * EV_LD + EV_GK + h * 64 + d] * __expf(CUM[63 * 64 + d] - CUM[e]); }
  for (int e = tid; e < 64 * 32; e += 512) { const int t = e >> 5, c4 = (e & 31) * 4; *(f32x4*)(VS + t * 128 + c4) = *(const f32x4*)(H32 + (size_t)(n * 64 + t) * EV_LD + EV_GV + h * 128 + c4); }
  __syncthreads();
  const int dg = tid >> 5, vg = tid & 31;
  f32x4 acc[4] = {f4zero(), f4zero(), f4zero(), f4zero()};
#pragma unroll 4
  for (int t = 0; t < 64; ++t) { const f32x4 k4 = *(const f32x4*)(KD + t * 64 + dg * 4), v4 = *(const f32x4*)(VS + t * 128 + vg * 4);
#pragma unroll
    for (int i = 0; i < 4; ++i) acc[i] += k4[i] * v4; }
#pragma unroll
  for (int i = 0; i < 4; ++i) *(f32x4*)(KVS + ((size_t)(h * NCH + n) * 64 + dg * 4 + i) * 128 + vg * 4) = acc[i];
  if (tid < 64) DEC[(size_t)(h * NCH + n) * 64 + tid] = __expf(CUM[63 * 64 + tid]);
  __syncthreads();
}
__device__ void gla_scan(const Params& p, int bid, int nb) {
  float* KVS = (float*)(p.ws + OFF_KVS); const float* DEC = (const float*)(p.ws + OFF_DEC);
  for (int e = bid * 512 + tid_(); e < GLA_H * 64 * 128; e += nb * 512) {
    const int h = e / (64 * 128), d = (e >> 7) & 63, v = e & 127; float s = 0.f;
#pragma unroll 8
    for (int n = 0; n < NCH; ++n) { float* q = KVS + ((size_t)(h * NCH + n) * 64 + d) * 128 + v; const float kv = *q; const float dc = DEC[(size_t)(h * NCH + n) * 64 + d]; *q = s; s = s * dc + kv; }
  }
}
__device__ void gla_out_item(const Params& p, int j, int h, int n, char* smem) {
  constexpr int QP = 68;
  const float* H32 = (const float*)(p.ws + OFF_H32); const float* SP = (const float*)(p.ws + OFF_KVS) + (size_t)(h * NCH + n) * 64 * 128; bf16_t* CAT = (bf16_t*)(p.ws + OFF_CAT);
  float* CUM = (float*)smem; float* QE = CUM + 4096; float* QEt = QE + 64 * QP; float* KE = QEt + 64 * QP; float* ATt = KE + 64 * QP; float* VS = ATt + 64 * QP;
  const int tid = tid_();
  gla_logcum(p, j, h, n, CUM, H32);
  for (int e = tid; e < 4096; e += 512) { const int t = e >> 6, d = e & 63; const float* hr = H32 + (size_t)(n * 64 + t) * EV_LD; const float c = CUM[e];
    const float qe = hr[EV_GQ + h * 64 + d] * 0.125f * __expf(c); QE[t * QP + d] = qe; QEt[d * QP + t] = qe; KE[t * QP + d] = hr[EV_GK + h * 64 + d] * __expf(-c); }
  for (int e = tid; e < 64 * 32; e += 512) { const int t = e >> 5, c4 = (e & 31) * 4; *(f32x4*)(VS + t * 128 + c4) = *(const f32x4*)(H32 + (size_t)(n * 64 + t) * EV_LD + EV_GV + h * 128 + c4); }
  __syncthreads();
  const int cg_ = tid >> 5, lg = tid & 31;
  { float a[4][2] = {{0.f, 0.f}, {0.f, 0.f}, {0.f, 0.f}, {0.f, 0.f}};
#pragma unroll 2
    for (int d4 = 0; d4 < 16; ++d4) { f32x4 k0 = *(const f32x4*)(KE + lg * QP + d4 * 4), k1 = *(const f32x4*)(KE + (lg + 32) * QP + d4 * 4);
#pragma unroll
      for (int i = 0; i < 4; ++i) { const f32x4 q = *(const f32x4*)(QE + (cg_ * 4 + i) * QP + d4 * 4); a[i][0] += q[0] * k0[0] + q[1] * k0[1] + q[2] * k0[2] + q[3] * k0[3]; a[i][1] += q[0] * k1[0] + q[1] * k1[1] + q[2] * k1[2] + q[3] * k1[3]; } }
#pragma unroll
    for (int i = 0; i < 4; ++i) { const int c = cg_ * 4 + i; ATt[lg * QP + c] = (c >= lg) ? a[i][0] : 0.f; ATt[(lg + 32) * QP + c] = (c >= lg + 32) ? a[i][1] : 0.f; } }
  __syncthreads();
  f32x4 acc[4] = {f4zero(), f4zero(), f4zero(), f4zero()};
#pragma unroll 4
  for (int s = 0; s < 64; ++s) { const f32x4 a4 = *(const f32x4*)(ATt + s * QP + cg_ * 4), v4 = *(const f32x4*)(VS + s * 128 + lg * 4);
#pragma unroll
    for (int i = 0; i < 4; ++i) acc[i] += a4[i] * v4; }
#pragma unroll 4
  for (int d = 0; d < 64; ++d) { const f32x4 q4 = *(const f32x4*)(QEt + d * QP + cg_ * 4), s4 = *(const f32x4*)(SP + d * 128 + lg * 4);
#pragma unroll
    for (int i = 0; i < 4; ++i) acc[i] += q4[i] * s4; }
  const f32x4 ng = *(const f32x4*)(p.gla_norm_g + (size_t)j * 128 + lg * 4);
#pragma unroll
  for (int i = 0; i < 4; ++i) {
    float ss = acc[i][0] * acc[i][0] + acc[i][1] * acc[i][1] + acc[i][2] * acc[i][2] + acc[i][3] * acc[i][3];
    ss += __shfl_xor(ss, 1); ss += __shfl_xor(ss, 2); ss += __shfl_xor(ss, 4); ss += __shfl_xor(ss, 8); ss += __shfl_xor(ss, 16);
    const float r = rsqrtf(ss * (1.f / 128.f) + 1e-6f); const int t = n * 64 + cg_ * 4 + i;
    const f32x4 gr = *(const f32x4*)(H32 + (size_t)t * EV_LD + EV_GR + h * 128 + lg * 4);
    const f32x4 o = acc[i] * r * ng;
    *(u32x2*)(CAT + (size_t)t * EVEN_OUT + h * 128 + lg * 4) = (u32x2){pack2(o[0] * siluf_(gr[0]), o[1] * siluf_(gr[1])), pack2(o[2] * siluf_(gr[2]), o[3] * siluf_(gr[3]))};
  }
  __syncthreads();
}

__device__ void moba_kmean_item(const Params& p, int h, int blk, char* smem) {
  const bf16_t* MK = (const bf16_t*)(p.ws + OFF_MK); float* KM = (float*)(p.ws + OFF_KMEAN); float* PART = (float*)smem;
  const int tid = tid_(), d = tid & 127, part = tid >> 7; float s = 0.f;
  for (int k = 0; k < 64; ++k) s += bf2f(MK[(size_t)(blk * 256 + part * 64 + k) * MQ_LD + h * 128 + d]);
  PART[tid] = s; __syncthreads();
  if (tid < 128) KM[(size_t)(h * NBLK + blk) * 128 + tid] = (PART[tid] + PART[128 + tid] + PART[256 + tid] + PART[384 + tid]) * (1.f / 256.f);
  __syncthreads();
}
struct Top3 { float v0, v1, v2; int i0, i1, i2; };
__device__ __forceinline__ bool top_better(float v, int i, float w, int j) { return v > w || (v == w && i < j); }
__device__ __forceinline__ Top3 top_ins(Top3 t, float v, int i) {
  const bool b0 = top_better(v, i, t.v0, t.i0), b1 = top_better(v, i, t.v1, t.i1), b2 = top_better(v, i, t.v2, t.i2);
  Top3 r;
  r.v2 = b1 ? t.v1 : (b2 ? v : t.v2); r.i2 = b1 ? t.i1 : (b2 ? i : t.i2);
  r.v1 = b0 ? t.v0 : (b1 ? v : t.v1); r.i1 = b0 ? t.i0 : (b1 ? i : t.i1);
  r.v0 = b0 ? v : t.v0; r.i0 = b0 ? i : t.i0;
  return r;
}
__device__ void moba_item(const Params& p, int h, int qc, char* smem) {
  constexpr int PB = 272;
  constexpr float NEG = -1e30f;
  const bf16_t* MQ = (const bf16_t*)(p.ws + OFF_MQ); const bf16_t* MK = (const bf16_t*)(p.ws + OFF_MK); const bf16_t* MVT = (const bf16_t*)(p.ws + OFF_MVT);
  const float* KM = (const float*)(p.ws + OFF_KMEAN); bf16_t* CAT = (bf16_t*)(p.ws + OFF_CAT);
  char* Qs = smem; char* Ks = Qs + 64 * PB; char* VTs = Ks + 128 * PB; unsigned* SEL = (unsigned*)(VTs + 128 * PB);
  float* MRG = (float*)Ks;
  const int tid = tid_(), w = tid >> 6, lane = tid & 63, fr = lane & 15, fq = lane >> 4, wq = w & 3, wh = w >> 2;
  const int t0 = qc * 64, own = t0 >> 8;
  const float slope = exp2f(-8.f * (float)(h + 1) / (float)MOBA_H), scale = 0.08838834764831845f;
  for (int e = tid; e < 64 * 16; e += 512) { const int r = e >> 4, c = e & 15; *(u32x4*)(Qs + r * PB + c * 16) = *(const u32x4*)(MQ + (size_t)(t0 + r) * MQ_LD + h * 128 + c * 8); }
  __syncthreads();
  { const int q = tid >> 3, part = tid & 7; Top3 tp; tp.v0 = tp.v1 = tp.v2 = -INFINITY; tp.i0 = tp.i1 = tp.i2 = 1 << 20;
    for (int nb_ = part; nb_ < own; nb_ += 8) { const float* km = KM + (size_t)(h * NBLK + nb_) * 128; float s = 0.f;
#pragma unroll 2
      for (int c = 0; c < 16; ++c) { const u32x4 qq = *(const u32x4*)(Qs + q * PB + c * 16); const f32x4 ka = *(const f32x4*)(km + c * 8), kb = *(const f32x4*)(km + c * 8 + 4);
        s += __uint_as_float(qq[0] << 16) * ka[0] + __uint_as_float(qq[0] & 0xffff0000u) * ka[1] + __uint_as_float(qq[1] << 16) * ka[2] + __uint_as_float(qq[1] & 0xffff0000u) * ka[3]
           + __uint_as_float(qq[2] << 16) * kb[0] + __uint_as_float(qq[2] & 0xffff0000u) * kb[1] + __uint_as_float(qq[3] << 16) * kb[2] + __uint_as_float(qq[3] & 0xffff0000u) * kb[3]; }
      tp = top_ins(tp, s, nb_); }
#pragma unroll
    for (int m = 1; m < 8; m <<= 1) { const float a0 = __shfl_xor(tp.v0, m), a1 = __shfl_xor(tp.v1, m), a2 = __shfl_xor(tp.v2, m); const int b0 = __shfl_xor(tp.i0, m), b1 = __shfl_xor(tp.i1, m), b2 = __shfl_xor(tp.i2, m);
      tp = top_ins(tp, a0, b0); tp = top_ins(tp, a1, b1); tp = top_ins(tp, a2, b2); }
    if (part == 0) { unsigned mk = 0; if (tp.i0 < 32) mk |= 1u << tp.i0; if (tp.i1 < 32) mk |= 1u << tp.i1; if (tp.i2 < 32) mk |= 1u << tp.i2; SEL[q] = mk; } }
  __syncthreads();
  unsigned um = 0; for (int q = 0; q < 64; ++q) um |= SEL[q];
  const unsigned mysel = SEL[wq * 16 + fr];
  bf16x8 qf[4];
#pragma unroll
  for (int kk = 0; kk < 4; ++kk) qf[kk] = *(const bf16x8*)(Qs + (wq * 16 + fr) * PB + kk * 64 + fq * 16);
  f32x4 oacc[8];
#pragma unroll
  for (int i = 0; i < 8; ++i) oacc[i] = f4zero();
  float mrow = NEG, lrow = 0.f;
  const int tq = t0 + wq * 16 + fr;
#pragma unroll 1
  for (int bi = -1; bi < own; ++bi) {
    const int b = (bi < 0) ? own : bi;
    if (bi >= 0 && !((um >> b) & 1u)) continue;
#pragma unroll 1
    for (int sb = 0; sb < 2; ++sb) {
      const int key0 = b * 256 + sb * 128;
      if (bi < 0 && key0 > t0 + 63) continue;
      __syncthreads();
      for (int e = tid; e < 128 * 16; e += 512) { const int r = e >> 4, c = e & 15;
        *(u32x4*)(Ks + r * PB + c * 16) = *(const u32x4*)(MK + (size_t)(key0 + r) * MQ_LD + h * 128 + c * 8);
        *(u32x4*)(VTs + r * PB + c * 16) = *(const u32x4*)(MVT + (size_t)(h * 128 + r) * SEQ + key0 + c * 8); }
      __syncthreads();
      const int kb = wh * 64;
      f32x4 sacc[4];
#pragma unroll
      for (int nt = 0; nt < 4; ++nt) { sacc[nt] = f4zero();
#pragma unroll
        for (int kk = 0; kk < 4; ++kk) { const bf16x8 kf = *(const bf16x8*)(Ks + (kb + nt * 16 + fr) * PB + kk * 64 + fq * 16); sacc[nt] = __builtin_amdgcn_mfma_f32_16x16x32_bf16(kf, qf[kk], sacc[nt], 0, 0, 0); } }
      float mx = NEG;
#pragma unroll
      for (int nt = 0; nt < 4; ++nt)
#pragma unroll
        for (int jj = 0; jj < 4; ++jj) { const int tk = key0 + kb + nt * 16 + fq * 4 + jj; float s = sacc[nt][jj] * scale - slope * (float)(tq - tk);
          const bool ok = (bi < 0) ? (tk <= tq) : (((mysel >> b) & 1u) != 0u); s = ok ? s : NEG; sacc[nt][jj] = s; mx = fmaxf(mx, s); }
      mx = fmaxf(mx, __shfl_xor(mx, 16)); mx = fmaxf(mx, __shfl_xor(mx, 32));
      const float mnew = fmaxf(mrow, mx), alpha = __expf(mrow - mnew); mrow = mnew;
      float ps = 0.f;
#pragma unroll
      for (int nt = 0; nt < 4; ++nt)
#pragma unroll
        for (int jj = 0; jj < 4; ++jj) { const float pv = __expf(sacc[nt][jj] - mnew); sacc[nt][jj] = pv; ps += pv; }
      lrow = lrow * alpha + ps;
#pragma unroll
      for (int i = 0; i < 8; ++i) oacc[i] *= alpha;
#pragma unroll
      for (int k2 = 0; k2 < 2; ++k2) {
        u32x4 pk; pk[0] = pack2(sacc[2 * k2][0], sacc[2 * k2][1]); pk[1] = pack2(sacc[2 * k2][2], sacc[2 * k2][3]); pk[2] = pack2(sacc[2 * k2 + 1][0], sacc[2 * k2 + 1][1]); pk[3] = pack2(sacc[2 * k2 + 1][2], sacc[2 * k2 + 1][3]);
        bf16x8 pb; __builtin_memcpy(&pb, &pk, 16);
#pragma unroll
        for (int dt = 0; dt < 8; ++dt) {
          const char* vr = VTs + (dt * 16 + fr) * PB + (kb + 32 * k2 + fq * 4) * 2;
          const u32x2 lo = *(const u32x2*)vr, hi = *(const u32x2*)(vr + 32);
          u32x4 vv; vv[0] = lo[0]; vv[1] = lo[1]; vv[2] = hi[0]; vv[3] = hi[1]; bf16x8 vf; __builtin_memcpy(&vf, &vv, 16);
          oacc[dt] = __builtin_amdgcn_mfma_f32_16x16x32_bf16(vf, pb, oacc[dt], 0, 0, 0);
        }
      }
    }
  }
  lrow += __shfl_xor(lrow, 16); lrow += __shfl_xor(lrow, 32);
  __syncthreads();
  if (wh == 1) { float* mg = MRG + (size_t)wq * 34 * 64;
#pragma unroll
    for (int dt = 0; dt < 8; ++dt)
#pragma unroll
      for (int jj = 0; jj < 4; ++jj) mg[(dt * 4 + jj) * 64 + lane] = oacc[dt][jj];
    mg[32 * 64 + lane] = mrow; mg[33 * 64 + lane] = lrow; }
  __syncthreads();
  if (wh == 0) { const float* mg = MRG + (size_t)wq * 34 * 64; const float m2 = mg[32 * 64 + lane], l2 = mg[33 * 64 + lane];
    const float ms = fmaxf(mrow, m2), f1 = __expf(mrow - ms), f2 = __expf(m2 - ms); const float inv = 1.f / (lrow * f1 + l2 * f2);
#pragma unroll
    for (int dt = 0; dt < 8; ++dt) { float o[4];
#pragma unroll
      for (int jj = 0; jj < 4; ++jj) o[jj] = (oacc[dt][jj] * f1 + mg[(dt * 4 + jj) * 64 + lane] * f2) * inv;
      *(u32x2*)(CAT + (size_t)tq * EVEN_OUT + GLA_H * 128 + h * 128 + dt * 16 + fq * 4) = (u32x2){pack2(o[0], o[1]), pack2(o[2], o[3])}; } }
  __syncthreads();
}

__device__ void gdn_local_item(const Params& p, int j, int h, int n, char* smem) {
  constexpr int SP_ = 260, KP = 132;
  const float* H32 = (const float*)(p.ws + OFF_H32);
  float* SOL = (float*)smem; float* KS = SOL + 64 * SP_; float* LM = KS + 64 * KP; float* BETA = LM + 64 * 65; float* GG = BETA + 64; float* GC = GG + 64;
  const size_t base = (size_t)(h * NCH + n);
  float* Ug = (float*)(p.ws + OFF_GU) + base * 8192; float* Wg = (float*)(p.ws + OFF_GW) + base * 8192; float* QDg = (float*)(p.ws + OFF_GQD) + base * 8192; float* KDg = (float*)(p.ws + OFF_GKD) + base * 8192;
  float* ATg = (float*)(p.ws + OFF_ATT) + base * 4096; float* EGL = (float*)(p.ws + OFF_EGL);
  const int tid = tid_(), t0 = n * 64;
  { const int cs = tid & 31, rg = tid >> 5, c4 = cs * 4; const float* cwb = p.gdn_conv_w + (size_t)j * 4 * (3 * GDN_H * 128);
#pragma unroll
    for (int part = 0; part < 3; ++part) { const int col = part * GDN_H * 128 + h * 128 + c4; f32x4 wv[4], xv[7];
#pragma unroll
      for (int jj = 0; jj < 4; ++jj) wv[jj] = *(const f32x4*)(cwb + (size_t)jj * (3 * GDN_H * 128) + col);
#pragma unroll
      for (int r = 0; r < 7; ++r) { const int t = t0 + rg * 4 - 3 + r; xv[r] = (t >= 0) ? *(const f32x4*)(H32 + (size_t)t * OD_LD + OD_QKV + col) : f4zero(); }
#pragma unroll
      for (int i = 0; i < 4; ++i) { f32x4 o = wv[0] * xv[i] + wv[1] * xv[i + 1] + wv[2] * xv[i + 2] + wv[3] * xv[i + 3];
        o[0] = siluf_(o[0]); o[1] = siluf_(o[1]); o[2] = siluf_(o[2]); o[3] = siluf_(o[3]);
        float* dst = (part == 0) ? (SOL + (rg * 4 + i) * SP_ + 128 + c4) : (part == 1) ? (KS + (rg * 4 + i) * KP + c4) : (SOL + (rg * 4 + i) * SP_ + c4);
        *(f32x4*)dst = o; } } }
  if (tid < 64) { const int t = t0 + tid; BETA[tid] = sigmoidf_(H32[(size_t)t * OD_LD + OD_BETA + h]);
    GG[tid] = -expf(p.gdn_a_log[j * GDN_H + h]) * softplusf_(H32[(size_t)t * OD_LD + OD_DEC + h] + p.gdn_dt_bias[j * GDN_H + h]); }
  __syncthreads();
  const int row = tid >> 3, seg = tid & 7;
  { float* qp = SOL + row * SP_ + 128 + seg * 16; float* kp = KS + row * KP + seg * 16; float sq = 0.f, sk = 0.f;
#pragma unroll
    for (int c = 0; c < 16; ++c) { sq += qp[c] * qp[c]; sk += kp[c] * kp[c]; }
    sq += __shfl_xor(sq, 1); sk += __shfl_xor(sk, 1); sq += __shfl_xor(sq, 2); sk += __shfl_xor(sk, 2); sq += __shfl_xor(sq, 4); sk += __shfl_xor(sk, 4);
    const float rq = rsqrtf(sq + 1e-6f) * 0.08838834764831845f, rk = rsqrtf(sk + 1e-6f);
#pragma unroll
    for (int c = 0; c < 16; ++c) { qp[c] *= rq; kp[c] *= rk; } }
  if (tid == 0) { float c = 0.f; for (int t = 0; t < 64; ++t) { c += GG[t]; GC[t] = c; } }
  __syncthreads();
  { const int ig = tid >> 5, jg = tid & 31; float aL[4][2] = {{0.f, 0.f}, {0.f, 0.f}, {0.f, 0.f}, {0.f, 0.f}}, aA[4][2] = {{0.f, 0.f}, {0.f, 0.f}, {0.f, 0.f}, {0.f, 0.f}};
#pragma unroll 2
    for (int d4 = 0; d4 < 32; ++d4) { const f32x4 k0 = *(const f32x4*)(KS + jg * KP + d4 * 4), k1 = *(const f32x4*)(KS + (jg + 32) * KP + d4 * 4);
#pragma unroll
      for (int i = 0; i < 4; ++i) { const f32x4 ki = *(const f32x4*)(KS + (ig * 4 + i) * KP + d4 * 4), qi = *(const f32x4*)(SOL + (ig * 4 + i) * SP_ + 128 + d4 * 4);
        aL[i][0] += ki[0] * k0[0] + ki[1] * k0[1] + ki[2] * k0[2] + ki[3] * k0[3]; aL[i][1] += ki[0] * k1[0] + ki[1] * k1[1] + ki[2] * k1[2] + ki[3] * k1[3];
        aA[i][0] += qi[0] * k0[0] + qi[1] * k0[1] + qi[2] * k0[2] + qi[3] * k0[3]; aA[i][1] += qi[0] * k1[0] + qi[1] * k1[1] + qi[2] * k1[2] + qi[3] * k1[3]; } }
#pragma unroll
    for (int i = 0; i < 4; ++i)
#pragma unroll
      for (int jj = 0; jj < 2; ++jj) { const int ii = ig * 4 + i, jx = jg + 32 * jj; const float dec = (ii >= jx) ? __expf(GC[ii] - GC[jx]) : 0.f;
        LM[ii * 65 + jx] = (ii > jx) ? BETA[ii] * aL[i][jj] * dec : 0.f; ATg[ii * 64 + jx] = aA[i][jj] * dec; } }
  { const float eg = __expf(GC[row]), ek = __expf(GC[63] - GC[row]); const float* qp = SOL + row * SP_ + 128 + seg * 16; const float* kp = KS + row * KP + seg * 16;
#pragma unroll
    for (int c = 0; c < 16; c += 4) { const f32x4 q = *(const f32x4*)(qp + c), k = *(const f32x4*)(kp + c); *(f32x4*)(QDg + row * 128 + seg * 16 + c) = q * eg; *(f32x4*)(KDg + row * 128 + seg * 16 + c) = k * ek; } }
  __syncthreads();
  { const float bt = BETA[row], be = bt * __expf(GC[row]); float* vp = SOL + row * SP_ + seg * 16; float* wp = SOL + row * SP_ + 128 + seg * 16; const float* kp = KS + row * KP + seg * 16;
#pragma unroll
    for (int c = 0; c < 16; ++c) { vp[c] *= bt; wp[c] = kp[c] * be; } }
  __syncthreads();
  { const int col = tid >> 1, half = tid & 1;
#pragma unroll 1
    for (int i = 1; i < 64; ++i) { float part = 0.f; const float rhs = SOL[i * SP_ + col];
#pragma unroll 4
      for (int jx = half; jx < i; jx += 2) part += LM[i * 65 + jx] * SOL[jx * SP_ + col];
      const float tot = part + __shfl_xor(part, 1);
      SOL[i * SP_ + col] = rhs - tot; } }
  __syncthreads();
#pragma unroll
  for (int c = 0; c < 16; c += 4) { *(f32x4*)(Ug + row * 128 + seg * 16 + c) = *(const f32x4*)(SOL + row * SP_ + seg * 16 + c); *(f32x4*)(Wg + row * 128 + seg * 16 + c) = *(const f32x4*)(SOL + row * SP_ + 128 + seg * 16 + c); }
  if (tid == 0) EGL[base] = __expf(GC[63]);
  __syncthreads();
}
__device__ void gdn_scan_item(const Params& p, int h, int sl, char* smem) {
  f32x4* SST = (f32x4*)smem; f32x4* VN = SST + 128; f32x4* PART = VN + 64;
  const float* EGL = (const float*)(p.ws + OFF_EGL); float* O32 = (float*)(p.ws + OFF_O32);
  const int tid = tid_(), c = tid >> 3, dp = tid & 7, j0 = sl * 4, d = tid & 127, cp = tid >> 7;
  if (tid < 128) SST[tid] = f4zero();
  __syncthreads();
#pragma unroll 1
  for (int n = 0; n < NCH; ++n) {
    const size_t base = (size_t)(h * NCH + n);
    const float* Un = (const float*)(p.ws + OFF_GU) + base * 8192; const float* Wn = (const float*)(p.ws + OFF_GW) + base * 8192; const float* QDn = (const float*)(p.ws + OFF_GQD) + base * 8192;
    const float* KDn = (const float*)(p.ws + OFF_GKD) + base * 8192; const float* ATn = (const float*)(p.ws + OFF_ATT) + base * 4096; const float egl = EGL[base];
    f32x4 a = f4zero(), o = f4zero();
#pragma unroll
    for (int q4 = 0; q4 < 4; ++q4) { const f32x4 w4 = *(const f32x4*)(Wn + c * 128 + dp * 16 + q4 * 4), qd4 = *(const f32x4*)(QDn + c * 128 + dp * 16 + q4 * 4);
#pragma unroll
      for (int e = 0; e < 4; ++e) { const f32x4 s = SST[dp * 16 + q4 * 4 + e]; a += w4[e] * s; o += qd4[e] * s; } }
    a += shfl_xor4(a, 1); a += shfl_xor4(a, 2); a += shfl_xor4(a, 4);
    if (dp == 0) VN[c] = *(const f32x4*)(Un + c * 128 + j0) - a;
    __syncthreads();
#pragma unroll
    for (int q4 = 0; q4 < 2; ++q4) { const f32x4 at4 = *(const f32x4*)(ATn + c * 64 + dp * 8 + q4 * 4);
#pragma unroll
      for (int e = 0; e < 4; ++e) o += at4[e] * VN[dp * 8 + q4 * 4 + e]; }
    o += shfl_xor4(o, 1); o += shfl_xor4(o, 2); o += shfl_xor4(o, 4);
    if (dp == 0) *(f32x4*)(O32 + (size_t)(n * 64 + c) * (GDN_H * 128) + h * 128 + j0) = o;
    f32x4 pt = f4zero();
#pragma unroll
    for (int cc = 0; cc < 16; ++cc) pt += KDn[(cp * 16 + cc) * 128 + d] * VN[cp * 16 + cc];
    PART[cp * 128 + d] = pt;
    __syncthreads();
    if (tid < 128) SST[tid] = SST[tid] * egl + PART[tid] + PART[128 + tid] + PART[256 + tid] + PART[384 + tid];
    __syncthreads();
  }
}
__device__ void gdn_final(const Params& p, int j, int bid, int nb) {
  const float* H32 = (const float*)(p.ws + OFF_H32); const float* O32 = (const float*)(p.ws + OFF_O32); bf16_t* CAT = (bf16_t*)(p.ws + OFF_CAT);
  const int grp = tid_() >> 5, l = tid_() & 31;
  const f32x4 ng = *(const f32x4*)(p.gdn_norm_g + (size_t)j * 128 + l * 4);
  for (int it = bid * 16 + grp; it < SEQ * GDN_H; it += nb * 16) {
    const int t = it / GDN_H, h = it % GDN_H;
    const f32x4 o = *(const f32x4*)(O32 + (size_t)t * (GDN_H * 128) + h * 128 + l * 4), z = *(const f32x4*)(H32 + (size_t)t * OD_LD + OD_Z + h * 128 + l * 4);
    float ss = o[0] * o[0] + o[1] * o[1] + o[2] * o[2] + o[3] * o[3];
    ss += __shfl_xor(ss, 1); ss += __shfl_xor(ss, 2); ss += __shfl_xor(ss, 4); ss += __shfl_xor(ss, 8); ss += __shfl_xor(ss, 16);
    const float r = rsqrtf(ss * (1.f / 128.f) + 1e-6f); const f32x4 v = o * r * ng;
    *(u32x2*)(CAT + (size_t)t * ODD_OUT + h * 128 + l * 4) = (u32x2){pack2(v[0] * siluf_(z[0]), v[1] * siluf_(z[1])), pack2(v[2] * siluf_(z[2]), v[3] * siluf_(z[3]))};
  }
}

template <bool OUT> __device__ void s5_item(const Params& p, int j, int g, int oct, char* smem) {
  constexpr int XP = 65;
  const float* H32 = (const float*)(p.ws + OFF_H32); const float* C = (const float*)(p.ws + OFF_S5C + j * SZ_S5C1); f32x2* XEND = (f32x2*)(p.ws + OFF_XEND); bf16_t* YS = (bf16_t*)(p.ws + OFF_YS);
  float* CRE = (float*)smem; float* CIM = CRE + 1024; f32x2* XS = (f32x2*)(CIM + 1024);
  const int tid = tid_(), w = tid >> 6, lane = tid & 63, n = oct * 8 + w, gp = g * S5_P + lane;
  if (OUT) { for (int e = tid; e < 1024; e += 512) { const int pp = e & 63, c = e >> 6; CRE[pp * 16 + c] = p.s5_c_re[(((size_t)j * S5_G + g) * 16 + c) * 64 + pp]; CIM[pp * 16 + c] = p.s5_c_im[(((size_t)j * S5_G + g) * 16 + c) * 64 + pp]; } }
  const float ar = C[gp], ai = C[S5_G * S5_P + gp];
  float bbr[16], bbi[16];
#pragma unroll
  for (int c = 0; c < 16; c += 4) { const f32x4 a = *(const f32x4*)(C + 4 * S5_G * S5_P + (size_t)gp * 16 + c), b = *(const f32x4*)(C + 20 * S5_G * S5_P + (size_t)gp * 16 + c);
    bbr[c] = a[0]; bbr[c + 1] = a[1]; bbr[c + 2] = a[2]; bbr[c + 3] = a[3]; bbi[c] = b[0]; bbi[c + 1] = b[1]; bbi[c + 2] = b[2]; bbi[c + 3] = b[3]; }
  float xr = 0.f, xi = 0.f;
  if (OUT) { const float a64r = C[2 * S5_G * S5_P + gp], a64i = C[3 * S5_G * S5_P + gp];
#pragma unroll 4
    for (int m = 0; m < n; ++m) { const f32x2 xe = XEND[(size_t)(m * S5_G + g) * S5_P + lane]; const float nr = a64r * xr - a64i * xi + xe[0], ni = a64r * xi + a64i * xr + xe[1]; xr = nr; xi = ni; } }
#pragma unroll 1
  for (int slab = 0; slab < 4; ++slab) {
#pragma unroll 2
    for (int tt = 0; tt < 16; ++tt) {
      const int t = n * 64 + slab * 16 + tt; const float* up = H32 + (size_t)t * OD_LD + OD_U + g * 16; float br = 0.f, bi = 0.f;
#pragma unroll
      for (int c = 0; c < 16; c += 4) { const f32x4 u4 = *(const f32x4*)(up + c);
#pragma unroll
        for (int e = 0; e < 4; ++e) { br += bbr[c + e] * u4[e]; bi += bbi[c + e] * u4[e]; } }
      const float nr = ar * xr - ai * xi + br, ni = ar * xi + ai * xr + bi; xr = nr; xi = ni;
      if (OUT) XS[(w * 16 + tt) * XP + lane] = (f32x2){xr, xi};
    }
    if (OUT) {
      __syncthreads();
      const int tt = lane >> 2, cq = lane & 3; f32x4 y = f4zero();
#pragma unroll 4
      for (int pp = 0; pp < 64; ++pp) { const f32x2 xv = XS[(w * 16 + tt) * XP + pp]; const f32x4 cr = *(const f32x4*)(CRE + pp * 16 + cq * 4), ci = *(const f32x4*)(CIM + pp * 16 + cq * 4); y += cr * xv[0] - ci * xv[1]; }
      const int t = n * 64 + slab * 16 + tt;
      const f32x4 u4 = *(const f32x4*)(H32 + (size_t)t * OD_LD + OD_U + g * 16 + cq * 4), d4 = *(const f32x4*)(p.s5_d + ((size_t)j * S5_G + g) * 16 + cq * 4);
      y += d4 * u4;
      *(u32x2*)(YS + (size_t)t * S5_CH + g * 16 + cq * 4) = (u32x2){pack2(geluf_(y[0]), geluf_(y[1])), pack2(geluf_(y[2]), geluf_(y[3]))};
      __syncthreads();
    }
  }
  if (!OUT) XEND[(size_t)(n * S5_G + g) * S5_P + lane] = (f32x2){xr, xi};
}

__device__ bool run_step(const Params& p, int step, char* smem, int bid, int nb) {
  LAUNDER_S(bid); LAUNDER_S(nb);
  char* ws = p.ws;
  if (step == 0) { step_prep(p, smem, bid, nb); return true; }
  const int L = (step - 1) / STEPS_PER_LAYER, s = (step - 1) % STEPS_PER_LAYER, j = L >> 1; const bool even = (L & 1) == 0;
  bf16_t* XB = (bf16_t*)(ws + OFF_XB); float* X32 = (float*)(ws + OFF_X32); float* Y32 = (float*)(ws + OFF_Y32); float* H32 = (float*)(ws + OFF_H32); bf16_t* CAT = (bf16_t*)(ws + OFF_CAT);
  float* stats_mix = (float*)(ws + OFF_STATS) + (size_t)(L * 2) * SEQ * 2; float* stats_ffn = stats_mix + (size_t)SEQ * 2;
  switch (s) {
    case 0:
      if (even) { EpiEvenIn E{H32, (bf16_t*)(ws + OFF_MQ), (bf16_t*)(ws + OFF_MK), (bf16_t*)(ws + OFF_MVT)}; run_gemm(smem, XB, (const bf16_t*)(ws + OFF_WINE + j * SZ_WINE), EVEN_NP, DM, E, bid, nb); }
      else { EpiOddIn E{H32}; run_gemm(smem, XB, (const bf16_t*)(ws + OFF_WINO + j * SZ_WINO), ODD_NP, DM, E, bid, nb); }
      return true;
    case 1:
      if (even) {
        for (int it = bid; it < GLA_H * NCH; it += nb) gla_kv_item(p, j, it % GLA_H, it / GLA_H, smem);
        for (int it = bid; it < MOBA_H * NBLK; it += nb) moba_kmean_item(p, it % MOBA_H, it / MOBA_H, smem);
      } else {
        for (int it = bid; it < GDN_H * NCH; it += nb) gdn_local_item(p, j, it % GDN_H, it / GDN_H, smem);
        for (int it = bid; it < S5_G * (NCH / 8); it += nb) { s5_item<false>(p, j, it % S5_G, it / S5_G, smem); }
      }
      return true;
    case 2:
      if (even) {
        gla_scan(p, bid, nb);
        for (int it = nb - 1 - bid; it < MOBA_H * NCH; it += nb) moba_item(p, it % MOBA_H, NCH - 1 - it / MOBA_H, smem);
      } else {
        for (int it = bid; it < GDN_H * 32; it += nb) gdn_scan_item(p, it / 32, it % 32, smem);
      }
      return true;
    case 3:
      if (even) { for (int it = bid; it < GLA_H * NCH; it += nb) gla_out_item(p, j, it % GLA_H, it / GLA_H, smem); }
      else {
        for (int it = bid; it < S5_G * (NCH / 8); it += nb) { s5_item<true>(p, j, it % S5_G, it / S5_G, smem); __syncthreads(); }
        gdn_final(p, j, bid, nb);
      }
      return true;
    case 4:
      if (even) return false;
      { EpiGlu E{(const bf16_t*)(ws + OFF_YS), p.s5_glu_b + (size_t)j * S5_CH, CAT}; run_gemm(smem, (const bf16_t*)(ws + OFF_YS), (const bf16_t*)(ws + OFF_WGLU + j * SZ_WGLU), S5_CH, S5_CH, E, bid, nb); }
      return true;
    case 5: {
      EpiRes E{L == 0 ? p.x : X32, Y32, stats_mix};
      if (even) run_gemm(smem, CAT, (const bf16_t*)(ws + OFF_WOUTE + j * SZ_WOUTE), DM, EVEN_OUT, E, bid, nb);
      else run_gemm(smem, CAT, (const bf16_t*)(ws + OFF_WOUTO + j * SZ_WOUTO), DM, ODD_OUT, E, bid, nb);
      return true; }
    case 6: step_ln(Y32, stats_mix, p.ln_mix_g + (size_t)L * DM, p.ln_mix_b + (size_t)L * DM, X32, XB, bid, nb); return true;
    case 7: { EpiBf16 E{(bf16_t*)(ws + OFF_H16), 2 * DFF}; run_gemm(smem, XB, (const bf16_t*)(ws + OFF_WUP + L * SZ_WUP), 2 * DFF, DM, E, bid, nb); return true; }
    case 8: step_ffn_conv((const bf16_t*)(ws + OFF_H16), p.ffn_conv_w + (size_t)L * 3 * 2 * DFF, (bf16_t*)(ws + OFF_G16), bid, nb); return true;
    case 9: { EpiRes E{X32, Y32, stats_ffn}; run_gemm(smem, (const bf16_t*)(ws + OFF_G16), (const bf16_t*)(ws + OFF_WDN + L * SZ_WDN), DM, DFF, E, bid, nb); return true; }
    case 10: step_ln(Y32, stats_ffn, p.ln_ffn_g + (size_t)L * DM, p.ln_ffn_b + (size_t)L * DM, (L == DEPTH - 1) ? p.out : X32, XB, bid, nb); return true;
  }
  return false;
}

#ifndef EMU
typedef __attribute__((address_space(4))) const Params* KParamsPtr;
__global__ void __launch_bounds__(512, 2) hybrid_megakernel(Params p_unused) {
  extern __shared__ __attribute__((aligned(16))) char smem[];
  cg::grid_group grid = cg::this_grid();
  const int bid = blockIdx.x, nb = gridDim.x;
  KParamsPtr q0 = (KParamsPtr)__builtin_amdgcn_kernarg_segment_ptr();
  const int sb = q0->step_begin, se = q0->step_end;
  for (int s = sb; s < se; ++s) {
    KParamsPtr q = q0; asm volatile("" : "+s"(q));
    Params lp; __builtin_memcpy(&lp, q, sizeof(Params));
    const bool did = run_step(lp, s, smem, bid, nb);
    if (did && s + 1 < se) grid.sync();
  }
}

extern "C" void kernel_launch(void* const* d_in, const int* in_sizes, int n_in, void* d_out, int out_size, void* d_ws, size_t ws_size, hipStream_t stream) {
  static int grid_blocks = 0;
  if (!grid_blocks) {
    int dev = 0, cus = 0, per_cu = 0;
    hipGetDevice(&dev);
    hipDeviceGetAttribute(&cus, hipDeviceAttributeMultiprocessorCount, dev);
    hipFuncSetAttribute((const void*)hybrid_megakernel, hipFuncAttributeMaxDynamicSharedMemorySize, LDS_BYTES);
    hipOccupancyMaxActiveBlocksPerMultiprocessor(&per_cu, hybrid_megakernel, 512, LDS_BYTES);
    if (per_cu < 1) per_cu = 1;
    if (per_cu > 1) per_cu = 1;
    grid_blocks = cus * per_cu;
  }
  if (ws_size < WS_NEEDED) { fprintf(stderr, "workspace too small: %zu < %zu\n", ws_size, (size_t)WS_NEEDED); return; }
  Params p{};
  const float** pp = (const float**)&p;
  for (int i = 0; i < 29; ++i) pp[i] = (const float*)d_in[i];
  p.out = (float*)d_out; p.ws = (char*)d_ws; p.step_begin = 0; p.step_end = N_STEPS;
  void* args[] = {&p};
  hipError_t e = hipLaunchCooperativeKernel((const void*)hybrid_megakernel, dim3(grid_blocks), dim3(512), args, LDS_BYTES, stream);
  if (e != hipSuccess) fprintf(stderr, "cooperative launch failed: %s (grid %d)\n", hipGetErrorString(e), grid_blocks);
}
#endif
```

```cpp
#ifdef EMU
#include "emu.h"
#else
#include <hip/hip_runtime.h>
#include <hip/hip_cooperative_groups.h>
#include <cstdio>
namespace cg = cooperative_groups;
#endif

typedef unsigned short bf16_t;
typedef short bf16x8 __attribute__((ext_vector_type(8)));
typedef float f32x4 __attribute__((ext_vector_type(4)));
typedef float f32x2 __attribute__((ext_vector_type(2)));
typedef unsigned u32x4 __attribute__((ext_vector_type(4)));
typedef unsigned u32x2 __attribute__((ext_vector_type(2)));

#ifdef EMU_SMALL
constexpr int SEQ = EMU_SEQ, DM = 256, DEPTH = 2, GLA_H = 2, MOBA_H = 2, GDN_H = 2, S5_CH = 256, DFF = 512;
constexpr float ALPHA = 1.4142135623730951f;
#else
constexpr int SEQ = 8192, DM = 2048, DEPTH = 4, GLA_H = 8, MOBA_H = 8, GDN_H = 8, S5_CH = 1024, DFF = 5632;
constexpr float ALPHA = 1.681792830507429f;
#endif
constexpr int N_EVEN = (DEPTH + 1) / 2, N_ODD = DEPTH / 2;
constexpr int NCH = SEQ / 64, NBLK = SEQ / 256;
constexpr int S5_G = S5_CH / 16, S5_P = 64;
constexpr int EV_GQ = 0, EV_GK = GLA_H * 64, EV_GV = 2 * GLA_H * 64, EV_GLR = EV_GV + GLA_H * 128, EV_GR = EV_GLR + 16,
              EV_MQ = EV_GR + GLA_H * 128, EV_MK = EV_MQ + MOBA_H * 128, EV_MV = EV_MK + MOBA_H * 128, EVEN_IN = EV_MV + MOBA_H * 128;
constexpr int EV_LD = EV_MQ;
constexpr int OD_QKV = 0, OD_Z = 3 * GDN_H * 128, OD_BETA = OD_Z + GDN_H * 128, OD_DEC = OD_BETA + GDN_H, OD_U = OD_DEC + GDN_H, ODD_IN = OD_U + S5_CH;
constexpr int OD_LD = ODD_IN;
constexpr int EVEN_OUT = GLA_H * 128 + MOBA_H * 128, ODD_OUT = GDN_H * 128 + S5_CH;
constexpr int EVEN_NMAIN = EVEN_IN - 16;
static_assert(EVEN_NMAIN % 256 == 0, "even projection main part must tile by 256");
constexpr int EVEN_NP = EVEN_NMAIN + 256, ODD_NP = ((ODD_IN + 255) / 256) * 256;
constexpr int MQ_LD = MOBA_H * 128;
constexpr int STEPS_PER_LAYER = 11, N_STEPS = 1 + DEPTH * STEPS_PER_LAYER;
constexpr int LDS_BYTES = 143360;
#ifdef EMU
constexpr bool GLU_IN_WINDOW = false;
#else
constexpr bool GLU_IN_WINDOW = true;
#endif

constexpr size_t al256(size_t x) { return (x + 255) & ~(size_t)255; }
constexpr size_t cmax(size_t a, size_t b) { return a > b ? a : b; }
constexpr size_t SZ_WINE = al256((size_t)EVEN_NP * DM * 2), SZ_WOUTE = al256((size_t)DM * EVEN_OUT * 2), SZ_WINO = al256((size_t)ODD_NP * DM * 2),
                 SZ_WGLU = al256((size_t)S5_CH * S5_CH * 2), SZ_WOUTO = al256((size_t)DM * ODD_OUT * 2), SZ_WUP = al256((size_t)2 * DFF * DM * 2), SZ_WDN = al256((size_t)DM * DFF * 2);
constexpr size_t OFF_WINE = 0, OFF_WOUTE = OFF_WINE + N_EVEN * SZ_WINE, OFF_WINO = OFF_WOUTE + N_EVEN * SZ_WOUTE, OFF_WGLU = OFF_WINO + N_ODD * SZ_WINO,
                 OFF_WOUTO = OFF_WGLU + N_ODD * SZ_WGLU, OFF_WUP = OFF_WOUTO + N_ODD * SZ_WOUTO, OFF_WDN = OFF_WUP + DEPTH * SZ_WUP, OFF_ACT = OFF_WDN + DEPTH * SZ_WDN;
constexpr size_t SZ_XB = al256((size_t)SEQ * DM * 2), SZ_X32 = al256((size_t)SEQ * DM * 4), SZ_H32 = al256((size_t)SEQ * cmax(EV_LD, OD_LD) * 4),
                 SZ_CAT = al256((size_t)SEQ * cmax(EVEN_OUT, ODD_OUT) * 2), SZ_STATS = al256((size_t)DEPTH * 2 * SEQ * 2 * 4),
                 SZ_S5C1 = al256((size_t)36 * S5_G * S5_P * 4), SZ_KMEAN = al256((size_t)MOBA_H * NBLK * 128 * 4);
constexpr size_t OFF_BAR = OFF_ACT, SZ_BAR = 16384;
constexpr size_t OFF_XB = OFF_BAR + SZ_BAR, OFF_X32 = OFF_XB + SZ_XB, OFF_Y32 = OFF_X32 + SZ_X32, OFF_H32 = OFF_Y32 + SZ_X32, OFF_CAT = OFF_H32 + SZ_H32, OFF_STATS = OFF_CAT + SZ_CAT,
                 OFF_S5C = OFF_STATS + SZ_STATS, OFF_KMEAN = OFF_S5C + N_ODD * SZ_S5C1, OFF_SCR = OFF_KMEAN + SZ_KMEAN;
constexpr size_t SZ_H16 = al256((size_t)SEQ * 2 * DFF * 2), SZ_G16 = al256((size_t)SEQ * DFF * 2);
constexpr size_t OFF_H16 = OFF_SCR, OFF_G16 = OFF_H16 + SZ_H16, END_FFN = OFF_G16 + SZ_G16;
constexpr size_t SZ_MQ = al256((size_t)SEQ * MQ_LD * 2), SZ_KVS = al256((size_t)GLA_H * NCH * 64 * 128 * 4), SZ_DEC = al256((size_t)GLA_H * NCH * 64 * 4);
constexpr size_t OFF_MQ = OFF_SCR, OFF_MK = OFF_MQ + SZ_MQ, OFF_MVT = OFF_MK + SZ_MQ, OFF_KVS = OFF_MVT + SZ_MQ, OFF_DEC = OFF_KVS + SZ_KVS, OFF_SPV = OFF_DEC + SZ_DEC, OFF_MCNT = OFF_SPV + SZ_KVS, OFF_MLIST = OFF_MCNT + 4096, OFF_PO = OFF_MLIST + al256((size_t)MOBA_H * NBLK * SEQ * 4),
                 OFF_PML = OFF_PO + al256((size_t)MOBA_H * SEQ * 4 * 128 * 4), END_EVEN = OFF_PML + al256((size_t)MOBA_H * SEQ * 4 * 2 * 4);
constexpr size_t SZ_GD = al256((size_t)GDN_H * NCH * 64 * 128 * 4), SZ_ATT = al256((size_t)GDN_H * NCH * 64 * 64 * 4), SZ_EGL = al256((size_t)GDN_H * NCH * 4),
                 SZ_O32 = al256((size_t)SEQ * GDN_H * 128 * 4), SZ_XEND = al256((size_t)NCH * S5_G * S5_P * 2 * 4), SZ_YS = al256((size_t)SEQ * S5_CH * 2);
constexpr size_t OFF_GU_ = 0;
constexpr size_t OFF_GU = OFF_SCR, OFF_GW = OFF_GU + SZ_GD, OFF_GQD = OFF_GW + SZ_GD, OFF_GKD = OFF_GQD + SZ_GD, OFF_ATT = OFF_GKD + SZ_GD, OFF_EGL = OFF_ATT + SZ_ATT,
                 OFF_O32 = OFF_EGL + SZ_EGL, OFF_XEND = OFF_O32 + SZ_O32, OFF_YS = OFF_XEND + SZ_XEND, OFF_CARRY = OFF_YS + SZ_YS, END_ODD = OFF_CARRY + SZ_XEND;
constexpr size_t WS_NEEDED = cmax(END_FFN, cmax(END_EVEN, END_ODD));

struct Params {
  const float *x, *even_w_in, *gla_w_gate2, *gla_b_gate, *gla_norm_g, *even_w_out, *odd_w_in, *gdn_conv_w, *gdn_a_log, *gdn_dt_bias, *gdn_norm_g,
      *s5_a_re, *s5_a_im, *s5_b_re, *s5_b_im, *s5_c_re, *s5_c_im, *s5_d, *s5_log_step, *s5_glu_w, *s5_glu_b, *odd_w_out, *ln_mix_g, *ln_mix_b,
      *ffn_w_up, *ffn_conv_w, *ffn_w_down, *ln_ffn_g, *ln_ffn_b;
  float* out; char* ws; int step_begin, step_end;
};

#ifdef EMU
__device__ __forceinline__ int tid_() { return threadIdx.x; }
#define LAUNDER_S(x)
#define SCHED_FENCE()
#define LAUNDER_V(x)
#define DRAIN_VM()
__device__ __forceinline__ void lds_barrier() { __syncthreads(); }
#else
__device__ __forceinline__ void lds_barrier() { asm volatile("s_waitcnt lgkmcnt(0)\n\ts_barrier" ::: "memory"); }
__device__ __forceinline__ int tid_() { int t = threadIdx.x; asm volatile("" : "+v"(t)); return t; }
#define LAUNDER_S(x) asm volatile("" : "+s"(x))
#define DRAIN_VM() __builtin_amdgcn_s_waitcnt(0x0F70)
#define SCHED_FENCE() __builtin_amdgcn_sched_barrier(0)
#define LAUNDER_V(x) asm volatile("" : "+v"(x))
#endif

__device__ __forceinline__ bf16_t f2bf(float f) { unsigned u = __float_as_uint(f); u += 0x7FFFu + ((u >> 16) & 1u); return (bf16_t)(u >> 16); }
__device__ __forceinline__ float bf2f(bf16_t b) { return __uint_as_float(((unsigned)b) << 16); }
#ifdef EMU
__device__ __forceinline__ unsigned pack2(float lo, float hi) { return (unsigned)f2bf(lo) | ((unsigned)f2bf(hi) << 16); }
#else
typedef __bf16 bf16v2_t __attribute__((ext_vector_type(2)));
__device__ __forceinline__ unsigned pack2(float lo, float hi) { const bf16v2_t v = __builtin_convertvector((f32x2){lo, hi}, bf16v2_t); return __builtin_bit_cast(unsigned, v); }
#endif
__device__ __forceinline__ float sigmoidf_(float x) { return 1.f / (1.f + __expf(-x)); }
__device__ __forceinline__ float siluf_(float x) { return x / (1.f + __expf(-x)); }
__device__ __forceinline__ float softplusf_(float x) { return fmaxf(x, 0.f) + log1pf(__expf(-fabsf(x))); }
__device__ __forceinline__ float geluf_(float x) { float u = 0.7978845608028654f * (x + 0.044715f * x * x * x); float e = __expf(2.f * u); float th = 1.f - 2.f / (e + 1.f); return 0.5f * x * (1.f + th); }
__device__ __forceinline__ f32x4 shfl_xor4(f32x4 v, int m) {
#ifdef EMU
  return __shfl_xor(v, m);
#else
  f32x4 r; r[0] = __shfl_xor(v[0], m); r[1] = __shfl_xor(v[1], m); r[2] = __shfl_xor(v[2], m); r[3] = __shfl_xor(v[3], m); return r;
#endif
}
__device__ __forceinline__ f32x4 f4zero() { return (f32x4){0.f, 0.f, 0.f, 0.f}; }
template <int CTRL> __device__ __forceinline__ float dpp_mov(float v) {
#ifdef EMU
  const int l = tid_() & 63; const int src = (CTRL == 0xB1) ? (l ^ 1) : (CTRL == 0x4E) ? (l ^ 2) : ((l & ~7) | (7 - (l & 7)));
  return __shfl(v, src);
#else
  return __builtin_bit_cast(float, __builtin_amdgcn_update_dpp(0, __builtin_bit_cast(int, v), CTRL, 0xF, 0xF, true));
#endif
}
__device__ __forceinline__ f32x4 red4_f4(f32x4 v) {
#pragma unroll
  for (int e = 0; e < 4; ++e) { v[e] += dpp_mov<0xB1>(v[e]); v[e] += dpp_mov<0x4E>(v[e]); }
  return v;
}
__device__ __forceinline__ f32x4 red8_f4(f32x4 v) {
#pragma unroll
  for (int e = 0; e < 4; ++e) { v[e] += dpp_mov<0xB1>(v[e]); v[e] += dpp_mov<0x4E>(v[e]); v[e] += dpp_mov<0x141>(v[e]); }
  return v;
}

namespace pg8 {
constexpr int BM = 256, BK = 64, HALF = 128, HTB = HALF * BK * 2, STAGE_BYTES = 8 * HTB, NXCD = 8, WGM = 8;
__host__ __device__ __forceinline__ int lds_byte(int r, int c) { const int st = (r >> 4) * 2 + (c >> 5), rr = r & 15, cc = c & 31, ob = rr * 64 + cc * 2; return st * 1024 + (ob ^ (((ob >> 9) & 1) << 5)); }
__host__ __device__ __forceinline__ void stage_rc(int b, int& R, int& C) { const int st = b / 1024, sb = b % 1024, swz = sb ^ (((sb >> 9) & 1) << 5); R = (st >> 1) * 16 + swz / 64; C = (st & 1) * 32 + (swz % 64) / 2; }
__host__ __device__ __forceinline__ int perm32(int rho) { const int n = rho >> 4, i = rho & 15; return 8 * (i >> 2) + 4 * n + (i & 3); }
struct Unit { int pm, pn; };
struct Gemm { const bf16_t* A; const bf16_t* Bt; int M, N, K; };
struct StaticOrder {
  int nM, nN, nwg, G, c;
  __host__ __device__ void init(int M, int N, int G_, int c_) { nM = M / BM; nN = N / BM; nwg = nM * nN; G = G_; c = c_; }
  __host__ __device__ bool next(int i, Unit& u) const {
    const long L = (long)i * G + c; if (L >= nwg) return false;
    int wgid = (int)L; { const int q = nwg / NXCD, r = nwg % NXCD, xcd = wgid % NXCD, off = wgid / NXCD; wgid = (xcd < r ? xcd * (q + 1) : r * (q + 1) + (xcd - r) * q) + off; }
    const int nig = WGM * nN, gid = wgid / nig, fm = gid * WGM, gsz = (nM - fm) < WGM ? (nM - fm) : WGM;
    u.pm = fm + ((wgid % nig) % gsz); u.pn = (wgid % nig) / gsz; return true;
  }
};
#ifndef EMU
#define PG8_LAS __attribute__((address_space(3)))
template <class Epi>
__device__ __forceinline__ void gemm_phase(char* smem, const Gemm g, const StaticOrder& S, const Epi& E) {
  PG8_LAS unsigned char* lds = (PG8_LAS unsigned char*)smem;
  const int tid = tid_(), wid = __builtin_amdgcn_readfirstlane(tid >> 6), lane = tid & 63, wr = wid >> 2, wc = wid & 3, fr = lane & 15, fq = lane >> 4;
  const int K = g.K, nt = K / BK;
  unsigned voffA[2], voffB[2];
#pragma unroll
  for (int i = 0; i < 2; ++i) { int R, C; stage_rc(tid * 16 + i * 8192, R, C); const int Rb = Epi::PERM ? ((R & ~31) + perm32(R & 31)) : R; voffA[i] = (unsigned)(R * K + C) * 2u; voffB[i] = (unsigned)(Rb * K + C) * 2u; }
  const size_t kstep = (size_t)(BK * 2);
  const size_t hstep = (size_t)HALF * K * 2;
  const size_t tstep = 2 * hstep;
  const unsigned ldsw = (unsigned)wid * 1024u;
  const int aoff = lds_byte(wr * 64 + fr, fq * 8), boff = lds_byte(wc * 32 + fr, fq * 8);
#define PG8_SA(b, h) (((b) * 2 + (h)) * HTB)
#define PG8_SB(b, h) ((4 + (b) * 2 + (h)) * HTB)
#define PG8_STAGE(bufoff, gbase, voff) do { _Pragma("unroll") for (int _i = 0; _i < 2; ++_i) \
    __builtin_amdgcn_global_load_lds((const unsigned*)((const char*)(gbase) + (voff)[_i]), (PG8_LAS unsigned*)(lds + (bufoff) + ldsw + _i * 8192), 16, 0, 0); } while (0)
#define PG8_LDA(dst, b, h) do { _Pragma("unroll") for (int m = 0; m < 4; ++m) _Pragma("unroll") for (int k = 0; k < 2; ++k) dst[m][k] = *(const PG8_LAS bf16x8*)(lds + PG8_SA(b, h) + aoff + m * 2048 + k * 1024); } while (0)
#define PG8_LDB(dst, b, h) do { _Pragma("unroll") for (int n = 0; n < 2; ++n) _Pragma("unroll") for (int k = 0; k < 2; ++k) dst[n][k] = *(const PG8_LAS bf16x8*)(lds + PG8_SB(b, h) + boff + n * 2048 + k * 1024); } while (0)
#define PG8_MMA(ai, bj, At, Bt) do { __builtin_amdgcn_s_setprio(1); _Pragma("unroll") for (int m = 0; m < 4; ++m) _Pragma("unroll") for (int n = 0; n < 2; ++n) _Pragma("unroll") for (int k = 0; k < 2; ++k) \
    acc[ai][bj][m][n] = __builtin_amdgcn_mfma_f32_16x16x32_bf16(Bt[n][k], At[m][k], acc[ai][bj][m][n], 0, 0, 0); __builtin_amdgcn_s_setprio(0); } while (0)
#define PG8_WAIT_V(n) asm volatile("s_waitcnt vmcnt(" #n ")" ::: "memory")
#define PG8_WAIT_L(n) asm volatile("s_waitcnt lgkmcnt(" #n ")" ::: "memory")
#define PG8_BAR __builtin_amdgcn_s_barrier()
#define PG8_SCHED __builtin_amdgcn_sched_barrier(0)
  Unit cur, nxt; int ui = 0;
  if (!S.next(0, cur)) return;
  f32x4 acc[2][2][4][2];
#pragma unroll
  for (int a = 0; a < 2; ++a)
#pragma unroll
    for (int b = 0; b < 2; ++b)
#pragma unroll
      for (int m = 0; m < 4; ++m)
#pragma unroll
        for (int n = 0; n < 2; ++n) acc[a][b][m][n] = (f32x4){0.f, 0.f, 0.f, 0.f};
  bf16x8 At[4][2], B0[2][2], B1[2][2];
  const char* cA = (const char*)g.A + (size_t)cur.pm * tstep; const char* cB = (const char*)g.Bt + (size_t)cur.pn * tstep;
  PG8_STAGE(PG8_SB(0, 0), cB, voffB); PG8_STAGE(PG8_SA(0, 0), cA, voffA); PG8_STAGE(PG8_SB(0, 1), cB + hstep, voffB); PG8_STAGE(PG8_SA(0, 1), cA + hstep, voffA);
  if (wr == 1) PG8_BAR;
  PG8_WAIT_V(4); PG8_BAR;
  PG8_STAGE(PG8_SB(1, 0), cB + kstep, voffB); PG8_STAGE(PG8_SA(1, 0), cA + kstep, voffA); PG8_STAGE(PG8_SB(1, 1), cB + hstep + kstep, voffB);
  PG8_WAIT_V(6); PG8_BAR;
  for (;;) {
    const bool has_next = S.next(ui + 1, nxt);
    const char* nA = has_next ? (const char*)g.A + (size_t)nxt.pm * tstep : cA; const char* nB = has_next ? (const char*)g.Bt + (size_t)nxt.pn * tstep : cB;
    for (int t = 0; t < nt; t += 2) {
      const bool last = (t == nt - 2);
      const char* a1 = cA + (size_t)(t + 1) * kstep;
      const char* a2 = last ? nA : cA + (size_t)(t + 2) * kstep; const char* b2 = last ? nB : cB + (size_t)(t + 2) * kstep;
      const char* a3 = a2 + kstep; const char* b3 = b2 + kstep;
      PG8_LDB(B0, 0, 0); PG8_SCHED; PG8_LDA(At, 0, 0); PG8_STAGE(PG8_SA(1, 1), a1 + hstep, voffA);
      PG8_WAIT_L(8); PG8_BAR; PG8_WAIT_L(0); PG8_MMA(0, 0, At, B0); PG8_BAR; PG8_SCHED;
      PG8_LDB(B1, 0, 1); PG8_STAGE(PG8_SB(0, 0), b2, voffB);
      PG8_BAR; PG8_WAIT_L(0); PG8_MMA(0, 1, At, B1); PG8_BAR;
      PG8_LDA(At, 0, 1); PG8_STAGE(PG8_SA(0, 0), a2, voffA);
      PG8_BAR; PG8_WAIT_L(0); PG8_MMA(1, 0, At, B0); PG8_BAR; PG8_SCHED;
      PG8_STAGE(PG8_SB(0, 1), b2 + hstep, voffB);
      PG8_WAIT_V(6); PG8_BAR; PG8_MMA(1, 1, At, B1); PG8_BAR;
      PG8_LDB(B0, 1, 0); PG8_SCHED; PG8_LDA(At, 1, 0); PG8_STAGE(PG8_SA(0, 1), a2 + hstep, voffA);
      PG8_WAIT_L(8); PG8_BAR; PG8_WAIT_L(0); PG8_MMA(0, 0, At, B0); PG8_BAR; PG8_SCHED;
      PG8_LDB(B1, 1, 1); PG8_STAGE(PG8_SB(1, 0), b3, voffB);
      PG8_BAR; PG8_WAIT_L(0); PG8_MMA(0, 1, At, B1); PG8_BAR;
      PG8_LDA(At, 1, 1); PG8_STAGE(PG8_SA(1, 0), a3, voffA);
      PG8_BAR; PG8_WAIT_L(0); PG8_MMA(1, 0, At, B0); PG8_BAR; PG8_SCHED;
      PG8_STAGE(PG8_SB(1, 1), b3 + hstep, voffB);
      PG8_WAIT_V(6); PG8_BAR; PG8_MMA(1, 1, At, B1); PG8_BAR;
    }
    E(acc, cur, wr, wc, fr, fq);
    if (!has_next) break;
#pragma unroll
    for (int a = 0; a < 2; ++a)
#pragma unroll
      for (int b = 0; b < 2; ++b)
#pragma unroll
        for (int m = 0; m < 4; ++m)
#pragma unroll
          for (int n = 0; n < 2; ++n) acc[a][b][m][n] = (f32x4){0.f, 0.f, 0.f, 0.f};
    cur = nxt; cA = nA; cB = nB; ++ui;
  }
  PG8_WAIT_V(0);
  if (wr == 0) PG8_BAR;
  PG8_BAR;
#undef PG8_SA
#undef PG8_SB
#undef PG8_STAGE
#undef PG8_LDA
#undef PG8_LDB
#undef PG8_MMA
#undef PG8_WAIT_V
#undef PG8_WAIT_L
#undef PG8_BAR
#undef PG8_SCHED
}
#else
template <class Epi>
void gemm_phase(char* smem, const Gemm g, const StaticOrder& S, const Epi& E) {
  const int tid = tid_(), wid = tid >> 6, lane = tid & 63, wr = wid >> 2, wc = wid & 3, fr = lane & 15, fq = lane >> 4;
  Unit u;
  for (int i = 0; S.next(i, u); ++i) {
    f32x4 acc[2][2][4][2];
    for (int ai = 0; ai < 2; ++ai) for (int bj = 0; bj < 2; ++bj) for (int m = 0; m < 4; ++m) for (int n = 0; n < 2; ++n) for (int j = 0; j < 4; ++j) {
      int row = u.pm * 256 + ai * 128 + wr * 64 + m * 16 + fr, col = u.pn * 256 + bj * 128 + wc * 32 + (Epi::PERM ? (fq * 8 + n * 4) : (n * 16 + fq * 4)) + j;
      const bf16_t* a = g.A + (size_t)row * g.K; const bf16_t* b = g.Bt + (size_t)col * g.K; float s = 0.f;
      for (int k = 0; k < g.K; ++k) s += bf2f(a[k]) * bf2f(b[k]);
      acc[ai][bj][m][n][j] = s;
    }
    E(acc, u, wr, wc, fr, fq);
  }
}
#endif
}
using pg8::Unit;

#define EPI_LOOP_BEGIN _Pragma("unroll") for (int ai = 0; ai < 2; ++ai) _Pragma("unroll") for (int m = 0; m < 4; ++m) { const int row = u.pm * 256 + ai * 128 + wr * 64 + m * 16 + fr;
#define EPI_FRAG_LOOP _Pragma("unroll") for (int bj = 0; bj < 2; ++bj) _Pragma("unroll") for (int n = 0; n < 2; ++n) { const int col = EPI_COLMAP(u.pn * 256 + bj * 128 + wc * 32 + n * 16 + fq * 4); const f32x4 v = acc[ai][bj][m][n];
#define EPI_COLMAP(c) (c)
#undef EPI_COLMAP
#define EPI_COLMAP(c) ((c) + (((c) >= EV_GLR) ? 16 : 0))
struct EpiEvenIn {
  static constexpr bool PERM = false;
  float* H32; bf16_t *MQ, *MK, *MVT;
  __device__ __forceinline__ void operator()(const f32x4 (&acc)[2][2][4][2], const Unit& u, int wr, int wc, int fr, int fq) const {
    EPI_LOOP_BEGIN
      EPI_FRAG_LOOP
        const int gcol = col; (void)gcol;
        if (col < EV_MQ) *(f32x4*)(H32 + (size_t)row * EV_LD + col) = v;
        else if (col < EV_MK) *(u32x2*)(MQ + (size_t)row * MQ_LD + (col - EV_MQ)) = (u32x2){pack2(v[0], v[1]), pack2(v[2], v[3])};
        else if (col < EV_MV) *(u32x2*)(MK + (size_t)row * MQ_LD + (col - EV_MK)) = (u32x2){pack2(v[0], v[1]), pack2(v[2], v[3])};
        else if (col < EVEN_IN) { bf16_t* d = MVT + (size_t)(col - EV_MV) * SEQ + row; d[0] = f2bf(v[0]); d[SEQ] = f2bf(v[1]); d[2 * (size_t)SEQ] = f2bf(v[2]); d[3 * (size_t)SEQ] = f2bf(v[3]); }
      }
    }
  }
};
#undef EPI_COLMAP
#define EPI_COLMAP(c) (c)
struct EpiOddIn {
  static constexpr bool PERM = false;
  float* H32;
  __device__ __forceinline__ void operator()(const f32x4 (&acc)[2][2][4][2], const Unit& u, int wr, int wc, int fr, int fq) const {
    EPI_LOOP_BEGIN
      EPI_FRAG_LOOP
        if (col < ODD_IN) *(f32x4*)(H32 + (size_t)row * OD_LD + col) = v;
      }
    }
  }
};
struct EpiBf16 {
  static constexpr bool PERM = true;
  bf16_t* O; int ld;
  __device__ __forceinline__ void operator()(const f32x4 (&acc)[2][2][4][2], const Unit& u, int wr, int wc, int fr, int fq) const {
    EPI_LOOP_BEGIN
      _Pragma("unroll") for (int bj = 0; bj < 2; ++bj) { const int col = u.pn * 256 + bj * 128 + wc * 32 + fq * 8; const f32x4 v0 = acc[ai][bj][m][0], v1 = acc[ai][bj][m][1];
        *(u32x4*)(O + (size_t)row * ld + col) = (u32x4){pack2(v0[0], v0[1]), pack2(v0[2], v0[3]), pack2(v1[0], v1[1]), pack2(v1[2], v1[3])};
      }
    }
  }
};
struct EpiRes {
  static constexpr bool PERM = false;
  const float* raw; const float* pst; const float* pg; const float* pb; float* Y; float* stats;
  __device__ __forceinline__ void operator()(const f32x4 (&acc)[2][2][4][2], const Unit& u, int wr, int wc, int fr, int fq) const {
    EPI_LOOP_BEGIN
      SCHED_FENCE();
      float s = 0.f, ss = 0.f, mu = 0.f, rs = 1.f;
      if (!raw) { mu = pst[(size_t)row * 2] * (1.f / DM); const float var = pst[(size_t)row * 2 + 1] * (1.f / DM) - mu * mu; rs = rsqrtf(fmaxf(var, 0.f) + 1e-5f); }
      EPI_FRAG_LOOP
        f32x4 r;
        if (raw) r = *(const f32x4*)(raw + (size_t)row * DM + col);
        else { const f32x4 yo = *(const f32x4*)(Y + (size_t)row * DM + col), gg = *(const f32x4*)(pg + col), bb = *(const f32x4*)(pb + col); r = (yo - mu) * rs * gg + bb; }
        const f32x4 y = r * ALPHA + v;
        *(f32x4*)(Y + (size_t)row * DM + col) = y;
        s += y[0] + y[1] + y[2] + y[3]; ss += y[0] * y[0] + y[1] * y[1] + y[2] * y[2] + y[3] * y[3];
      }
      s += __shfl_xor(s, 16); ss += __shfl_xor(ss, 16); s += __shfl_xor(s, 32); ss += __shfl_xor(ss, 32);
      if (fq == 0) { atomicAdd(stats + (size_t)row * 2, s); atomicAdd(stats + (size_t)row * 2 + 1, ss); }
    }
  }
};
struct EpiGlu {
  static constexpr bool PERM = false;
  const bf16_t* YS; const float* bias; bf16_t* CAT;
  __device__ __forceinline__ void operator()(const f32x4 (&acc)[2][2][4][2], const Unit& u, int wr, int wc, int fr, int fq) const {
    EPI_LOOP_BEGIN
      EPI_FRAG_LOOP
        const u32x2 yy = *(const u32x2*)(YS + (size_t)row * S5_CH + col);
        const f32x4 b = *(const f32x4*)(bias + col);
        float y0 = __uint_as_float(yy[0] << 16), y1 = __uint_as_float(yy[0] & 0xffff0000u), y2 = __uint_as_float(yy[1] << 16), y3 = __uint_as_float(yy[1] & 0xffff0000u);
        y0 *= sigmoidf_(v[0] + b[0]); y1 *= sigmoidf_(v[1] + b[1]); y2 *= sigmoidf_(v[2] + b[2]); y3 *= sigmoidf_(v[3] + b[3]);
        *(u32x2*)(CAT + (size_t)row * ODD_OUT + GDN_H * 128 + col) = (u32x2){pack2(y0, y1), pack2(y2, y3)};
      }
    }
  }
};

template <class Epi> __device__ __forceinline__ void run_gemm(char* smem, const bf16_t* A, const bf16_t* Bt, int N, int K, const Epi& E, int bid, int nb) {
  pg8::Gemm g{A, Bt, SEQ, N, K}; pg8::StaticOrder S; S.init(SEQ, N, nb, bid);
  pg8::gemm_phase<Epi>(smem, g, S, E);
}

__device__ __forceinline__ void transpose_convert(const float* src, bf16_t* dst, int K, int N, int Np, char* smem, int bid, int nb, int glr = -1) {
  float* T = (float*)smem;
  const int tk = K / 64, tn = Np / 64, ntile = tk * tn, tid = tid_();
  const int r0 = tid >> 4, c4 = (tid & 15) * 4;
  f32x4 v[2];
  if (bid < ntile) { const int k0 = (bid % tk) * 64, n = (bid / tk) * 64 + c4;
#pragma unroll
    for (int i = 0; i < 2; ++i) v[i] = (n < N) ? *(const f32x4*)(src + (size_t)(k0 + r0 + 32 * i) * N + n) : f4zero(); }
  for (int t = bid; t < ntile; t += nb) {
    const int k0 = (t % tk) * 64, n0 = (t / tk) * 64;
#pragma unroll
    for (int i = 0; i < 2; ++i) {
#pragma unroll
      for (int e = 0; e < 4; ++e) T[(c4 + e) * 65 + r0 + 32 * i] = v[i][e]; }
    __syncthreads();
    if (t + nb < ntile) { const int k1 = ((t + nb) % tk) * 64, n = ((t + nb) / tk) * 64 + c4;
#pragma unroll
      for (int i = 0; i < 2; ++i) v[i] = (n < N) ? *(const f32x4*)(src + (size_t)(k1 + r0 + 32 * i) * N + n) : f4zero(); }
    { const int n = tid >> 3, ks = (tid & 7) * 8; const float* tp = T + n * 65 + ks;
      u32x4 o; o[0] = pack2(tp[0], tp[1]); o[1] = pack2(tp[2], tp[3]); o[2] = pack2(tp[4], tp[5]); o[3] = pack2(tp[6], tp[7]);
      int dn = n0 + n; if (glr >= 0) dn = (dn < glr) ? dn : (dn < glr + 16) ? (N - 16 + (dn - glr)) : (dn < N) ? dn - 16 : dn;
      *(u32x4*)(dst + (size_t)dn * K + k0 + ks) = o; }
    __syncthreads();
  }
}
__device__ __forceinline__ void conv_mat(const Params& p, int kind, int idx, char* smem, int bid, int nb) {
  const float* src; size_t doff; int K, N, Np, glr = -1;
  switch (kind) {
    case 0: src = p.even_w_in + (size_t)idx * DM * EVEN_IN; doff = OFF_WINE + idx * SZ_WINE; K = DM; N = EVEN_IN; Np = EVEN_NP; glr = EV_GLR; break;
    case 1: src = p.even_w_out + (size_t)idx * EVEN_OUT * DM; doff = OFF_WOUTE + idx * SZ_WOUTE; K = EVEN_OUT; N = DM; Np = DM; break;
    case 2: src = p.odd_w_in + (size_t)idx * DM * ODD_IN; doff = OFF_WINO + idx * SZ_WINO; K = DM; N = ODD_IN; Np = ODD_NP; break;
    case 3: src = p.s5_glu_w + (size_t)idx * S5_CH * S5_CH; doff = OFF_WGLU + idx * SZ_WGLU; K = S5_CH; N = S5_CH; Np = S5_CH; break;
    case 4: src = p.odd_w_out + (size_t)idx * ODD_OUT * DM; doff = OFF_WOUTO + idx * SZ_WOUTO; K = ODD_OUT; N = DM; Np = DM; break;
    case 5: src = p.ffn_w_up + (size_t)idx * DM * 2 * DFF; doff = OFF_WUP + idx * SZ_WUP; K = DM; N = 2 * DFF; Np = 2 * DFF; break;
    default: src = p.ffn_w_down + (size_t)idx * DFF * DM; doff = OFF_WDN + idx * SZ_WDN; K = DFF; N = DM; Np = DM; break;
  }
  transpose_convert(src, (bf16_t*)(p.ws + doff), K, N, Np, smem, bid, nb, glr);
}
__device__ __forceinline__ void conv_group(const Params& p, int g, char* smem, int bid, int nb) {
#pragma unroll 1
  for (int k = 0; k < 10; ++k) {
    int kind, idx; bool on;
    if (g < 0) { kind = (k < 2) ? k : (k < 4) ? k + 3 : k - 2; idx = 0; on = (k < 4) || (k < 7 && DEPTH > 1); }
    else {
      if (k < 2) { kind = 5 + k; idx = g; on = true; }
      else if (k < 4) { kind = k - 2; idx = (g + 1) >> 1; on = g + 1 < DEPTH; }
      else if (k < 6) { kind = 5 + (k - 4); idx = g + 1; on = g + 1 < DEPTH; }
      else if (k < 9) { kind = 2 + (k - 6); idx = (g + 2) >> 1; on = g + 2 < DEPTH; }
      else { kind = 0; idx = 0; on = false; }
    }
    if (on) conv_mat(p, kind, idx, smem, bid, nb);
  }
}
__device__ __forceinline__ void step_prep(const Params& p, char* smem, int bid, int nb) {
  char* ws = p.ws;
  conv_group(p, -1, smem, bid, nb);
  const size_t gt = (size_t)bid * 512 + tid_(), gn = (size_t)nb * 512;
  { bf16_t* XB = (bf16_t*)(ws + OFF_XB);
    for (size_t e = gt; e < (size_t)SEQ * DM / 4; e += gn) { const f32x4 v = *(const f32x4*)(p.x + e * 4); *(u32x2*)(XB + e * 4) = (u32x2){pack2(v[0], v[1]), pack2(v[2], v[3])}; } }
  { float* st = (float*)(ws + OFF_STATS); for (size_t e = gt; e < (size_t)DEPTH * 2 * SEQ * 2; e += gn) st[e] = 0.f; }
  for (size_t e = gt; e < (size_t)N_ODD * S5_G * S5_P; e += gn) {
    const int j = (int)(e / (S5_G * S5_P)), gp = (int)(e % (S5_G * S5_P)), g = gp / S5_P;
    float* C = (float*)(ws + OFF_S5C + j * SZ_S5C1);
    const float are = p.s5_a_re[(size_t)j * S5_G * S5_P + gp], aim = p.s5_a_im[(size_t)j * S5_G * S5_P + gp];
    const float step = expf(p.s5_log_step[j * S5_G + g]);
    const float mag = expf(are * step), abr = mag * cosf(aim * step), abi = mag * sinf(aim * step);
    const float den = are * are + aim * aim;
    const float zr = ((abr - 1.f) * are + abi * aim) / den, zi = (abi * are - (abr - 1.f) * aim) / den;
    C[gp] = abr; C[S5_G * S5_P + gp] = abi;
    float pr = abr, pi = abi;
    for (int k = 0; k < 6; ++k) { const float nr = pr * pr - pi * pi, ni = 2.f * pr * pi; pr = nr; pi = ni; }
    C[2 * S5_G * S5_P + gp] = pr; C[3 * S5_G * S5_P + gp] = pi;
    float* BBR = C + 4 * S5_G * S5_P + (size_t)gp * 16; float* BBI = C + 20 * S5_G * S5_P + (size_t)gp * 16;
    for (int c = 0; c < 16; ++c) { const float br = p.s5_b_re[((size_t)j * S5_G * S5_P + gp) * 16 + c], bi = p.s5_b_im[((size_t)j * S5_G * S5_P + gp) * 16 + c];
      BBR[c] = zr * br - zi * bi; BBI[c] = zr * bi + zi * br; }
  }
}

__device__ __forceinline__ void step_ln(const float* Y, const float* stats, const float* g, const float* b, float* X32, bf16_t* XB, int bid, int nb) {
  const int w = tid_() >> 6, lane = tid_() & 63;
  constexpr int NV = DM / 256;
  for (int row = bid * 8 + w; row < SEQ; row += nb * 8) {
    f32x4 y[NV];
#pragma unroll
    for (int i = 0; i < NV; ++i) y[i] = *(const f32x4*)(Y + (size_t)row * DM + lane * 4 + i * 256);
    const float mu = stats[(size_t)row * 2] * (1.f / DM); const float var = stats[(size_t)row * 2 + 1] * (1.f / DM) - mu * mu; const float rs = rsqrtf(fmaxf(var, 0.f) + 1e-5f);
#pragma unroll
    for (int i = 0; i < NV; ++i) { const int c = lane * 4 + i * 256;
      const f32x4 gg = *(const f32x4*)(g + c), bb = *(const f32x4*)(b + c);
      const f32x4 o = (y[i] - mu) * rs * gg + bb;
      if (X32) *(f32x4*)(X32 + (size_t)row * DM + c) = o;
      *(u32x2*)(XB + (size_t)row * DM + c) = (u32x2){pack2(o[0], o[1]), pack2(o[2], o[3])}; }
  }
}

__device__ __forceinline__ void step_ffn_conv(const bf16_t* H16, const float* cw, bf16_t* G16, int bid, int nb) {
  constexpr int CG = DFF / 8, RB = 16;
  const size_t total = (size_t)(SEQ / RB) * CG;
  for (size_t it = (size_t)bid * 512 + tid_(); it < total; it += (size_t)nb * 512) {
    const int cg8 = (int)(it % CG) * 8, t0 = (int)(it / CG) * RB;
    float wg[3][8], wv[3][8];
#pragma unroll
    for (int i = 0; i < 3; ++i) {
#pragma unroll
      for (int k = 0; k < 8; k += 4) { const f32x4 a = *(const f32x4*)(cw + (size_t)i * 2 * DFF + cg8 + k), b = *(const f32x4*)(cw + (size_t)i * 2 * DFF + DFF + cg8 + k);
        wg[i][k] = a[0]; wg[i][k + 1] = a[1]; wg[i][k + 2] = a[2]; wg[i][k + 3] = a[3]; wv[i][k] = b[0]; wv[i][k + 1] = b[1]; wv[i][k + 2] = b[2]; wv[i][k + 3] = b[3]; }
    }
    float g0[8], g1[8], v0[8], v1[8];
#pragma unroll
    for (int k = 0; k < 8; ++k) { g0[k] = g1[k] = v0[k] = v1[k] = 0.f; }
    if (t0 >= 2) {
      const u32x4 a = *(const u32x4*)(H16 + (size_t)(t0 - 2) * 2 * DFF + cg8), b = *(const u32x4*)(H16 + (size_t)(t0 - 2) * 2 * DFF + DFF + cg8);
      const u32x4 c = *(const u32x4*)(H16 + (size_t)(t0 - 1) * 2 * DFF + cg8), d = *(const u32x4*)(H16 + (size_t)(t0 - 1) * 2 * DFF + DFF + cg8);
#pragma unroll
      for (int k = 0; k < 4; ++k) { g0[2 * k] = __uint_as_float(a[k] << 16); g0[2 * k + 1] = __uint_as_float(a[k] & 0xffff0000u); v0[2 * k] = __uint_as_float(b[k] << 16); v0[2 * k + 1] = __uint_as_float(b[k] & 0xffff0000u);
        g1[2 * k] = __uint_as_float(c[k] << 16); g1[2 * k + 1] = __uint_as_float(c[k] & 0xffff0000u); v1[2 * k] = __uint_as_float(d[k] << 16); v1[2 * k + 1] = __uint_as_float(d[k] & 0xffff0000u); }
    }
#pragma unroll 1
    for (int tb = t0; tb < t0 + RB; tb += 8) {
      u32x4 ra[8], rb[8];
#pragma unroll
      for (int r = 0; r < 8; ++r) { ra[r] = *(const u32x4*)(H16 + (size_t)(tb + r) * 2 * DFF + cg8); rb[r] = *(const u32x4*)(H16 + (size_t)(tb + r) * 2 * DFF + DFF + cg8); }
#pragma unroll
      for (int r = 0; r < 8; ++r) {
        const u32x4 a = ra[r], b = rb[r]; const int t = tb + r;
        float g2[8], v2[8], o[8];
#pragma unroll
        for (int k = 0; k < 4; ++k) { g2[2 * k] = __uint_as_float(a[k] << 16); g2[2 * k + 1] = __uint_as_float(a[k] & 0xffff0000u); v2[2 * k] = __uint_as_float(b[k] << 16); v2[2 * k + 1] = __uint_as_float(b[k] & 0xffff0000u); }
#pragma unroll
        for (int k = 0; k < 8; ++k) { const float gg = wg[0][k] * g0[k] + wg[1][k] * g1[k] + wg[2][k] * g2[k]; const float vv = wv[0][k] * v0[k] + wv[1][k] * v1[k] + wv[2][k] * v2[k];
          o[k] = siluf_(gg) * vv; g0[k] = g1[k]; g1[k] = g2[k]; v0[k] = v1[k]; v1[k] = v2[k]; }
        u32x4 ov; ov[0] = pack2(o[0], o[1]); ov[1] = pack2(o[2], o[3]); ov[2] = pack2(o[4], o[5]); ov[3] = pack2(o[6], o[7]);
        *(u32x4*)(G16 + (size_t)t * DFF + cg8) = ov;
      }
    }
  }
}

__device__ __forceinline__ void gla_logcum(const Params& p, int j, int h, int n, float* CUM, const float* H32, float* TMP) {
  const int tid = tid_();
  const float* w2 = p.gla_w_gate2 + (size_t)j * 16 * (GLA_H * 64); const float* bg = p.gla_b_gate + (size_t)j * GLA_H * 64;
  float* GL = TMP; float* W2 = TMP + 1024; float* BG = W2 + 1024;
  for (int e = tid; e < 1024; e += 512) { GL[e] = H32[(size_t)(n * 64 + (e >> 4)) * EV_LD + EV_GLR + (e & 15)]; W2[e] = w2[(e >> 6) * (GLA_H * 64) + h * 64 + (e & 63)]; }
  if (tid < 64) BG[tid] = bg[h * 64 + tid];
  __syncthreads();
  for (int e = tid; e < 4096; e += 512) {
    const int t = e >> 6, d = e & 63; float x = BG[d];
#pragma unroll
    for (int r = 0; r < 16; ++r) x += GL[t * 16 + r] * W2[r * 64 + d];
    CUM[e] = (fminf(x, 0.f) - log1pf(__expf(-fabsf(x)))) * (1.f / 16.f);
  }
  __syncthreads();
  if (tid < 64) { float c = 0.f;
#pragma unroll 16
    for (int t = 0; t < 64; ++t) { c += CUM[t * 64 + tid]; CUM[t * 64 + tid] = c; } }
  __syncthreads();
}
__device__ __forceinline__ void gla_kv_item(const Params& p, int j, int h, int n, char* smem) {
  const float* H32 = (const float*)(p.ws + OFF_H32); float* KVS = (float*)(p.ws + OFF_KVS); float* DEC = (float*)(p.ws + OFF_DEC);
  float* CUM = (float*)smem; float* KD = CUM + 4096; float* VS = KD + 4096;
  const int tid = tid_();
  f32x4 vpre[4];
#pragma unroll
  for (int i = 0; i < 4; ++i) { const int e = tid + 512 * i, t = e >> 5, c4 = (e & 31) * 4; vpre[i] = *(const f32x4*)(H32 + (size_t)(n * 64 + t) * EV_LD + EV_GV + h * 128 + c4); }
  gla_logcum(p, j, h, n, CUM, H32, VS);
  for (int e = tid; e < 4096; e += 512) { const int t = e >> 6, d = e & 63; KD[e] = H32[(size_t)(n * 64 + t) * EV_LD + EV_GK + h * 64 + d] * __expf(CUM[63 * 64 + d] - CUM[e]); }
#pragma unroll
  for (int i = 0; i < 4; ++i) { const int e = tid + 512 * i, t = e >> 5, c4 = (e & 31) * 4; *(f32x4*)(VS + t * 128 + c4) = vpre[i]; }
  __syncthreads();
  const int dg = tid >> 5, vg = tid & 31;
  f32x4 acc[4] = {f4zero(), f4zero(), f4zero(), f4zero()};
#pragma unroll 4
  for (int t = 0; t < 64; ++t) { const f32x4 k4 = *(const f32x4*)(KD + t * 64 + dg * 4), v4 = *(const f32x4*)(VS + t * 128 + vg * 4);
#pragma unroll
    for (int i = 0; i < 4; ++i) acc[i] += k4[i] * v4; }
#pragma unroll
  for (int i = 0; i < 4; ++i) *(f32x4*)(KVS + ((size_t)(h * NCH + n) * 64 + dg * 4 + i) * 128 + vg * 4) = acc[i];
  if (tid < 64) DEC[(size_t)(h * NCH + n) * 64 + tid] = __expf(CUM[63 * 64 + tid]);
  __syncthreads();
}
__device__ __forceinline__ void gla_scan(const Params& p, int bid, int nb) {
  const float* __restrict__ KVS = (const float*)(p.ws + OFF_KVS); const float* __restrict__ DEC = (const float*)(p.ws + OFF_DEC); float* __restrict__ SPV = (float*)(p.ws + OFF_SPV);
  const int tid = tid_();
  if (tid < 256) for (int e = bid * 256 + tid; e < GLA_H * 64 * 128; e += nb * 256) {
    const int h = e / (64 * 128), d = (e >> 7) & 63, v = e & 127; float s = 0.f;
#pragma unroll 1
    for (int n0 = 0; n0 < NCH; n0 += 16) { float kv[16], dc[16];
#pragma unroll
      for (int k = 0; k < 16; ++k) { kv[k] = KVS[((size_t)(h * NCH + n0 + k) * 64 + d) * 128 + v]; dc[k] = DEC[(size_t)(h * NCH + n0 + k) * 64 + d]; }
#pragma unroll
      for (int k = 0; k < 16; ++k) { SPV[((size_t)(h * NCH + n0 + k) * 64 + d) * 128 + v] = s; s = s * dc[k] + kv[k]; } }
  }
}
__device__ __forceinline__ void gla_out_item(const Params& p, int j, int h, int n, char* smem) {
  constexpr int QP = 68;
  const float* H32 = (const float*)(p.ws + OFF_H32); const float* SP = (const float*)(p.ws + OFF_SPV) + (size_t)(h * NCH + n) * 64 * 128; bf16_t* CAT = (bf16_t*)(p.ws + OFF_CAT);
  float* CUM = (float*)smem; float* QE = CUM + 4096; float* KE = QE + 64 * QP; float* QEt = KE + 64 * QP; float* ATt = QEt + 64 * QP; float* VS = ATt + 64 * QP;
  float* SPs = QE;
  const int tid = tid_();
  f32x4 vpre[4];
#pragma unroll
  for (int i = 0; i < 4; ++i) { const int e = tid + 512 * i, t = e >> 5, c4 = (e & 31) * 4; vpre[i] = *(const f32x4*)(H32 + (size_t)(n * 64 + t) * EV_LD + EV_GV + h * 128 + c4); }
  gla_logcum(p, j, h, n, CUM, H32, VS);
  for (int e = tid; e < 4096; e += 512) { const int t = e >> 6, d = e & 63; const float* hr = H32 + (size_t)(n * 64 + t) * EV_LD; const float c = CUM[e];
    const float qe = hr[EV_GQ + h * 64 + d] * 0.125f * __expf(c); QE[t * QP + d] = qe; QEt[d * QP + t] = qe; KE[t * QP + d] = hr[EV_GK + h * 64 + d] * __expf(-c); }
#pragma unroll
  for (int i = 0; i < 4; ++i) { const int e = tid + 512 * i, t = e >> 5, c4 = (e & 31) * 4; *(f32x4*)(VS + t * 128 + c4) = vpre[i]; }
  __syncthreads();
  const int cg_ = tid >> 5, lg = tid & 31;
  { float a[4][2] = {{0.f, 0.f}, {0.f, 0.f}, {0.f, 0.f}, {0.f, 0.f}};
#pragma unroll 2
    for (int d4 = 0; d4 < 16; ++d4) { f32x4 k0 = *(const f32x4*)(KE + lg * QP + d4 * 4), k1 = *(const f32x4*)(KE + (lg + 32) * QP + d4 * 4);
#pragma unroll
      for (int i = 0; i < 4; ++i) { const f32x4 q = *(const f32x4*)(QE + (cg_ * 4 + i) * QP + d4 * 4); a[i][0] += q[0] * k0[0] + q[1] * k0[1] + q[2] * k0[2] + q[3] * k0[3]; a[i][1] += q[0] * k1[0] + q[1] * k1[1] + q[2] * k1[2] + q[3] * k1[3]; } }
#pragma unroll
    for (int i = 0; i < 4; ++i) { const int c = cg_ * 4 + i; ATt[lg * QP + c] = (c >= lg) ? a[i][0] : 0.f; ATt[(lg + 32) * QP + c] = (c >= lg + 32) ? a[i][1] : 0.f; } }
  __syncthreads();
  for (int e = tid; e < 64 * 32; e += 512) *(f32x4*)(SPs + e * 4) = *(const f32x4*)(SP + e * 4);
  __syncthreads();
  f32x4 acc[4] = {f4zero(), f4zero(), f4zero(), f4zero()};
#pragma unroll 4
  for (int s = 0; s < 64; ++s) { const f32x4 a4 = *(const f32x4*)(ATt + s * QP + cg_ * 4), v4 = *(const f32x4*)(VS + s * 128 + lg * 4);
#pragma unroll
    for (int i = 0; i < 4; ++i) acc[i] += a4[i] * v4; }
#pragma unroll 4
  for (int d = 0; d < 64; ++d) { const f32x4 q4 = *(const f32x4*)(QEt + d * QP + cg_ * 4), s4 = *(const f32x4*)(SPs + d * 128 + lg * 4);
#pragma unroll
    for (int i = 0; i < 4; ++i) acc[i] += q4[i] * s4; }
  const f32x4 ng = *(const f32x4*)(p.gla_norm_g + (size_t)j * 128 + lg * 4);
#pragma unroll
  for (int i = 0; i < 4; ++i) {
    float ss = acc[i][0] * acc[i][0] + acc[i][1] * acc[i][1] + acc[i][2] * acc[i][2] + acc[i][3] * acc[i][3];
    ss += __shfl_xor(ss, 1); ss += __shfl_xor(ss, 2); ss += __shfl_xor(ss, 4); ss += __shfl_xor(ss, 8); ss += __shfl_xor(ss, 16);
    const float r = rsqrtf(ss * (1.f / 128.f) + 1e-6f); const int t = n * 64 + cg_ * 4 + i;
    const f32x4 gr = *(const f32x4*)(H32 + (size_t)t * EV_LD + EV_GR + h * 128 + lg * 4);
    const f32x4 o = acc[i] * r * ng;
    *(u32x2*)(CAT + (size_t)t * EVEN_OUT + h * 128 + lg * 4) = (u32x2){pack2(o[0] * siluf_(gr[0]), o[1] * siluf_(gr[1])), pack2(o[2] * siluf_(gr[2]), o[3] * siluf_(gr[3]))};
  }
  __syncthreads();
}

__device__ __forceinline__ void moba_kmean_item(const Params& p, int h, int blk, char* smem) {
  const bf16_t* MK = (const bf16_t*)(p.ws + OFF_MK); float* KM = (float*)(p.ws + OFF_KMEAN); float* PART = (float*)smem;
  const int tid = tid_(), d = tid & 127, part = tid >> 7; float s = 0.f;
#pragma unroll 16
  for (int k = 0; k < 64; ++k) s += bf2f(MK[(size_t)(blk * 256 + part * 64 + k) * MQ_LD + h * 128 + d]);
  PART[tid] = s; __syncthreads();
  if (tid < 128) KM[(size_t)(h * NBLK + blk) * 128 + tid] = (PART[tid] + PART[128 + tid] + PART[256 + tid] + PART[384 + tid]) * (1.f / 256.f);
  __syncthreads();
}
struct Top3 { float v0, v1, v2; int i0, i1, i2; };
__device__ __forceinline__ bool top_better(float v, int i, float w, int j) { return v > w || (v == w && i < j); }
__device__ __forceinline__ Top3 top_ins(Top3 t, float v, int i) {
  const bool b0 = top_better(v, i, t.v0, t.i0), b1 = top_better(v, i, t.v1, t.i1), b2 = top_better(v, i, t.v2, t.i2);
  Top3 r;
  r.v2 = b1 ? t.v1 : (b2 ? v : t.v2); r.i2 = b1 ? t.i1 : (b2 ? i : t.i2);
  r.v1 = b0 ? t.v0 : (b1 ? v : t.v1); r.i1 = b0 ? t.i0 : (b1 ? i : t.i1);
  r.v0 = b0 ? v : t.v0; r.i0 = b0 ? i : t.i0;
  return r;
}
template <bool GATH> __device__ __forceinline__ void moba_tile(const Params& p, int h, int arg0, int arg1, int arg2, char* smem) {
  constexpr int PB = 272;
  constexpr float NEG = -1e30f;
  const bf16_t* MQ = (const bf16_t*)(p.ws + OFF_MQ); const bf16_t* MK = (const bf16_t*)(p.ws + OFF_MK); const bf16_t* MVT = (const bf16_t*)(p.ws + OFF_MVT);
  const float* KM = (const float*)(p.ws + OFF_KMEAN); unsigned* MCNT = (unsigned*)(p.ws + OFF_MCNT); unsigned* MLIST = (unsigned*)(p.ws + OFF_MLIST);
  float* PO = (float*)(p.ws + OFF_PO); f32x2* PML = (f32x2*)(p.ws + OFF_PML);
  char* Qs = smem; char* Ks = Qs + 64 * PB; char* VTs = Ks + 128 * PB; int* ROWT = (int*)(VTs + 128 * PB); int* ROWS = ROWT + 64;
  float* MRG = (float*)Ks;
  const int tid = tid_(), w = tid >> 6, lane = tid & 63, fr = lane & 15, fq = lane >> 4, wq = w & 3, wh = w >> 2;
  const int t0 = GATH ? 0 : arg0 * 64, own = t0 >> 8;
  const float slope = exp2f(-8.f * (float)(h + 1) / (float)MOBA_H), scale = 0.08838834764831845f;
  const int kbase = GATH ? arg0 * 256 : own * 256;
  unsigned ent = 0u; const bool rv = GATH ? (arg1 + tid < arg2) : true;
  if (GATH && tid < 64) ent = MLIST[(size_t)(h * NBLK + arg0) * SEQ + (rv ? arg1 + tid : arg1)];
  u32x4 kreg[4], vreg[4];
  { const int key0 = kbase;
#pragma unroll
    for (int i = 0; i < 4; ++i) { const int e = tid + 512 * i, r = e >> 4, c = e & 15;
      kreg[i] = *(const u32x4*)(MK + (size_t)(key0 + r) * MQ_LD + h * 128 + c * 8); vreg[i] = *(const u32x4*)(MVT + (size_t)(h * 128 + r) * SEQ + key0 + c * 8); } }
  if (tid < 64) {
    if (GATH) { ROWT[tid] = (int)(ent >> 2); ROWS[tid] = rv ? (int)(ent & 3u) : -1; }
    else { ROWT[tid] = t0 + tid; ROWS[tid] = 3; } }
  lds_barrier();
  for (int e = tid; e < 64 * 16; e += 512) { const int r = e >> 4, c = e & 15; *(u32x4*)(Qs + r * PB + c * 16) = *(const u32x4*)(MQ + (size_t)ROWT[r] * MQ_LD + h * 128 + c * 8); }
  lds_barrier();
  if (!GATH) {
    float* KMs = (float*)Ks;
    for (int e = tid; e < own * 32; e += 512) *(f32x4*)(KMs + e * 4) = *(const f32x4*)(KM + (size_t)h * NBLK * 128 + e * 4);
    __syncthreads();
    const int q = tid >> 3, part = tid & 7; Top3 tp; tp.v0 = tp.v1 = tp.v2 = -INFINITY; tp.i0 = tp.i1 = tp.i2 = 1 << 20;
    for (int nb_ = part; nb_ < own; nb_ += 8) { const float* km = KMs + nb_ * 128; float s = 0.f;
#pragma unroll 2
      for (int c = 0; c < 16; ++c) { const u32x4 qq = *(const u32x4*)(Qs + q * PB + c * 16); const f32x4 ka = *(const f32x4*)(km + c * 8), kb = *(const f32x4*)(km + c * 8 + 4);
        s += __uint_as_float(qq[0] << 16) * ka[0] + __uint_as_float(qq[0] & 0xffff0000u) * ka[1] + __uint_as_float(qq[1] << 16) * ka[2] + __uint_as_float(qq[1] & 0xffff0000u) * ka[3]
           + __uint_as_float(qq[2] << 16) * kb[0] + __uint_as_float(qq[2] & 0xffff0000u) * kb[1] + __uint_as_float(qq[3] << 16) * kb[2] + __uint_as_float(qq[3] & 0xffff0000u) * kb[3]; }
      tp = top_ins(tp, s, nb_); }
#pragma unroll
    for (int m = 1; m < 8; m <<= 1) { const float a0 = __shfl_xor(tp.v0, m), a1 = __shfl_xor(tp.v1, m), a2 = __shfl_xor(tp.v2, m); const int b0 = __shfl_xor(tp.i0, m), b1 = __shfl_xor(tp.i1, m), b2 = __shfl_xor(tp.i2, m);
      tp = top_ins(tp, a0, b0); tp = top_ins(tp, a1, b1); tp = top_ins(tp, a2, b2); }
    unsigned* CL = (unsigned*)(ROWS + 64); unsigned* BASE = CL + 32;
    if (tid < 32) CL[tid] = 0u;
    __syncthreads();
    unsigned l0 = 0, l1 = 0, l2 = 0;
    if (part == 0) { if (tp.i0 < 32) l0 = atomicAdd(CL + tp.i0, 1u); if (tp.i1 < 32) l1 = atomicAdd(CL + tp.i1, 1u); if (tp.i2 < 32) l2 = atomicAdd(CL + tp.i2, 1u); }
    __syncthreads();
    if (tid < own && CL[tid] > 0u) BASE[tid] = atomicAdd(MCNT + h * NBLK + tid, CL[tid]);
    __syncthreads();
    if (part == 0) { const unsigned tt = (unsigned)(t0 + q);
      if (tp.i0 < 32) MLIST[(size_t)(h * NBLK + tp.i0) * SEQ + BASE[tp.i0] + l0] = (tt << 2) | 0u;
      if (tp.i1 < 32) MLIST[(size_t)(h * NBLK + tp.i1) * SEQ + BASE[tp.i1] + l1] = (tt << 2) | 1u;
      if (tp.i2 < 32) MLIST[(size_t)(h * NBLK + tp.i2) * SEQ + BASE[tp.i2] + l2] = (tt << 2) | 2u; }
  }
  bf16x8 qf[4];
#pragma unroll
  for (int kk = 0; kk < 4; ++kk) qf[kk] = *(const bf16x8*)(Qs + (wq * 16 + fr) * PB + kk * 64 + fq * 16);
  f32x4 oacc[8];
#pragma unroll
  for (int i = 0; i < 8; ++i) oacc[i] = f4zero();
  float mrow = NEG, lrow = 0.f;
  const int tq = ROWT[wq * 16 + fr], slot = ROWS[wq * 16 + fr];
  const int ntile = GATH ? 2 : ((own * 256 + 128 <= t0 + 63) ? 2 : 1);
#pragma unroll 1
  for (int ti = 0; ti < ntile; ++ti) {
    {
      const int key0 = kbase + ti * 128;
      lds_barrier();
#pragma unroll
      for (int i = 0; i < 4; ++i) { const int e = tid + 512 * i, r = e >> 4, c = e & 15; *(u32x4*)(Ks + r * PB + c * 16) = kreg[i]; *(u32x4*)(VTs + r * PB + c * 16) = vreg[i]; }
      if (ti + 1 < ntile) { const int key1 = key0 + 128;
#pragma unroll
        for (int i = 0; i < 4; ++i) { const int e = tid + 512 * i, r = e >> 4, c = e & 15;
          kreg[i] = *(const u32x4*)(MK + (size_t)(key1 + r) * MQ_LD + h * 128 + c * 8); vreg[i] = *(const u32x4*)(MVT + (size_t)(h * 128 + r) * SEQ + key1 + c * 8); } }
      lds_barrier();
      const int kb = wh * 64;
      f32x4 sacc[4];
#pragma unroll
      for (int nt = 0; nt < 4; ++nt) { sacc[nt] = f4zero();
#pragma unroll
        for (int kk = 0; kk < 4; ++kk) { const bf16x8 kf = *(const bf16x8*)(Ks + (kb + nt * 16 + fr) * PB + kk * 64 + fq * 16); sacc[nt] = __builtin_amdgcn_mfma_f32_16x16x32_bf16(kf, qf[kk], sacc[nt], 0, 0, 0); } }
      float mx = NEG;
#pragma unroll
      for (int nt = 0; nt < 4; ++nt)
#pragma unroll
        for (int jj = 0; jj < 4; ++jj) { const int tk = key0 + kb + nt * 16 + fq * 4 + jj; float s = sacc[nt][jj] * scale - slope * (float)(tq - tk);
          const bool ok = GATH ? true : (tk <= tq); s = ok ? s : NEG; sacc[nt][jj] = s; mx = fmaxf(mx, s); }
      mx = fmaxf(mx, __shfl_xor(mx, 16)); mx = fmaxf(mx, __shfl_xor(mx, 32));
      const float mnew = fmaxf(mrow, mx), alpha = __expf(mrow - mnew); mrow = mnew;
      float ps = 0.f;
#pragma unroll
      for (int nt = 0; nt < 4; ++nt)
#pragma unroll
        for (int jj = 0; jj < 4; ++jj) { const float pv = __expf(sacc[nt][jj] - mnew); sacc[nt][jj] = pv; ps += pv; }
      lrow = lrow * alpha + ps;
#pragma unroll
      for (int i = 0; i < 8; ++i) oacc[i] *= alpha;
#pragma unroll
      for (int k2 = 0; k2 < 2; ++k2) {
        u32x4 pk; pk[0] = pack2(sacc[2 * k2][0], sacc[2 * k2][1]); pk[1] = pack2(sacc[2 * k2][2], sacc[2 * k2][3]); pk[2] = pack2(sacc[2 * k2 + 1][0], sacc[2 * k2 + 1][1]); pk[3] = pack2(sacc[2 * k2 + 1][2], sacc[2 * k2 + 1][3]);
        bf16x8 pb; __builtin_memcpy(&pb, &pk, 16);
#pragma unroll
        for (int dt = 0; dt < 8; ++dt) {
          const char* vr = VTs + (dt * 16 + fr) * PB + (kb + 32 * k2 + fq * 4) * 2;
          const u32x2 lo = *(const u32x2*)vr, hi = *(const u32x2*)(vr + 32);
          u32x4 vv; vv[0] = lo[0]; vv[1] = lo[1]; vv[2] = hi[0]; vv[3] = hi[1]; bf16x8 vf; __builtin_memcpy(&vf, &vv, 16);
          oacc[dt] = __builtin_amdgcn_mfma_f32_16x16x32_bf16(vf, pb, oacc[dt], 0, 0, 0);
        }
      }
    }
  }
  lrow += __shfl_xor(lrow, 16); lrow += __shfl_xor(lrow, 32);
  __syncthreads();
  if (wh == 1) { float* mg = MRG + (size_t)wq * 34 * 64;
#pragma unroll
    for (int dt = 0; dt < 8; ++dt)
#pragma unroll
      for (int jj = 0; jj < 4; ++jj) mg[(dt * 4 + jj) * 64 + lane] = oacc[dt][jj];
    mg[32 * 64 + lane] = mrow; mg[33 * 64 + lane] = lrow; }
  __syncthreads();
  if (wh == 0 && slot >= 0) { const float* mg = MRG + (size_t)wq * 34 * 64; const float m2 = mg[32 * 64 + lane], l2 = mg[33 * 64 + lane];
    const float ms = fmaxf(mrow, m2), f1 = __expf(mrow - ms), f2 = __expf(m2 - ms); const float lt = lrow * f1 + l2 * f2, inv = 1.f / lt;
    const size_t pi = ((size_t)h * SEQ + tq) * 4 + slot;
#pragma unroll
    for (int dt = 0; dt < 8; ++dt) { f32x4 o;
#pragma unroll
      for (int jj = 0; jj < 4; ++jj) o[jj] = (oacc[dt][jj] * f1 + mg[(dt * 4 + jj) * 64 + lane] * f2) * inv;
      *(f32x4*)(PO + pi * 128 + dt * 16 + fq * 4) = o; }
    if (fq == 0) PML[pi] = (f32x2){ms, lt}; }
  __syncthreads();
}
__device__ __forceinline__ void moba_gathered(const Params& p, char* smem, int bid, int nb) {
  const unsigned* MCNT = (const unsigned*)(p.ws + OFF_MCNT);
  int* PC = (int*)(smem + 120 * 1024); int* PF = PC + 256;
  const int tid = tid_();
  if (tid < 256) PC[tid] = (tid < MOBA_H * NBLK) ? (int)((MCNT[tid] + 63u) >> 6) : 0;
  __syncthreads();
  if (tid < 256) { int sum = 0; for (int k = 0; k < tid; ++k) sum += PC[k]; PF[tid] = sum; }
  __syncthreads();
  const int total = PF[255] + PC[255];
  const int vb = ((nb & 7) == 0) ? (bid & 7) * (nb >> 3) + (bid >> 3) : bid;
  for (int g = vb; g < total; g += nb) {
    int lo = 0, hi = 256;
    while (hi - lo > 1) { const int mid = (lo + hi) >> 1; if (PF[mid] <= g) lo = mid; else hi = mid; }
    moba_tile<true>(p, lo / NBLK, lo % NBLK, (g - PF[lo]) * 64, (int)MCNT[lo], smem);
  }
}
__device__ __forceinline__ void moba_combine(const Params& p, int bid, int nb) {
  const float* PO = (const float*)(p.ws + OFF_PO); const f32x2* PML = (const f32x2*)(p.ws + OFF_PML); bf16_t* CAT = (bf16_t*)(p.ws + OFF_CAT);
  const int grp = tid_() >> 5, l = tid_() & 31;
  for (int it = bid * 16 + grp; it < SEQ * MOBA_H; it += nb * 16) {
    const int t = it / MOBA_H, h = it % MOBA_H, own = t >> 8, nv = own < 3 ? own : 3; const size_t pi = ((size_t)h * SEQ + t) * 4;
    f32x2 ml[4]; f32x4 po[4];
    ml[3] = PML[pi + 3]; po[3] = *(const f32x4*)(PO + (pi + 3) * 128 + l * 4);
#pragma unroll
    for (int k = 0; k < 3; ++k) { if (k < nv) { ml[k] = PML[pi + k]; po[k] = *(const f32x4*)(PO + (pi + k) * 128 + l * 4); } else { ml[k] = (f32x2){-1e30f, 0.f}; po[k] = f4zero(); } }
    float mm = fmaxf(fmaxf(ml[0][0], ml[1][0]), fmaxf(ml[2][0], ml[3][0]));
    float wsum = 0.f; f32x4 acc = f4zero();
#pragma unroll
    for (int k = 0; k < 4; ++k) { const float wk = ml[k][1] * __expf(ml[k][0] - mm); wsum += wk; acc += po[k] * wk; }
    const float inv = 1.f / wsum;
    *(u32x2*)(CAT + (size_t)t * EVEN_OUT + GLA_H * 128 + h * 128 + l * 4) = (u32x2){pack2(acc[0] * inv, acc[1] * inv), pack2(acc[2] * inv, acc[3] * inv)};
  }
}

__device__ __forceinline__ void gdn_local_item(const Params& p, int j, int h, int n, char* smem) {
  constexpr int SP_ = 260, KP = 132;
  const float* H32 = (const float*)(p.ws + OFF_H32);
  float* SOL = (float*)smem; float* KS = SOL + 64 * SP_; float* LM = KS + 64 * KP; float* BETA = LM + 2 * 64 * 36;   float* GG = BETA + 64; float* GC = GG + 64;
  const size_t base = (size_t)(h * NCH + n);
  float* Ug = (float*)(p.ws + OFF_GU) + base * 8192; bf16_t* Wg = (bf16_t*)(p.ws + OFF_GW) + base * 8192; bf16_t* QDg = (bf16_t*)(p.ws + OFF_GQD) + base * 8192; bf16_t* KDg = (bf16_t*)(p.ws + OFF_GKD) + base * 8192;
  bf16_t* ATg = (bf16_t*)(p.ws + OFF_ATT) + base * 4096; float* EGL = (float*)(p.ws + OFF_EGL);
  const int tid = tid_(), t0 = n * 64;
  { const int cs = tid & 31, rg = tid >> 5, c4 = cs * 4; const float* cwb = p.gdn_conv_w + (size_t)j * 4 * (3 * GDN_H * 128);
#pragma unroll
    for (int part = 0; part < 3; ++part) { const int col = part * GDN_H * 128 + h * 128 + c4; f32x4 wv[4], xv[7];
#pragma unroll
      for (int jj = 0; jj < 4; ++jj) wv[jj] = *(const f32x4*)(cwb + (size_t)jj * (3 * GDN_H * 128) + col);
#pragma unroll
      for (int r = 0; r < 7; ++r) { const int t = t0 + rg * 4 - 3 + r; xv[r] = (t >= 0) ? *(const f32x4*)(H32 + (size_t)t * OD_LD + OD_QKV + col) : f4zero(); }
#pragma unroll
      for (int i = 0; i < 4; ++i) { f32x4 o = wv[0] * xv[i] + wv[1] * xv[i + 1] + wv[2] * xv[i + 2] + wv[3] * xv[i + 3];
        o[0] = siluf_(o[0]); o[1] = siluf_(o[1]); o[2] = siluf_(o[2]); o[3] = siluf_(o[3]);
        float* dst = (part == 0) ? (SOL + (rg * 4 + i) * SP_ + 128 + c4) : (part == 1) ? (KS + (rg * 4 + i) * KP + c4) : (SOL + (rg * 4 + i) * SP_ + c4);
        *(f32x4*)dst = o; } } }
  if (tid < 64) { const int t = t0 + tid; BETA[tid] = sigmoidf_(H32[(size_t)t * OD_LD + OD_BETA + h]);
    GG[tid] = -expf(p.gdn_a_log[j * GDN_H + h]) * softplusf_(H32[(size_t)t * OD_LD + OD_DEC + h] + p.gdn_dt_bias[j * GDN_H + h]); }
  __syncthreads();
  const int row = tid >> 3, seg = tid & 7;
  { float* qp = SOL + row * SP_ + 128 + seg * 16; float* kp = KS + row * KP + seg * 16; float sq = 0.f, sk = 0.f;
#pragma unroll
    for (int c = 0; c < 16; ++c) { sq += qp[c] * qp[c]; sk += kp[c] * kp[c]; }
    sq += __shfl_xor(sq, 1); sk += __shfl_xor(sk, 1); sq += __shfl_xor(sq, 2); sk += __shfl_xor(sk, 2); sq += __shfl_xor(sq, 4); sk += __shfl_xor(sk, 4);
    const float rq = rsqrtf(sq + 1e-6f) * 0.08838834764831845f, rk = rsqrtf(sk + 1e-6f);
#pragma unroll
    for (int c = 0; c < 16; ++c) { qp[c] *= rq; kp[c] *= rk; }
    char* Kb = (char*)LM; char* Qb = smem + 122880;
#pragma unroll
    for (int c = 0; c < 16; c += 8) { *(u32x4*)(Kb + row * 272 + (seg * 16 + c) * 2) = (u32x4){pack2(kp[c], kp[c + 1]), pack2(kp[c + 2], kp[c + 3]), pack2(kp[c + 4], kp[c + 5]), pack2(kp[c + 6], kp[c + 7])};
      *(u32x4*)(Qb + row * 272 + (seg * 16 + c) * 2) = (u32x4){pack2(qp[c], qp[c + 1]), pack2(qp[c + 2], qp[c + 3]), pack2(qp[c + 4], qp[c + 5]), pack2(qp[c + 6], qp[c + 7])}; } }
  if (tid == 0) { float c = 0.f;
#pragma unroll 16
    for (int t = 0; t < 64; ++t) { c += GG[t]; GC[t] = c; } }
  __syncthreads();
  {
    const char* Kb = (const char*)LM; const char* Qb = smem + 122880;
    const int w = tid >> 6, lane = tid & 63, fr = lane & 15, fq = lane >> 4, it = w >> 1, jt0 = 2 * (w & 1);
    f32x4 aL[2] = {f4zero(), f4zero()}, aA[2] = {f4zero(), f4zero()};
#pragma unroll
    for (int kk = 0; kk < 4; ++kk) {
      const bf16x8 ki = *(const bf16x8*)(Kb + (it * 16 + fr) * 272 + kk * 64 + fq * 16), qi = *(const bf16x8*)(Qb + (it * 16 + fr) * 272 + kk * 64 + fq * 16);
#pragma unroll
      for (int jj = 0; jj < 2; ++jj) { const bf16x8 kj = *(const bf16x8*)(Kb + ((jt0 + jj) * 16 + fr) * 272 + kk * 64 + fq * 16);
        aL[jj] = __builtin_amdgcn_mfma_f32_16x16x32_bf16(ki, kj, aL[jj], 0, 0, 0); aA[jj] = __builtin_amdgcn_mfma_f32_16x16x32_bf16(qi, kj, aA[jj], 0, 0, 0); } }
    __syncthreads();
#pragma unroll
    for (int jj = 0; jj < 2; ++jj)
#pragma unroll
      for (int r = 0; r < 4; ++r) { const int ii = it * 16 + fq * 4 + r, jx = (jt0 + jj) * 16 + fr; const float dec = (ii >= jx) ? __expf(GC[ii] - GC[jx]) : 0.f;
        LM[(jx & 1) * (64 * 36) + ii * 36 + (jx >> 1)] = (ii > jx) ? BETA[ii] * aL[jj][r] * dec : 0.f; ATg[ii * 64 + jx] = f2bf(aA[jj][r] * dec); } }
  { const float eg = __expf(GC[row]), ek = __expf(GC[63] - GC[row]); const float* qp = SOL + row * SP_ + 128 + seg * 16; const float* kp = KS + row * KP + seg * 16;
#pragma unroll
    for (int c = 0; c < 16; c += 4) { const f32x4 q = *(const f32x4*)(qp + c), k = *(const f32x4*)(kp + c); { const f32x4 qq = q * eg; *(u32x2*)(QDg + row * 128 + seg * 16 + c) = (u32x2){pack2(qq[0], qq[1]), pack2(qq[2], qq[3])}; }
#pragma unroll
      for (int e = 0; e < 4; ++e) KDg[(seg * 16 + c + e) * 64 + row] = f2bf(k[e] * ek); } }
  __syncthreads();
  { const float bt = BETA[row], be = bt * __expf(GC[row]); float* vp = SOL + row * SP_ + seg * 16; float* wp = SOL + row * SP_ + 128 + seg * 16; const float* kp = KS + row * KP + seg * 16;
#pragma unroll
    for (int c = 0; c < 16; ++c) { vp[c] *= bt; wp[c] = kp[c] * be; } }
  __syncthreads();
  { const int col = tid >> 1, half = tid & 1; const float* lmh = LM + half * (64 * 36);
    float x[32];
#pragma unroll
    for (int k = 0; k < 32; ++k) x[k] = 0.f;
#pragma unroll
    for (int i = 0; i < 64; ++i) {
      const float rhs = SOL[i * SP_ + col]; float part = 0.f;
#pragma unroll
      for (int k4 = 0; k4 < (i + 1) / 2; k4 += 4) { const f32x4 l4 = *(const f32x4*)(lmh + i * 36 + k4);
#pragma unroll
        for (int e = 0; e < 4; ++e) if (k4 + e < (i + 1) / 2) part += l4[e] * x[k4 + e]; }
      const float nv = rhs - (part + dpp_mov<0xB1>(part));
      x[i >> 1] = ((i & 1) == half) ? nv : x[i >> 1];
      if (i > 0) SOL[i * SP_ + col] = nv;
    } }
  __syncthreads();
#pragma unroll
  for (int c = 0; c < 16; c += 4) { const f32x4 uu = *(const f32x4*)(SOL + row * SP_ + seg * 16 + c);
#pragma unroll
    for (int e = 0; e < 4; ++e) Ug[(seg * 16 + c + e) * 64 + row] = uu[e];
    { const f32x4 ww = *(const f32x4*)(SOL + row * SP_ + 128 + seg * 16 + c); *(u32x2*)(Wg + row * 128 + seg * 16 + c) = (u32x2){pack2(ww[0], ww[1]), pack2(ww[2], ww[3])}; } }
  if (tid == 0) EGL[base] = __expf(GC[63]);
  __syncthreads();
}
struct GdnMRegs { bf16x8 a12[4], a4[2]; f32x4 x[2]; float egl; };
__device__ __forceinline__ void gdn_mload(GdnMRegs& r, const char* ws, int h, int n, int w, int fr, int fq, int j0) {
  const size_t base = (size_t)(h * NCH + n);
  const float* UTn = (const float*)(ws + OFF_GU) + base * 8192; const bf16_t* Wn = (const bf16_t*)(ws + OFF_GW) + base * 8192; const bf16_t* QDn = (const bf16_t*)(ws + OFF_GQD) + base * 8192;
  const bf16_t* KDTn = (const bf16_t*)(ws + OFF_GKD) + base * 8192; const bf16_t* ATn = (const bf16_t*)(ws + OFF_ATT) + base * 4096;
  const bf16_t* a12p = ((w < 4) ? Wn : QDn) + (16 * (w & 3) + fr) * 128 + fq * 8;
#pragma unroll
  for (int kk = 0; kk < 4; ++kk) r.a12[kk] = *(const bf16x8*)(a12p + kk * 32);
  const bf16_t* a4p = KDTn + (16 * w + fr) * 64 + fq * 8;
#pragma unroll
  for (int kk = 0; kk < 2; ++kk) r.a4[kk] = *(const bf16x8*)(a4p + kk * 32);
  const char* xp = (w < 4) ? (const char*)(UTn + (j0 + fr) * 64 + 16 * w + fq * 4) : (const char*)(ATn + (16 * (w - 4) + fr) * 64 + fq * 8); const int xs = (w < 4) ? 16 * 64 * 4 : 64;
#pragma unroll
  for (int i = 0; i < 2; ++i) r.x[i] = *(const f32x4*)(xp + i * xs);
  r.egl = ((const float*)(ws + OFF_EGL))[base];
}
constexpr int GS_SP = 272, GS_VP = 144;
__device__ __forceinline__ void gdn_mstep(const GdnMRegs& cur, f32x4 (&sacc)[2], char* ST, char* VT, float* OB, int n, int h, int j0, int w, int fr, int fq) {
  f32x4 acc[2] = {f4zero(), f4zero()};
#pragma unroll
  for (int kk = 0; kk < 4; ++kk) { const bf16x8 af = cur.a12[kk];
#pragma unroll
    for (int jt = 0; jt < 2; ++jt) { const bf16x8 bfr = *(const bf16x8*)(ST + (jt * 16 + fr) * GS_SP + (kk * 32 + fq * 8) * 2); acc[jt] = __builtin_amdgcn_mfma_f32_16x16x32_bf16(af, bfr, acc[jt], 0, 0, 0); } }
  if (w < 4) {
#pragma unroll
    for (int jt = 0; jt < 2; ++jt) { const f32x4 vn = cur.x[jt] - acc[jt]; *(u32x2*)(VT + (jt * 16 + fr) * GS_VP + (16 * w + fq * 4) * 2) = (u32x2){pack2(vn[0], vn[1]), pack2(vn[2], vn[3])}; } }
  lds_barrier();
  bf16x8 vf[2][2];
#pragma unroll
  for (int kk = 0; kk < 2; ++kk)
#pragma unroll
    for (int jt = 0; jt < 2; ++jt) vf[kk][jt] = *(const bf16x8*)(VT + (jt * 16 + fr) * GS_VP + (kk * 32 + fq * 8) * 2);
  if (w >= 4) {
#pragma unroll
    for (int kk = 0; kk < 2; ++kk) { bf16x8 af; __builtin_memcpy(&af, &cur.x[kk], 16);
#pragma unroll
      for (int jt = 0; jt < 2; ++jt) acc[jt] = __builtin_amdgcn_mfma_f32_16x16x32_bf16(af, vf[kk][jt], acc[jt], 0, 0, 0); }
#pragma unroll
    for (int jt = 0; jt < 2; ++jt)
#pragma unroll
      for (int r = 0; r < 4; ++r) OB[((n & 7) * 64 + 16 * (w - 4) + fq * 4 + r) * 36 + jt * 16 + fr] = acc[jt][r];
  }
#pragma unroll
  for (int jt = 0; jt < 2; ++jt) sacc[jt] *= cur.egl;
#pragma unroll
  for (int kk = 0; kk < 2; ++kk) { const bf16x8 af = cur.a4[kk];
#pragma unroll
    for (int jt = 0; jt < 2; ++jt) sacc[jt] = __builtin_amdgcn_mfma_f32_16x16x32_bf16(af, vf[kk][jt], sacc[jt], 0, 0, 0); }
#pragma unroll
  for (int jt = 0; jt < 2; ++jt) *(u32x2*)(ST + (jt * 16 + fr) * GS_SP + (16 * w + fq * 4) * 2) = (u32x2){pack2(sacc[jt][0], sacc[jt][1]), pack2(sacc[jt][2], sacc[jt][3])};
  lds_barrier();
}
__device__ __forceinline__ void gdn_oflush(const float* OB, float* O32, int n_last, int h, int j0, int tid) {
#pragma unroll
  for (int i = 0; i < 8; ++i) { const int e = tid + 512 * i, rowi = e >> 3, q = e & 7;
    *(f32x4*)(O32 + (size_t)((n_last - 7) * 64 + rowi) * (GDN_H * 128) + h * 128 + j0 + q * 4) = *(const f32x4*)(OB + rowi * 36 + q * 4); }
}
__device__ __forceinline__ void gdn_scan_item(const Params& p, int h, int sl, char* smem) {
  char* ST = smem; char* VT = ST + 32 * GS_SP; float* OB = (float*)(VT + 32 * GS_VP);
  float* O32 = (float*)(p.ws + OFF_O32);
  const int tid = tid_(), w = tid >> 6, lane = tid & 63, fr = lane & 15, fq = lane >> 4, j0 = sl * 32;
  { float z = 0.f; LAUNDER_V(z); for (int e = tid; e < 32 * GS_SP / 4; e += 512) ((float*)ST)[e] = z; }
  f32x4 sacc[2] = {f4zero(), f4zero()};
  GdnMRegs a0, a1, b0, b1;
  gdn_mload(a0, p.ws, h, 0, w, fr, fq, j0); gdn_mload(a1, p.ws, h, 1, w, fr, fq, j0);
  lds_barrier();
#pragma unroll 1
  for (int n = 0; n < NCH; n += 4) {
    DRAIN_VM();
    gdn_mload(b0, p.ws, h, n + 2, w, fr, fq, j0); gdn_mload(b1, p.ws, h, n + 3, w, fr, fq, j0);
    gdn_mstep(a0, sacc, ST, VT, OB, n, h, j0, w, fr, fq);
    gdn_mstep(a1, sacc, ST, VT, OB, n + 1, h, j0, w, fr, fq);
    DRAIN_VM();
    { const int m0 = (n + 4 < NCH) ? n + 4 : n, m1 = (n + 5 < NCH) ? n + 5 : n + 1;
      gdn_mload(a0, p.ws, h, m0, w, fr, fq, j0); gdn_mload(a1, p.ws, h, m1, w, fr, fq, j0); }
    gdn_mstep(b0, sacc, ST, VT, OB, n + 2, h, j0, w, fr, fq);
    gdn_mstep(b1, sacc, ST, VT, OB, n + 3, h, j0, w, fr, fq);
    if ((n & 7) == 4) gdn_oflush(OB, O32, n + 3, h, j0, tid);
  }
}
__device__ __forceinline__ void gdn_final(const Params& p, int j, int bid, int nb) {
  const float* H32 = (const float*)(p.ws + OFF_H32); const float* O32 = (const float*)(p.ws + OFF_O32); bf16_t* CAT = (bf16_t*)(p.ws + OFF_CAT);
  const int grp = tid_() >> 5, l = tid_() & 31;
  const f32x4 ng = *(const f32x4*)(p.gdn_norm_g + (size_t)j * 128 + l * 4);
  for (int it = bid * 16 + grp; it < SEQ * GDN_H; it += nb * 16) {
    const int t = it / GDN_H, h = it % GDN_H;
    const f32x4 o = *(const f32x4*)(O32 + (size_t)t * (GDN_H * 128) + h * 128 + l * 4), z = *(const f32x4*)(H32 + (size_t)t * OD_LD + OD_Z + h * 128 + l * 4);
    float ss = o[0] * o[0] + o[1] * o[1] + o[2] * o[2] + o[3] * o[3];
    ss += __shfl_xor(ss, 1); ss += __shfl_xor(ss, 2); ss += __shfl_xor(ss, 4); ss += __shfl_xor(ss, 8); ss += __shfl_xor(ss, 16);
    const float r = rsqrtf(ss * (1.f / 128.f) + 1e-6f); const f32x4 v = o * r * ng;
    *(u32x2*)(CAT + (size_t)t * ODD_OUT + h * 128 + l * 4) = (u32x2){pack2(v[0] * siluf_(z[0]), v[1] * siluf_(z[1])), pack2(v[2] * siluf_(z[2]), v[3] * siluf_(z[3]))};
  }
}

template <bool OUT> __device__ __forceinline__ void s5_item(const Params& p, int j, int g, int oct, char* smem) {
  constexpr int XP = 68;
  const float* H32 = (const float*)(p.ws + OFF_H32); const float* C = (const float*)(p.ws + OFF_S5C + j * SZ_S5C1); f32x2* XEND = (f32x2*)(p.ws + OFF_XEND); bf16_t* YS = (bf16_t*)(p.ws + OFF_YS);
  float* XR = (float*)smem; float* XI = XR + 8 * 16 * XP; float* US = XI + 8 * 16 * XP;
  const int tid = tid_(), w = tid >> 6, lane = tid & 63, n = oct * 8 + w, gp = g * S5_P + lane, fr = lane & 15, fq = lane >> 4;
  { const float* up = H32 + (size_t)(n * 64 + lane) * OD_LD + OD_U + g * 16; float* ud = US + (w * 64 + lane) * 16;
#pragma unroll
    for (int c = 0; c < 16; c += 4) *(f32x4*)(ud + c) = *(const f32x4*)(up + c); }
  bf16x8 cf[4];
  if (OUT) {
#pragma unroll
    for (int kk = 0; kk < 4; ++kk) { const float* cp = ((kk < 2) ? p.s5_c_re : p.s5_c_im) + (((size_t)j * S5_G + g) * 16 + fr) * 64 + (kk & 1) * 32 + fq * 8;
      const f32x4 c0 = *(const f32x4*)cp, c1 = *(const f32x4*)(cp + 4); const float sg = (kk < 2) ? 1.f : -1.f;
      u32x4 pk; pk[0] = pack2(sg * c0[0], sg * c0[1]); pk[1] = pack2(sg * c0[2], sg * c0[3]); pk[2] = pack2(sg * c1[0], sg * c1[1]); pk[3] = pack2(sg * c1[2], sg * c1[3]); __builtin_memcpy(&cf[kk], &pk, 16); } }
  const float ar = C[gp], ai = C[S5_G * S5_P + gp];
  float bbr[16], bbi[16];
#pragma unroll
  for (int c = 0; c < 16; c += 4) { const f32x4 a = *(const f32x4*)(C + 4 * S5_G * S5_P + (size_t)gp * 16 + c), b = *(const f32x4*)(C + 20 * S5_G * S5_P + (size_t)gp * 16 + c);
    bbr[c] = a[0]; bbr[c + 1] = a[1]; bbr[c + 2] = a[2]; bbr[c + 3] = a[3]; bbi[c] = b[0]; bbi[c + 1] = b[1]; bbi[c + 2] = b[2]; bbi[c + 3] = b[3]; }
  float xr = 0.f, xi = 0.f;
  if (OUT) { const float a64r = C[2 * S5_G * S5_P + gp], a64i = C[3 * S5_G * S5_P + gp];
#pragma unroll 1
    for (int m0 = 0; m0 < n; m0 += 16) { f32x2 xe[16];
#pragma unroll
      for (int k = 0; k < 16; ++k) xe[k] = XEND[(size_t)(((m0 + k < n) ? m0 + k : 0) * S5_G + g) * S5_P + lane];
#pragma unroll
      for (int k = 0; k < 16; ++k) if (m0 + k < n) { const float nr = a64r * xr - a64i * xi + xe[k][0], ni = a64r * xi + a64i * xr + xe[k][1]; xr = nr; xi = ni; } } }
  __syncthreads();
#pragma unroll 1
  for (int slab = 0; slab < 4; ++slab) {
#pragma unroll 2
    for (int tt = 0; tt < 16; ++tt) {
      const float* up = US + (w * 64 + slab * 16 + tt) * 16; float br = 0.f, bi = 0.f;
#pragma unroll
      for (int c = 0; c < 16; c += 4) { const f32x4 u4 = *(const f32x4*)(up + c);
#pragma unroll
        for (int e = 0; e < 4; ++e) { br += bbr[c + e] * u4[e]; bi += bbi[c + e] * u4[e]; } }
      const float nr = ar * xr - ai * xi + br, ni = ar * xi + ai * xr + bi; xr = nr; xi = ni;
      if (OUT) { XR[(w * 16 + tt) * XP + lane] = xr; XI[(w * 16 + tt) * XP + lane] = xi; }
    }
    if (OUT) {
      __syncthreads();
      f32x4 y = f4zero();
#pragma unroll
      for (int kk = 0; kk < 4; ++kk) { const float* xp = ((kk < 2) ? XR : XI) + (w * 16 + fr) * XP + (kk & 1) * 32 + fq * 8;
        const f32x4 x0 = *(const f32x4*)xp, x1 = *(const f32x4*)(xp + 4);
        u32x4 pk; pk[0] = pack2(x0[0], x0[1]); pk[1] = pack2(x0[2], x0[3]); pk[2] = pack2(x1[0], x1[1]); pk[3] = pack2(x1[2], x1[3]); bf16x8 xf; __builtin_memcpy(&xf, &pk, 16);
        y = __builtin_amdgcn_mfma_f32_16x16x32_bf16(cf[kk], xf, y, 0, 0, 0); }
      const int t = n * 64 + slab * 16 + fr;
      const f32x4 u4 = *(const f32x4*)(US + (w * 64 + slab * 16 + fr) * 16 + fq * 4), d4 = *(const f32x4*)(p.s5_d + ((size_t)j * S5_G + g) * 16 + fq * 4);
      y += d4 * u4;
      *(u32x2*)(YS + (size_t)t * S5_CH + g * 16 + fq * 4) = (u32x2){pack2(geluf_(y[0]), geluf_(y[1])), pack2(geluf_(y[2]), geluf_(y[3]))};
      __syncthreads();
    }
  }
  if (!OUT) XEND[(size_t)(n * S5_G + g) * S5_P + lane] = (f32x2){xr, xi};
}

__device__ __forceinline__ void s5_carry(const Params& p, int j, int bid, int nb) {
  const float* C = (const float*)(p.ws + OFF_S5C + j * SZ_S5C1); const f32x2* __restrict__ XEND = (const f32x2*)(p.ws + OFF_XEND); f32x2* __restrict__ CARRY = (f32x2*)(p.ws + OFF_CARRY);
  for (int e = bid * 512 + tid_(); e < S5_G * S5_P; e += nb * 512) {
    const float a64r = C[2 * S5_G * S5_P + e], a64i = C[3 * S5_G * S5_P + e]; float xr = 0.f, xi = 0.f;
#pragma unroll 1
    for (int n0 = 0; n0 < NCH; n0 += 16) { f32x2 xe[16];
#pragma unroll
      for (int k = 0; k < 16; ++k) xe[k] = XEND[(size_t)(n0 + k) * S5_G * S5_P + e];
#pragma unroll
      for (int k = 0; k < 16; ++k) { CARRY[(size_t)(n0 + k) * S5_G * S5_P + e] = (f32x2){xr, xi}; const float nr = a64r * xr - a64i * xi + xe[k][0], ni = a64r * xi + a64i * xr + xe[k][1]; xr = nr; xi = ni; } }
  }
}

__device__ __forceinline__ void glr_pass(const bf16_t* XB, const bf16_t* Wg, float* H32, int bid, int nb) {
  const int w = tid_() >> 6, lane = tid_() & 63, fr = lane & 15, fq = lane >> 4;
  for (int tile = bid * 8 + w; tile < SEQ / 16; tile += nb * 8) {
    const bf16_t* ap = XB + (size_t)(tile * 16 + fr) * DM + fq * 8; const bf16_t* bp = Wg + (size_t)fr * DM + fq * 8;
    f32x4 acc = f4zero();
#pragma unroll 8
    for (int kk = 0; kk < DM / 32; ++kk) { const bf16x8 a = *(const bf16x8*)(ap + kk * 32), b = *(const bf16x8*)(bp + kk * 32); acc = __builtin_amdgcn_mfma_f32_16x16x32_bf16(a, b, acc, 0, 0, 0); }
#pragma unroll
    for (int jj = 0; jj < 4; ++jj) H32[(size_t)(tile * 16 + fq * 4 + jj) * EV_LD + EV_GLR + fr] = acc[jj];
  }
}

#ifndef EMU
__device__ __forceinline__ void subgrid_barrier(unsigned* cnt, unsigned count, unsigned* tmo) {
  asm volatile("s_waitcnt vmcnt(0)" ::: "memory");
  __syncthreads();
  if (threadIdx.x == 0) {
    __builtin_amdgcn_fence(__ATOMIC_RELEASE, "agent");
    asm volatile("s_waitcnt vmcnt(0)" ::: "memory");
    __hip_atomic_fetch_add(cnt, 1u, __ATOMIC_RELAXED, __HIP_MEMORY_SCOPE_AGENT);
    unsigned sp = 0;
    while (__hip_atomic_load(cnt, __ATOMIC_RELAXED, __HIP_MEMORY_SCOPE_AGENT) < count) { __builtin_amdgcn_s_sleep(1);
      if ((++sp & 255u) == 0u) { if (__hip_atomic_load(tmo, __ATOMIC_RELAXED, __HIP_MEMORY_SCOPE_AGENT)) break; if (sp > (1u << 18)) { atomicAdd(tmo, 1u); break; } } }
    __builtin_amdgcn_fence(__ATOMIC_ACQUIRE, "agent");
    asm volatile("s_waitcnt vmcnt(0)" ::: "memory");
  }
  __syncthreads();
}
#else
__device__ __forceinline__ void subgrid_barrier(unsigned*, unsigned, unsigned*) {}
#endif

#ifdef EMU
#define SUBGRID_GLU()
#else
#define SUBGRID_GLU() do { subgrid_barrier((unsigned*)(ws + OFF_BAR) + 3600 + 64 * L, (unsigned)(nb - NSCAN), (unsigned*)(ws + OFF_BAR) + 128); \
    EpiGlu E{(const bf16_t*)(ws + OFF_YS), p.s5_glu_b + (size_t)j * S5_CH, CAT}; run_gemm(smem, (const bf16_t*)(ws + OFF_YS), (const bf16_t*)(ws + OFF_WGLU + j * SZ_WGLU), S5_CH, S5_CH, E, bid - NSCAN, nb - NSCAN); } while (0)
#endif
__device__ __forceinline__ bool run_step(const Params& p, int step, char* smem, int bid, int nb) {
  LAUNDER_S(bid); LAUNDER_S(nb);
  char* ws = p.ws;
  if (step == 0) { step_prep(p, smem, bid, nb); return true; }
  const int L = (step - 1) / STEPS_PER_LAYER, s = (step - 1) % STEPS_PER_LAYER, j = L >> 1; const bool even = (L & 1) == 0;
  bf16_t* XB = (bf16_t*)(ws + OFF_XB); float* X32 = (float*)(ws + OFF_X32); float* Y32 = (float*)(ws + OFF_Y32); float* H32 = (float*)(ws + OFF_H32); bf16_t* CAT = (bf16_t*)(ws + OFF_CAT);
  float* stats_mix = (float*)(ws + OFF_STATS) + (size_t)(L * 2) * SEQ * 2; float* stats_ffn = stats_mix + (size_t)SEQ * 2;
  switch (s) {
    case 0:
      if (even) { EpiEvenIn E{H32, (bf16_t*)(ws + OFF_MQ), (bf16_t*)(ws + OFF_MK), (bf16_t*)(ws + OFF_MVT)}; run_gemm(smem, XB, (const bf16_t*)(ws + OFF_WINE + j * SZ_WINE), EVEN_NMAIN, DM, E, bid, nb);
        glr_pass(XB, (const bf16_t*)(ws + OFF_WINE + j * SZ_WINE) + (size_t)EVEN_NMAIN * DM, H32, bid, nb); }
      else { EpiOddIn E{H32}; run_gemm(smem, XB, (const bf16_t*)(ws + OFF_WINO + j * SZ_WINO), ODD_NP, DM, E, bid, nb); }
      return true;
    case 1:
      if (even) {
        for (int it = bid; it < GLA_H * NCH; it += nb) gla_kv_item(p, j, it % GLA_H, it / GLA_H, smem);
        for (int it = bid; it < MOBA_H * NBLK; it += nb) moba_kmean_item(p, it % MOBA_H, it / MOBA_H, smem);
        if (bid == 0 && tid_() < MOBA_H * NBLK) ((unsigned*)(ws + OFF_MCNT))[tid_()] = 0u;
      } else {
        for (int it = bid; it < GDN_H * NCH; it += nb) gdn_local_item(p, j, it % GDN_H, it / GDN_H, smem);
        for (int it = bid; it < S5_G * (NCH / 8); it += nb) { s5_item<false>(p, j, it % S5_G, it / S5_G, smem); __syncthreads(); }
      }
      return true;
    case 2:
      if (even) {
        gla_scan(p, bid, nb);
        for (int it = nb - 1 - bid; it < MOBA_H * NCH; it += nb) moba_tile<false>(p, it % MOBA_H, NCH - 1 - it / MOBA_H, 0, 0, smem);
      } else {
        constexpr int NSCAN = GDN_H * 4;
        if (nb > 2 * NSCAN) {
          if (bid < NSCAN) gdn_scan_item(p, bid % GDN_H, bid / GDN_H, smem);
          else { for (int it = bid - NSCAN; it < S5_G * (NCH / 8); it += nb - NSCAN) { s5_item<true>(p, j, it % S5_G, it / S5_G, smem); __syncthreads(); }
            SUBGRID_GLU();
            conv_group(p, L, smem, bid - NSCAN, nb - NSCAN); }
        } else {
          for (int it = bid; it < NSCAN; it += nb) gdn_scan_item(p, it % GDN_H, it / GDN_H, smem);
          for (int it = bid; it < S5_G * (NCH / 8); it += nb) { s5_item<true>(p, j, it % S5_G, it / S5_G, smem); __syncthreads(); }
          conv_group(p, L, smem, bid, nb);
        }
      }
      return true;
    case 3:
      if (even) { for (int it = bid; it < GLA_H * NCH; it += nb) gla_out_item(p, j, it % GLA_H, it / GLA_H, smem); moba_gathered(p, smem, bid, nb); }
      else {
        gdn_final(p, j, bid, nb);
      }
      return true;
    case 4:
      if (even) { moba_combine(p, bid, nb); return true; }
      if (GLU_IN_WINDOW && nb > 2 * GDN_H * 4) return false;
      { EpiGlu E{(const bf16_t*)(ws + OFF_YS), p.s5_glu_b + (size_t)j * S5_CH, CAT}; run_gemm(smem, (const bf16_t*)(ws + OFF_YS), (const bf16_t*)(ws + OFF_WGLU + j * SZ_WGLU), S5_CH, S5_CH, E, bid, nb); }
      return true;
    case 5: {
      const float* pst = stats_mix - (size_t)SEQ * 2;
      EpiRes E{L == 0 ? p.x : nullptr, pst, p.ln_ffn_g + (size_t)(L > 0 ? L - 1 : 0) * DM, p.ln_ffn_b + (size_t)(L > 0 ? L - 1 : 0) * DM, Y32, stats_mix};
      if (even) run_gemm(smem, CAT, (const bf16_t*)(ws + OFF_WOUTE + j * SZ_WOUTE), DM, EVEN_OUT, E, bid, nb);
      else run_gemm(smem, CAT, (const bf16_t*)(ws + OFF_WOUTO + j * SZ_WOUTO), DM, ODD_OUT, E, bid, nb);
      return true; }
    case 6: step_ln(Y32, stats_mix, p.ln_mix_g + (size_t)L * DM, p.ln_mix_b + (size_t)L * DM, nullptr, XB, bid, nb); return true;
    case 7: { EpiBf16 E{(bf16_t*)(ws + OFF_H16), 2 * DFF}; run_gemm(smem, XB, (const bf16_t*)(ws + OFF_WUP + L * SZ_WUP), 2 * DFF, DM, E, bid, nb); return true; }
    case 8: step_ffn_conv((const bf16_t*)(ws + OFF_H16), p.ffn_conv_w + (size_t)L * 3 * 2 * DFF, (bf16_t*)(ws + OFF_G16), bid, nb); return true;
    case 9: { EpiRes E{nullptr, stats_mix, p.ln_mix_g + (size_t)L * DM, p.ln_mix_b + (size_t)L * DM, Y32, stats_ffn}; run_gemm(smem, (const bf16_t*)(ws + OFF_G16), (const bf16_t*)(ws + OFF_WDN + L * SZ_WDN), DM, DFF, E, bid, nb); return true; }
    case 10: step_ln(Y32, stats_ffn, p.ln_ffn_g + (size_t)L * DM, p.ln_ffn_b + (size_t)L * DM, (L == DEPTH - 1) ? p.out : nullptr, XB, bid, nb); return true;
  }
  return false;
}

#ifndef EMU
#define XB_TMO      128
#define XB_XCNT(j)  (256  + 64 * (j))
#define XB_XSUB(j)  (1280 + 64 * (j))
#define XB_XGEN(j)  (2304 + 64 * (j))
#define XB_TOP      3328
#define XB_TOPGEN   3392
#define XCD_BAR_WORDS 3456
#define XB_SPIN_CAP (1u << 18)
#define LAS __attribute__((address_space(3)))
__device__ __forceinline__ unsigned xb_ld(unsigned* p)              { return __hip_atomic_load(p, __ATOMIC_RELAXED, __HIP_MEMORY_SCOPE_AGENT); }
__device__ __forceinline__ unsigned xb_add(unsigned* p, unsigned v) { return __hip_atomic_fetch_add(p, v, __ATOMIC_RELAXED, __HIP_MEMORY_SCOPE_AGENT); }
__device__ __forceinline__ unsigned xb_xcc_id() { return (unsigned)__builtin_amdgcn_s_getreg((3 << 11) | 20) & 0xFu; }
#define XB_SPIN(cond, bar) do { unsigned _sp = 0; while (cond) { __builtin_amdgcn_s_sleep(1); \
    if ((++_sp & 255u) == 0u) { if (xb_ld(&(bar)[XB_TMO])) break; if (_sp > XB_SPIN_CAP) { atomicAdd(&(bar)[XB_TMO], 1u); break; } } } } while (0)
__device__ __forceinline__ void xcd_barrier_complete(unsigned* bar, unsigned x, unsigned& nloc, unsigned& nx) {
  const unsigned G = gridDim.x;
  unsigned sum, cnt, mine, sp = 0u;
  for (;;) {
    sum = 0u; cnt = 0u; mine = 0u;
#pragma unroll
    for (unsigned j = 0; j < 16; ++j) { const unsigned c = xb_ld(&bar[XB_XCNT(j)]); sum += c; cnt += (c > 0u) ? 1u : 0u; mine = (j == x) ? c : mine; }
    if (sum == G) break;
    __builtin_amdgcn_s_sleep(1);
    if ((++sp & 255u) == 0u) { if (xb_ld(&bar[XB_TMO])) break; if (sp > XB_SPIN_CAP) { atomicAdd(&bar[XB_TMO], 1u); break; } }
  }
  nloc = mine > 0u ? mine : 1u; nx = cnt > 0u ? cnt : 1u;
}
__device__ __forceinline__ void xcd_barrier(unsigned* bar, volatile LAS unsigned* st) {
  asm volatile("s_waitcnt vmcnt(0)" ::: "memory");
  __syncthreads();
  if (threadIdx.x == 0) {
    const unsigned x = xb_xcc_id();
    __builtin_amdgcn_s_waitcnt(0);
    unsigned nloc = st[0], nx = st[1];
    if (nloc == 0u) { xcd_barrier_complete(bar, x, nloc, nx); st[0] = nloc; st[1] = nx; }
    const unsigned old = xb_add(&bar[XB_XSUB(x)], 1u);
    const unsigned gen = old / nloc;
    if (old + 1u == (gen + 1u) * nloc) {
      __builtin_amdgcn_fence(__ATOMIC_RELEASE, "agent");
      asm volatile("s_waitcnt vmcnt(0)" ::: "memory");
      const unsigned og = xb_add(&bar[XB_TOP], 1u);
      const unsigned tg = og / nx;
      if (og + 1u == (tg + 1u) * nx) xb_add(&bar[XB_TOPGEN], 1u);
      else XB_SPIN(xb_ld(&bar[XB_TOPGEN]) == tg, bar);
      __builtin_amdgcn_fence(__ATOMIC_ACQUIRE, "agent");
      xb_add(&bar[XB_XGEN(x)], 1u);
      asm volatile("s_waitcnt vmcnt(0)" ::: "memory");
    } else {
      XB_SPIN(xb_ld(&bar[XB_XGEN(x)]) == gen, bar);
      __builtin_amdgcn_fence(__ATOMIC_ACQUIRE, "agent");
      asm volatile("s_waitcnt vmcnt(0)" ::: "memory");
    }
  }
  __syncthreads();
}

typedef __attribute__((address_space(4))) const Params* KParamsPtr;
__global__ void __launch_bounds__(512, 2) hybrid_megakernel(Params p_unused) {
  extern __shared__ __attribute__((aligned(16))) char smem[];
  __shared__ uint4 xb_words;
  cg::grid_group grid = cg::this_grid();
  const int bid = blockIdx.x, nb = gridDim.x;
  KParamsPtr q0 = (KParamsPtr)__builtin_amdgcn_kernarg_segment_ptr();
  const int sb = q0->step_begin, se = q0->step_end;
  if (threadIdx.x == 0) { xb_words = make_uint4(0u, 0u, 0u, 0u); (void)xb_add(&((unsigned*)(q0->ws + OFF_BAR))[XB_XCNT(xb_xcc_id())], 1u); }
  __syncthreads();
#ifdef PROBE_MASK
  __shared__ unsigned long long tacc_s[2];
  if (threadIdx.x == 0) tacc_s[0] = 0;
#endif
  for (int s = sb; s < se; ++s) {
    KParamsPtr q = q0; asm volatile("" : "+s"(q));
    Params lp; __builtin_memcpy(&lp, q, sizeof(Params));
#ifdef PROBE_MASK
    const unsigned long long t0 = wall_clock64();
#endif
    const bool did = run_step(lp, s, smem, bid, nb);
#ifdef PROBE_MASK
    const bool more = true;
#else
    const bool more = s + 1 < se;
#endif
    if (did && more) {
      if (s == sb) grid.sync();
      else xcd_barrier((unsigned*)(q0->ws + OFF_BAR), (volatile LAS unsigned*)&xb_words);
    }
#ifdef PROBE_MASK
    { const unsigned long long t1 = wall_clock64(); const int bit = (s == 0) ? 22 : (((s - 1) / STEPS_PER_LAYER) & 1) * 11 + (s - 1) % STEPS_PER_LAYER;
      if (((PROBE_MASK >> bit) & 1u) && threadIdx.x == 0) tacc_s[0] += t1 - t0; }
#endif
  }
#ifdef PROBE_MASK
  __syncthreads();
  if (bid == 0) { const unsigned n = (unsigned)(tacc_s[0] / 20); float* out = q0->out;
    for (unsigned i = threadIdx.x; i < n; i += 512) out[((size_t)i * 271) % ((size_t)SEQ * DM)] += 0.1f; }
#endif
}

extern "C" void kernel_launch(void* const* d_in, const int* in_sizes, int n_in, void* d_out, int out_size, void* d_ws, size_t ws_size, hipStream_t stream) {
  static int grid_blocks = 0;
  if (!grid_blocks) {
    int dev = 0, cus = 0, per_cu = 0;
    hipGetDevice(&dev);
    hipDeviceGetAttribute(&cus, hipDeviceAttributeMultiprocessorCount, dev);
    hipFuncSetAttribute((const void*)hybrid_megakernel, hipFuncAttributeMaxDynamicSharedMemorySize, LDS_BYTES);
    hipOccupancyMaxActiveBlocksPerMultiprocessor(&per_cu, hybrid_megakernel, 512, LDS_BYTES);
    if (per_cu < 1) per_cu = 1;
    if (per_cu > 1) per_cu = 1;
    grid_blocks = cus * per_cu;
  }
  if (ws_size < WS_NEEDED) { fprintf(stderr, "workspace too small: %zu < %zu\n", ws_size, (size_t)WS_NEEDED); return; }
  Params p{};
  const float** pp = (const float**)&p;
  for (int i = 0; i < 29; ++i) pp[i] = (const float*)d_in[i];
  p.out = (float*)d_out; p.ws = (char*)d_ws; p.step_begin = 0; p.step_end = N_STEPS;
  hipMemsetAsync((char*)d_ws + OFF_BAR, 0, SZ_BAR, stream);
  void* args[] = {&p};
  hipError_t e = hipLaunchCooperativeKernel((const void*)hybrid_megakernel, dim3(grid_blocks), dim3(512), args, LDS_BYTES, stream);
  if (e != hipSuccess) fprintf(stderr, "cooperative launch failed: %s (grid %d)\n", hipGetErrorString(e), grid_blocks);
}
#endif
```

```cpp
#ifdef EMU
#include "emu.h"
#else
#include <hip/hip_runtime.h>
#include <hip/hip_cooperative_groups.h>
#include <cstdio>
namespace cg = cooperative_groups;
#endif

typedef unsigned short bf16_t;
typedef short bf16x8 __attribute__((ext_vector_type(8)));
typedef float f32x4 __attribute__((ext_vector_type(4)));
typedef float f32x2 __attribute__((ext_vector_type(2)));
typedef unsigned u32x4 __attribute__((ext_vector_type(4)));
typedef unsigned u32x2 __attribute__((ext_vector_type(2)));

#ifdef EMU_SMALL
constexpr int SEQ = EMU_SEQ, DM = 256, DEPTH = 2, GLA_H = 2, MOBA_H = 2, GDN_H = 2, S5_CH = 256, DFF = 512;
constexpr float ALPHA = 1.4142135623730951f;
#else
constexpr int SEQ = 8192, DM = 2048, DEPTH = 4, GLA_H = 8, MOBA_H = 8, GDN_H = 8, S5_CH = 1024, DFF = 5632;
constexpr float ALPHA = 1.681792830507429f;
#endif
constexpr int N_EVEN = (DEPTH + 1) / 2, N_ODD = DEPTH / 2;
constexpr int NCH = SEQ / 64, NBLK = SEQ / 256;
constexpr int S5_G = S5_CH / 16, S5_P = 64;
constexpr int EV_GQ = 0, EV_GK = GLA_H * 64, EV_GV = 2 * GLA_H * 64, EV_GLR = EV_GV + GLA_H * 128, EV_GR = EV_GLR + 16,
              EV_MQ = EV_GR + GLA_H * 128, EV_MK = EV_MQ + MOBA_H * 128, EV_MV = EV_MK + MOBA_H * 128, EVEN_IN = EV_MV + MOBA_H * 128;
constexpr int EV_LD = EV_MQ;
constexpr int OD_QKV = 0, OD_Z = 3 * GDN_H * 128, OD_BETA = OD_Z + GDN_H * 128, OD_DEC = OD_BETA + GDN_H, OD_U = OD_DEC + GDN_H, ODD_IN = OD_U + S5_CH;
constexpr int OD_LD = ODD_IN;
constexpr int EVEN_OUT = GLA_H * 128 + MOBA_H * 128, ODD_OUT = GDN_H * 128 + S5_CH;
constexpr int EVEN_NMAIN = EVEN_IN - 16;
static_assert(EVEN_NMAIN % 256 == 0, "even projection main part must tile by 256");
constexpr int EVEN_NP = EVEN_NMAIN + 256, ODD_NP = ((ODD_IN + 255) / 256) * 256;
constexpr int MQ_LD = MOBA_H * 128;
constexpr int STEPS_PER_LAYER = 11, N_STEPS = 1 + DEPTH * STEPS_PER_LAYER;
constexpr int LDS_BYTES = 143360;
#ifdef EMU
constexpr bool GLU_IN_WINDOW = false;
#else
constexpr bool GLU_IN_WINDOW = true;
#endif

constexpr size_t al256(size_t x) { return (x + 255) & ~(size_t)255; }
constexpr size_t cmax(size_t a, size_t b) { return a > b ? a : b; }
constexpr size_t SZ_WINE = al256((size_t)EVEN_NP * DM * 2), SZ_WOUTE = al256((size_t)DM * EVEN_OUT * 2), SZ_WINO = al256((size_t)ODD_NP * DM * 2),
                 SZ_WGLU = al256((size_t)S5_CH * S5_CH * 2), SZ_WOUTO = al256((size_t)DM * ODD_OUT * 2), SZ_WUP = al256((size_t)2 * DFF * DM * 2), SZ_WDN = al256((size_t)DM * DFF * 2);
constexpr size_t OFF_WINE = 0, OFF_WOUTE = OFF_WINE + N_EVEN * SZ_WINE, OFF_WINO = OFF_WOUTE + N_EVEN * SZ_WOUTE, OFF_WGLU = OFF_WINO + N_ODD * SZ_WINO,
                 OFF_WOUTO = OFF_WGLU + N_ODD * SZ_WGLU, OFF_WUP = OFF_WOUTO + N_ODD * SZ_WOUTO, OFF_WDN = OFF_WUP + DEPTH * SZ_WUP, OFF_ACT = OFF_WDN + DEPTH * SZ_WDN;
constexpr size_t SZ_XB = al256((size_t)SEQ * DM * 2), SZ_X32 = al256((size_t)SEQ * DM * 4), SZ_H32 = al256((size_t)SEQ * cmax(EV_LD, OD_LD) * 4),
                 SZ_CAT = al256((size_t)SEQ * cmax(EVEN_OUT, ODD_OUT) * 2), SZ_STATS = al256((size_t)DEPTH * 2 * SEQ * 2 * 4),
                 SZ_S5C1 = al256((size_t)36 * S5_G * S5_P * 4), SZ_KMEAN = al256((size_t)MOBA_H * NBLK * 128 * 4);
constexpr size_t OFF_BAR = OFF_ACT, SZ_BAR = 16384;
constexpr size_t OFF_XB = OFF_BAR + SZ_BAR, OFF_X32 = OFF_XB + SZ_XB, OFF_Y32 = OFF_X32 + SZ_X32, OFF_H32 = OFF_Y32 + SZ_X32, OFF_CAT = OFF_H32 + SZ_H32, OFF_STATS = OFF_CAT + SZ_CAT,
                 OFF_S5C = OFF_STATS + SZ_STATS, OFF_KMEAN = OFF_S5C + N_ODD * SZ_S5C1, OFF_SCR = OFF_KMEAN + SZ_KMEAN;
constexpr size_t SZ_H16 = al256((size_t)SEQ * 2 * DFF * 2), SZ_G16 = al256((size_t)SEQ * DFF * 2);
constexpr size_t OFF_H16 = OFF_SCR, OFF_G16 = OFF_H16 + SZ_H16, END_FFN = OFF_G16 + SZ_G16;
constexpr size_t SZ_MQ = al256((size_t)SEQ * MQ_LD * 2), SZ_KVS = al256((size_t)GLA_H * NCH * 64 * 128 * 4), SZ_DEC = al256((size_t)GLA_H * NCH * 64 * 4);
constexpr size_t OFF_MQ = OFF_SCR, OFF_MK = OFF_MQ + SZ_MQ, OFF_MVT = OFF_MK + SZ_MQ, OFF_KVS = OFF_MVT + SZ_MQ, OFF_DEC = OFF_KVS + SZ_KVS, OFF_SPV = OFF_DEC + SZ_DEC, OFF_MCNT = OFF_SPV + SZ_KVS, OFF_MLIST = OFF_MCNT + 4096, OFF_PO = OFF_MLIST + al256((size_t)MOBA_H * NBLK * SEQ * 4),
                 OFF_PML = OFF_PO + al256((size_t)MOBA_H * SEQ * 4 * 128 * 4), END_EVEN = OFF_PML + al256((size_t)MOBA_H * SEQ * 4 * 2 * 4);
constexpr size_t SZ_GD = al256((size_t)GDN_H * NCH * 64 * 128 * 4), SZ_ATT = al256((size_t)GDN_H * NCH * 64 * 64 * 4), SZ_EGL = al256((size_t)GDN_H * NCH * 4),
                 SZ_O32 = al256((size_t)SEQ * GDN_H * 128 * 4), SZ_XEND = al256((size_t)NCH * S5_G * S5_P * 2 * 4), SZ_YS = al256((size_t)SEQ * S5_CH * 2);
constexpr size_t OFF_GU_ = 0;
constexpr size_t OFF_GU = OFF_SCR, OFF_GW = OFF_GU + SZ_GD, OFF_GQD = OFF_GW + SZ_GD, OFF_GKD = OFF_GQD + SZ_GD, OFF_ATT = OFF_GKD + SZ_GD, OFF_EGL = OFF_ATT + SZ_ATT,
                 OFF_O32 = OFF_EGL + SZ_EGL, OFF_XEND = OFF_O32 + SZ_O32, OFF_YS = OFF_XEND + SZ_XEND, OFF_CARRY = OFF_YS + SZ_YS, END_ODD = OFF_CARRY + SZ_XEND;
constexpr size_t WS_NEEDED = cmax(END_FFN, cmax(END_EVEN, END_ODD));

struct Params {
  const float *x, *even_w_in, *gla_w_gate2, *gla_b_gate, *gla_norm_g, *even_w_out, *odd_w_in, *gdn_conv_w, *gdn_a_log, *gdn_dt_bias, *gdn_norm_g,
      *s5_a_re, *s5_a_im, *s5_b_re, *s5_b_im, *s5_c_re, *s5_c_im, *s5_d, *s5_log_step, *s5_glu_w, *s5_glu_b, *odd_w_out, *ln_mix_g, *ln_mix_b,
      *ffn_w_up, *ffn_conv_w, *ffn_w_down, *ln_ffn_g, *ln_ffn_b;
  float* out; char* ws; int step_begin, step_end;
};

#ifdef EMU
__device__ __forceinline__ int tid_() { return threadIdx.x; }
#define LAUNDER_S(x)
#define SCHED_FENCE()
#define LAUNDER_V(x)
#define DRAIN_VM()
__device__ __forceinline__ void lds_barrier() { __syncthreads(); }
#else
__device__ __forceinline__ void lds_barrier() { asm volatile("s_waitcnt lgkmcnt(0)\n\ts_barrier" ::: "memory"); }
__device__ __forceinline__ int tid_() { int t = threadIdx.x; asm volatile("" : "+v"(t)); return t; }
#define LAUNDER_S(x) asm volatile("" : "+s"(x))
#define DRAIN_VM() __builtin_amdgcn_s_waitcnt(0x0F70)
#define SCHED_FENCE() __builtin_amdgcn_sched_barrier(0)
#define LAUNDER_V(x) asm volatile("" : "+v"(x))
#endif

__device__ __forceinline__ bf16_t f2bf(float f) { unsigned u = __float_as_uint(f); u += 0x7FFFu + ((u >> 16) & 1u); return (bf16_t)(u >> 16); }
__device__ __forceinline__ float bf2f(bf16_t b) { return __uint_as_float(((unsigned)b) << 16); }
#ifdef EMU
__device__ __forceinline__ unsigned pack2(float lo, float hi) { return (unsigned)f2bf(lo) | ((unsigned)f2bf(hi) << 16); }
#else
typedef __bf16 bf16v2_t __attribute__((ext_vector_type(2)));
__device__ __forceinline__ unsigned pack2(float lo, float hi) { const bf16v2_t v = __builtin_convertvector((f32x2){lo, hi}, bf16v2_t); return __builtin_bit_cast(unsigned, v); }
#endif
__device__ __forceinline__ float sigmoidf_(float x) { return 1.f / (1.f + __expf(-x)); }
__device__ __forceinline__ float siluf_(float x) { return x / (1.f + __expf(-x)); }
__device__ __forceinline__ float softplusf_(float x) { return fmaxf(x, 0.f) + log1pf(__expf(-fabsf(x))); }
__device__ __forceinline__ float geluf_(float x) { float u = 0.7978845608028654f * (x + 0.044715f * x * x * x); float e = __expf(2.f * u); float th = 1.f - 2.f / (e + 1.f); return 0.5f * x * (1.f + th); }
__device__ __forceinline__ f32x4 shfl_xor4(f32x4 v, int m) {
#ifdef EMU
  return __shfl_xor(v, m);
#else
  f32x4 r; r[0] = __shfl_xor(v[0], m); r[1] = __shfl_xor(v[1], m); r[2] = __shfl_xor(v[2], m); r[3] = __shfl_xor(v[3], m); return r;
#endif
}
__device__ __forceinline__ f32x4 f4zero() { return (f32x4){0.f, 0.f, 0.f, 0.f}; }
template <int CTRL> __device__ __forceinline__ float dpp_mov(float v) {
#ifdef EMU
  const int l = tid_() & 63; const int src = (CTRL == 0xB1) ? (l ^ 1) : (CTRL == 0x4E) ? (l ^ 2) : ((l & ~7) | (7 - (l & 7)));
  return __shfl(v, src);
#else
  return __builtin_bit_cast(float, __builtin_amdgcn_update_dpp(0, __builtin_bit_cast(int, v), CTRL, 0xF, 0xF, true));
#endif
}
__device__ __forceinline__ f32x4 red4_f4(f32x4 v) {
#pragma unroll
  for (int e = 0; e < 4; ++e) { v[e] += dpp_mov<0xB1>(v[e]); v[e] += dpp_mov<0x4E>(v[e]); }
  return v;
}
__device__ __forceinline__ f32x4 red8_f4(f32x4 v) {
#pragma unroll
  for (int e = 0; e < 4; ++e) { v[e] += dpp_mov<0xB1>(v[e]); v[e] += dpp_mov<0x4E>(v[e]); v[e] += dpp_mov<0x141>(v[e]); }
  return v;
}

namespace pg8 {
constexpr int BM = 256, BK = 64, HALF = 128, HTB = HALF * BK * 2, STAGE_BYTES = 8 * HTB, NXCD = 8, WGM = 8;
__host__ __device__ __forceinline__ int lds_byte(int r, int c) { const int st = (r >> 4) * 2 + (c >> 5), rr = r & 15, cc = c & 31, ob = rr * 64 + cc * 2; return st * 1024 + (ob ^ (((ob >> 9) & 1) << 5)); }
__host__ __device__ __forceinline__ void stage_rc(int b, int& R, int& C) { const int st = b / 1024, sb = b % 1024, swz = sb ^ (((sb >> 9) & 1) << 5); R = (st >> 1) * 16 + swz / 64; C = (st & 1) * 32 + (swz % 64) / 2; }
__host__ __device__ __forceinline__ int perm32(int rho) { const int n = rho >> 4, i = rho & 15; return 8 * (i >> 2) + 4 * n + (i & 3); }
struct Unit { int pm, pn; };
struct Gemm { const bf16_t* A; const bf16_t* Bt; int M, N, K; };
struct StaticOrder {
  int nM, nN, nwg, G, c;
  __host__ __device__ void init(int M, int N, int G_, int c_) { nM = M / BM; nN = N / BM; nwg = nM * nN; G = G_; c = c_; }
  __host__ __device__ bool next(int i, Unit& u) const {
    const long L = (long)i * G + c; if (L >= nwg) return false;
    int wgid = (int)L; { const int q = nwg / NXCD, r = nwg % NXCD, xcd = wgid % NXCD, off = wgid / NXCD; wgid = (xcd < r ? xcd * (q + 1) : r * (q + 1) + (xcd - r) * q) + off; }
    const int nig = WGM * nN, gid = wgid / nig, fm = gid * WGM, gsz = (nM - fm) < WGM ? (nM - fm) : WGM;
    u.pm = fm + ((wgid % nig) % gsz); u.pn = (wgid % nig) / gsz; return true;
  }
};
#ifndef EMU
#define PG8_LAS __attribute__((address_space(3)))
template <class Epi>
__device__ __forceinline__ void gemm_phase(char* smem, const Gemm g, const StaticOrder& S, const Epi& E) {
  PG8_LAS unsigned char* lds = (PG8_LAS unsigned char*)smem;
  const int tid = tid_(), wid = __builtin_amdgcn_readfirstlane(tid >> 6), lane = tid & 63, wr = wid >> 2, wc = wid & 3, fr = lane & 15, fq = lane >> 4;
  const int K = g.K, nt = K / BK;
  unsigned voffA[2], voffB[2];
#pragma unroll
  for (int i = 0; i < 2; ++i) { int R, C; stage_rc(tid * 16 + i * 8192, R, C); const int Rb = Epi::PERM ? ((R & ~31) + perm32(R & 31)) : R; voffA[i] = (unsigned)(R * K + C) * 2u; voffB[i] = (unsigned)(Rb * K + C) * 2u; }
  const size_t kstep = (size_t)(BK * 2);
  const size_t hstep = (size_t)HALF * K * 2;
  const size_t tstep = 2 * hstep;
  const unsigned ldsw = (unsigned)wid * 1024u;
  const int aoff = lds_byte(wr * 64 + fr, fq * 8), boff = lds_byte(wc * 32 + fr, fq * 8);
#define PG8_SA(b, h) (((b) * 2 + (h)) * HTB)
#define PG8_SB(b, h) ((4 + (b) * 2 + (h)) * HTB)
#define PG8_STAGE(bufoff, gbase, voff) do { _Pragma("unroll") for (int _i = 0; _i < 2; ++_i) \
    __builtin_amdgcn_global_load_lds((const unsigned*)((const char*)(gbase) + (voff)[_i]), (PG8_LAS unsigned*)(lds + (bufoff) + ldsw + _i * 8192), 16, 0, 0); } while (0)
#define PG8_LDA(dst, b, h) do { _Pragma("unroll") for (int m = 0; m < 4; ++m) _Pragma("unroll") for (int k = 0; k < 2; ++k) dst[m][k] = *(const PG8_LAS bf16x8*)(lds + PG8_SA(b, h) + aoff + m * 2048 + k * 1024); } while (0)
#define PG8_LDB(dst, b, h) do { _Pragma("unroll") for (int n = 0; n < 2; ++n) _Pragma("unroll") for (int k = 0; k < 2; ++k) dst[n][k] = *(const PG8_LAS bf16x8*)(lds + PG8_SB(b, h) + boff + n * 2048 + k * 1024); } while (0)
#define PG8_MMA(ai, bj, At, Bt) do { __builtin_amdgcn_s_setprio(1); _Pragma("unroll") for (int m = 0; m < 4; ++m) _Pragma("unroll") for (int n = 0; n < 2; ++n) _Pragma("unroll") for (int k = 0; k < 2; ++k) \
    acc[ai][bj][m][n] = __builtin_amdgcn_mfma_f32_16x16x32_bf16(Bt[n][k], At[m][k], acc[ai][bj][m][n], 0, 0, 0); __builtin_amdgcn_s_setprio(0); } while (0)
#define PG8_WAIT_V(n) asm volatile("s_waitcnt vmcnt(" #n ")" ::: "memory")
#define PG8_WAIT_L(n) asm volatile("s_waitcnt lgkmcnt(" #n ")" ::: "memory")
#define PG8_BAR __builtin_amdgcn_s_barrier()
#define PG8_SCHED __builtin_amdgcn_sched_barrier(0)
  Unit cur, nxt; int ui = 0;
  if (!S.next(0, cur)) return;
  f32x4 acc[2][2][4][2];
#pragma unroll
  for (int a = 0; a < 2; ++a)
#pragma unroll
    for (int b = 0; b < 2; ++b)
#pragma unroll
      for (int m = 0; m < 4; ++m)
#pragma unroll
        for (int n = 0; n < 2; ++n) acc[a][b][m][n] = (f32x4){0.f, 0.f, 0.f, 0.f};
  bf16x8 At[4][2], B0[2][2], B1[2][2];
  const char* cA = (const char*)g.A + (size_t)cur.pm * tstep; const char* cB = (const char*)g.Bt + (size_t)cur.pn * tstep;
  PG8_STAGE(PG8_SB(0, 0), cB, voffB); PG8_STAGE(PG8_SA(0, 0), cA, voffA); PG8_STAGE(PG8_SB(0, 1), cB + hstep, voffB); PG8_STAGE(PG8_SA(0, 1), cA + hstep, voffA);
  if (wr == 1) PG8_BAR;
  PG8_WAIT_V(4); PG8_BAR;
  PG8_STAGE(PG8_SB(1, 0), cB + kstep, voffB); PG8_STAGE(PG8_SA(1, 0), cA + kstep, voffA); PG8_STAGE(PG8_SB(1, 1), cB + hstep + kstep, voffB);
  PG8_WAIT_V(6); PG8_BAR;
  for (;;) {
    const bool has_next = S.next(ui + 1, nxt);
    const char* nA = has_next ? (const char*)g.A + (size_t)nxt.pm * tstep : cA; const char* nB = has_next ? (const char*)g.Bt + (size_t)nxt.pn * tstep : cB;
    for (int t = 0; t < nt; t += 2) {
      const bool last = (t == nt - 2);
      const char* a1 = cA + (size_t)(t + 1) * kstep;
      const char* a2 = last ? nA : cA + (size_t)(t + 2) * kstep; const char* b2 = last ? nB : cB + (size_t)(t + 2) * kstep;
      const char* a3 = a2 + kstep; const char* b3 = b2 + kstep;
      PG8_LDB(B0, 0, 0); PG8_SCHED; PG8_LDA(At, 0, 0); PG8_STAGE(PG8_SA(1, 1), a1 + hstep, voffA);
      PG8_WAIT_L(8); PG8_BAR; PG8_WAIT_L(0); PG8_MMA(0, 0, At, B0); PG8_BAR; PG8_SCHED;
      PG8_LDB(B1, 0, 1); PG8_STAGE(PG8_SB(0, 0), b2, voffB);
      PG8_BAR; PG8_WAIT_L(0); PG8_MMA(0, 1, At, B1); PG8_BAR;
      PG8_LDA(At, 0, 1); PG8_STAGE(PG8_SA(0, 0), a2, voffA);
      PG8_BAR; PG8_WAIT_L(0); PG8_MMA(1, 0, At, B0); PG8_BAR; PG8_SCHED;
      PG8_STAGE(PG8_SB(0, 1), b2 + hstep, voffB);
      PG8_WAIT_V(6); PG8_BAR; PG8_MMA(1, 1, At, B1); PG8_BAR;
      PG8_LDB(B0, 1, 0); PG8_SCHED; PG8_LDA(At, 1, 0); PG8_STAGE(PG8_SA(0, 1), a2 + hstep, voffA);
      PG8_WAIT_L(8); PG8_BAR; PG8_WAIT_L(0); PG8_MMA(0, 0, At, B0); PG8_BAR; PG8_SCHED;
      PG8_LDB(B1, 1, 1); PG8_STAGE(PG8_SB(1, 0), b3, voffB);
      PG8_BAR; PG8_WAIT_L(0); PG8_MMA(0, 1, At, B1); PG8_BAR;
      PG8_LDA(At, 1, 1); PG8_STAGE(PG8_SA(1, 0), a3, voffA);
      PG8_BAR; PG8_WAIT_L(0); PG8_MMA(1, 0, At, B0); PG8_BAR; PG8_SCHED;
      PG8_STAGE(PG8_SB(1, 1), b3 + hstep, voffB);
      PG8_WAIT_V(6); PG8_BAR; PG8_MMA(1, 1, At, B1); PG8_BAR;
    }
    E(acc, cur, wr, wc, fr, fq);
    if (!has_next) break;
#pragma unroll
    for (int a = 0; a < 2; ++a)
#pragma unroll
      for (int b = 0; b < 2; ++b)
#pragma unroll
        for (int m = 0; m < 4; ++m)
#pragma unroll
          for (int n = 0; n < 2; ++n) acc[a][b][m][n] = (f32x4){0.f, 0.f, 0.f, 0.f};
    cur = nxt; cA = nA; cB = nB; ++ui;
  }
  PG8_WAIT_V(0);
  if (wr == 0) PG8_BAR;
  PG8_BAR;
#undef PG8_SA
#undef PG8_SB
#undef PG8_STAGE
#undef PG8_LDA
#undef PG8_LDB
#undef PG8_MMA
#undef PG8_WAIT_V
#undef PG8_WAIT_L
#undef PG8_BAR
#undef PG8_SCHED
}
#else
template <class Epi>
void gemm_phase(char* smem, const Gemm g, const StaticOrder& S, const Epi& E) {
  const int tid = tid_(), wid = tid >> 6, lane = tid & 63, wr = wid >> 2, wc = wid & 3, fr = lane & 15, fq = lane >> 4;
  Unit u;
  for (int i = 0; S.next(i, u); ++i) {
    f32x4 acc[2][2][4][2];
    for (int ai = 0; ai < 2; ++ai) for (int bj = 0; bj < 2; ++bj) for (int m = 0; m < 4; ++m) for (int n = 0; n < 2; ++n) for (int j = 0; j < 4; ++j) {
      int row = u.pm * 256 + ai * 128 + wr * 64 + m * 16 + fr, col = u.pn * 256 + bj * 128 + wc * 32 + (Epi::PERM ? (fq * 8 + n * 4) : (n * 16 + fq * 4)) + j;
      const bf16_t* a = g.A + (size_t)row * g.K; const bf16_t* b = g.Bt + (size_t)col * g.K; float s = 0.f;
      for (int k = 0; k < g.K; ++k) s += bf2f(a[k]) * bf2f(b[k]);
      acc[ai][bj][m][n][j] = s;
    }
    E(acc, u, wr, wc, fr, fq);
  }
}
#endif
}
using pg8::Unit;

#define EPI_LOOP_BEGIN _Pragma("unroll") for (int ai = 0; ai < 2; ++ai) _Pragma("unroll") for (int m = 0; m < 4; ++m) { const int row = u.pm * 256 + ai * 128 + wr * 64 + m * 16 + fr;
#define EPI_FRAG_LOOP _Pragma("unroll") for (int bj = 0; bj < 2; ++bj) _Pragma("unroll") for (int n = 0; n < 2; ++n) { const int col = EPI_COLMAP(u.pn * 256 + bj * 128 + wc * 32 + n * 16 + fq * 4); const f32x4 v = acc[ai][bj][m][n];
#define EPI_COLMAP(c) (c)
#undef EPI_COLMAP
#define EPI_COLMAP(c) ((c) + (((c) >= EV_GLR) ? 16 : 0))
struct EpiEvenIn {
  static constexpr bool PERM = false;
  float* H32; bf16_t *MQ, *MK, *MVT;
  __device__ __forceinline__ void operator()(const f32x4 (&acc)[2][2][4][2], const Unit& u, int wr, int wc, int fr, int fq) const {
    EPI_LOOP_BEGIN
      EPI_FRAG_LOOP
        const int gcol = col; (void)gcol;
        if (col < EV_MQ) *(f32x4*)(H32 + (size_t)row * EV_LD + col) = v;
        else if (col < EV_MK) *(u32x2*)(MQ + (size_t)row * MQ_LD + (col - EV_MQ)) = (u32x2){pack2(v[0], v[1]), pack2(v[2], v[3])};
        else if (col < EV_MV) *(u32x2*)(MK + (size_t)row * MQ_LD + (col - EV_MK)) = (u32x2){pack2(v[0], v[1]), pack2(v[2], v[3])};
        else if (col < EVEN_IN) { bf16_t* d = MVT + (size_t)(col - EV_MV) * SEQ + row; d[0] = f2bf(v[0]); d[SEQ] = f2bf(v[1]); d[2 * (size_t)SEQ] = f2bf(v[2]); d[3 * (size_t)SEQ] = f2bf(v[3]); }
      }
    }
  }
};
#undef EPI_COLMAP
#define EPI_COLMAP(c) (c)
struct EpiOddIn {
  static constexpr bool PERM = false;
  float* H32;
  __device__ __forceinline__ void operator()(const f32x4 (&acc)[2][2][4][2], const Unit& u, int wr, int wc, int fr, int fq) const {
    EPI_LOOP_BEGIN
      EPI_FRAG_LOOP
        if (col < ODD_IN) *(f32x4*)(H32 + (size_t)row * OD_LD + col) = v;
      }
    }
  }
};
struct EpiBf16 {
  static constexpr bool PERM = true;
  bf16_t* O; int ld;
  __device__ __forceinline__ void operator()(const f32x4 (&acc)[2][2][4][2], const Unit& u, int wr, int wc, int fr, int fq) const {
    EPI_LOOP_BEGIN
      _Pragma("unroll") for (int bj = 0; bj < 2; ++bj) { const int col = u.pn * 256 + bj * 128 + wc * 32 + fq * 8; const f32x4 v0 = acc[ai][bj][m][0], v1 = acc[ai][bj][m][1];
        *(u32x4*)(O + (size_t)row * ld + col) = (u32x4){pack2(v0[0], v0[1]), pack2(v0[2], v0[3]), pack2(v1[0], v1[1]), pack2(v1[2], v1[3])};
      }
    }
  }
};
struct EpiRes {
  static constexpr bool PERM = false;
  const float* raw; const float* pst; const float* pg; const float* pb; float* Y; float* stats;
  __device__ __forceinline__ void operator()(const f32x4 (&acc)[2][2][4][2], const Unit& u, int wr, int wc, int fr, int fq) const {
    EPI_LOOP_BEGIN
      SCHED_FENCE();
      float s = 0.f, ss = 0.f, mu = 0.f, rs = 1.f;
      if (!raw) { mu = pst[(size_t)row * 2] * (1.f / DM); const float var = pst[(size_t)row * 2 + 1] * (1.f / DM) - mu * mu; rs = rsqrtf(fmaxf(var, 0.f) + 1e-5f); }
      EPI_FRAG_LOOP
        f32x4 r;
        if (raw) r = *(const f32x4*)(raw + (size_t)row * DM + col);
        else { const f32x4 yo = *(const f32x4*)(Y + (size_t)row * DM + col), gg = *(const f32x4*)(pg + col), bb = *(const f32x4*)(pb + col); r = (yo - mu) * rs * gg + bb; }
        const f32x4 y = r * ALPHA + v;
        *(f32x4*)(Y + (size_t)row * DM + col) = y;
        s += y[0] + y[1] + y[2] + y[3]; ss += y[0] * y[0] + y[1] * y[1] + y[2] * y[2] + y[3] * y[3];
      }
      s += __shfl_xor(s, 16); ss += __shfl_xor(ss, 16); s += __shfl_xor(s, 32); ss += __shfl_xor(ss, 32);
      if (fq == 0) { atomicAdd(stats + (size_t)row * 2, s); atomicAdd(stats + (size_t)row * 2 + 1, ss); }
    }
  }
};
struct EpiGlu {
  static constexpr bool PERM = false;
  const bf16_t* YS; const float* bias; bf16_t* CAT;
  __device__ __forceinline__ void operator()(const f32x4 (&acc)[2][2][4][2], const Unit& u, int wr, int wc, int fr, int fq) const {
    EPI_LOOP_BEGIN
      EPI_FRAG_LOOP
        const u32x2 yy = *(const u32x2*)(YS + (size_t)row * S5_CH + col);
        const f32x4 b = *(const f32x4*)(bias + col);
        float y0 = __uint_as_float(yy[0] << 16), y1 = __uint_as_float(yy[0] & 0xffff0000u), y2 = __uint_as_float(yy[1] << 16), y3 = __uint_as_float(yy[1] & 0xffff0000u);
        y0 *= sigmoidf_(v[0] + b[0]); y1 *= sigmoidf_(v[1] + b[1]); y2 *= sigmoidf_(v[2] + b[2]); y3 *= sigmoidf_(v[3] + b[3]);
        *(u32x2*)(CAT + (size_t)row * ODD_OUT + GDN_H * 128 + col) = (u32x2){pack2(y0, y1), pack2(y2, y3)};
      }
    }
  }
};

template <class Epi> __device__ __forceinline__ void run_gemm(char* smem, const bf16_t* A, const bf16_t* Bt, int N, int K, const Epi& E, int bid, int nb) {
  pg8::Gemm g{A, Bt, SEQ, N, K}; pg8::StaticOrder S; S.init(SEQ, N, nb, bid);
  pg8::gemm_phase<Epi>(smem, g, S, E);
}

__device__ __forceinline__ void transpose_convert(const float* src, bf16_t* dst, int K, int N, int Np, char* smem, int bid, int nb, int glr = -1) {
  float* T = (float*)smem;
  const int tk = K / 64, tn = Np / 64, ntile = tk * tn, tid = tid_();
  const int r0 = tid >> 4, c4 = (tid & 15) * 4;
  f32x4 v[2];
  if (bid < ntile) { const int k0 = (bid % tk) * 64, n = (bid / tk) * 64 + c4;
#pragma unroll
    for (int i = 0; i < 2; ++i) v[i] = (n < N) ? *(const f32x4*)(src + (size_t)(k0 + r0 + 32 * i) * N + n) : f4zero(); }
  for (int t = bid; t < ntile; t += nb) {
    const int k0 = (t % tk) * 64, n0 = (t / tk) * 64;
#pragma unroll
    for (int i = 0; i < 2; ++i) {
#pragma unroll
      for (int e = 0; e < 4; ++e) T[(c4 + e) * 65 + r0 + 32 * i] = v[i][e]; }
    __syncthreads();
    if (t + nb < ntile) { const int k1 = ((t + nb) % tk) * 64, n = ((t + nb) / tk) * 64 + c4;
#pragma unroll
      for (int i = 0; i < 2; ++i) v[i] = (n < N) ? *(const f32x4*)(src + (size_t)(k1 + r0 + 32 * i) * N + n) : f4zero(); }
    { const int n = tid >> 3, ks = (tid & 7) * 8; const float* tp = T + n * 65 + ks;
      u32x4 o; o[0] = pack2(tp[0], tp[1]); o[1] = pack2(tp[2], tp[3]); o[2] = pack2(tp[4], tp[5]); o[3] = pack2(tp[6], tp[7]);
      int dn = n0 + n; if (glr >= 0) dn = (dn < glr) ? dn : (dn < glr + 16) ? (N - 16 + (dn - glr)) : (dn < N) ? dn - 16 : dn;
      *(u32x4*)(dst + (size_t)dn * K + k0 + ks) = o; }
    __syncthreads();
  }
}
__device__ __forceinline__ void conv_mat(const Params& p, int kind, int idx, char* smem, int bid, int nb) {
  const float* src; size_t doff; int K, N, Np, glr = -1;
  switch (kind) {
    case 0: src = p.even_w_in + (size_t)idx * DM * EVEN_IN; doff = OFF_WINE + idx * SZ_WINE; K = DM; N = EVEN_IN; Np = EVEN_NP; glr = EV_GLR; break;
    case 1: src = p.even_w_out + (size_t)idx * EVEN_OUT * DM; doff = OFF_WOUTE + idx * SZ_WOUTE; K = EVEN_OUT; N = DM; Np = DM; break;
    case 2: src = p.odd_w_in + (size_t)idx * DM * ODD_IN; doff = OFF_WINO + idx * SZ_WINO; K = DM; N = ODD_IN; Np = ODD_NP; break;
    case 3: src = p.s5_glu_w + (size_t)idx * S5_CH * S5_CH; doff = OFF_WGLU + idx * SZ_WGLU; K = S5_CH; N = S5_CH; Np = S5_CH; break;
    case 4: src = p.odd_w_out + (size_t)idx * ODD_OUT * DM; doff = OFF_WOUTO + idx * SZ_WOUTO; K = ODD_OUT; N = DM; Np = DM; break;
    case 5: src = p.ffn_w_up + (size_t)idx * DM * 2 * DFF; doff = OFF_WUP + idx * SZ_WUP; K = DM; N = 2 * DFF; Np = 2 * DFF; break;
    default: src = p.ffn_w_down + (size_t)idx * DFF * DM; doff = OFF_WDN + idx * SZ_WDN; K = DFF; N = DM; Np = DM; break;
  }
  transpose_convert(src, (bf16_t*)(p.ws + doff), K, N, Np, smem, bid, nb, glr);
}
__device__ __forceinline__ void conv_group(const Params& p, int g, char* smem, int bid, int nb) {
#pragma unroll 1
  for (int k = 0; k < 10; ++k) {
    int kind, idx; bool on;
    if (g < 0) { kind = (k < 2) ? k : (k < 4) ? k + 3 : k - 2; idx = 0; on = (k < 4) || (k < 7 && DEPTH > 1); }
    else {
      if (k < 2) { kind = 5 + k; idx = g; on = true; }
      else if (k < 4) { kind = k - 2; idx = (g + 1) >> 1; on = g + 1 < DEPTH; }
      else if (k < 6) { kind = 5 + (k - 4); idx = g + 1; on = g + 1 < DEPTH; }
      else if (k < 9) { kind = 2 + (k - 6); idx = (g + 2) >> 1; on = g + 2 < DEPTH; }
      else { kind = 0; idx = 0; on = false; }
    }
    if (on) conv_mat(p, kind, idx, smem, bid, nb);
  }
}
__device__ __forceinline__ void step_prep(const Params& p, char* smem, int bid, int nb) {
  char* ws = p.ws;
  conv_group(p, -1, smem, bid, nb);
  const size_t gt = (size_t)bid * 512 + tid_(), gn = (size_t)nb * 512;
  { bf16_t* XB = (bf16_t*)(ws + OFF_XB);
    for (size_t e = gt; e < (size_t)SEQ * DM / 4; e += gn) { const f32x4 v = *(const f32x4*)(p.x + e * 4); *(u32x2*)(XB + e * 4) = (u32x2){pack2(v[0], v[1]), pack2(v[2], v[3])}; } }
  { float* st = (float*)(ws + OFF_STATS); for (size_t e = gt; e < (size_t)DEPTH * 2 * SEQ * 2; e += gn) st[e] = 0.f; }
  for (size_t e = gt; e < (size_t)N_ODD * S5_G * S5_P; e += gn) {
    const int j = (int)(e / (S5_G * S5_P)), gp = (int)(e % (S5_G * S5_P)), g = gp / S5_P;
    float* C = (float*)(ws + OFF_S5C + j * SZ_S5C1);
    const float are = p.s5_a_re[(size_t)j * S5_G * S5_P + gp], aim = p.s5_a_im[(size_t)j * S5_G * S5_P + gp];
    const float step = expf(p.s5_log_step[j * S5_G + g]);
    const float mag = expf(are * step), abr = mag * cosf(aim * step), abi = mag * sinf(aim * step);
    const float den = are * are + aim * aim;
    const float zr = ((abr - 1.f) * are + abi * aim) / den, zi = (abi * are - (abr - 1.f) * aim) / den;
    C[gp] = abr; C[S5_G * S5_P + gp] = abi;
    float pr = abr, pi = abi;
    for (int k = 0; k < 6; ++k) { const float nr = pr * pr - pi * pi, ni = 2.f * pr * pi; pr = nr; pi = ni; }
    C[2 * S5_G * S5_P + gp] = pr; C[3 * S5_G * S5_P + gp] = pi;
    float* BBR = C + 4 * S5_G * S5_P + (size_t)gp * 16; float* BBI = C + 20 * S5_G * S5_P + (size_t)gp * 16;
    for (int c = 0; c < 16; ++c) { const float br = p.s5_b_re[((size_t)j * S5_G * S5_P + gp) * 16 + c], bi = p.s5_b_im[((size_t)j * S5_G * S5_P + gp) * 16 + c];
      BBR[c] = zr * br - zi * bi; BBI[c] = zr * bi + zi * br; }
  }
}

__device__ __forceinline__ void step_ln(const float* Y, const float* stats, const float* g, const float* b, float* X32, bf16_t* XB, int bid, int nb) {
  const int w = tid_() >> 6, lane = tid_() & 63;
  constexpr int NV = DM / 256;
  for (int row = bid * 8 + w; row < SEQ; row += nb * 8) {
    f32x4 y[NV];
#pragma unroll
    for (int i = 0; i < NV; ++i) y[i] = *(const f32x4*)(Y + (size_t)row * DM + lane * 4 + i * 256);
    const float mu = stats[(size_t)row * 2] * (1.f / DM); const float var = stats[(size_t)row * 2 + 1] * (1.f / DM) - mu * mu; const float rs = rsqrtf(fmaxf(var, 0.f) + 1e-5f);
#pragma unroll
    for (int i = 0; i < NV; ++i) { const int c = lane * 4 + i * 256;
      const f32x4 gg = *(const f32x4*)(g + c), bb = *(const f32x4*)(b + c);
      const f32x4 o = (y[i] - mu) * rs * gg + bb;
      if (X32) *(f32x4*)(X32 + (size_t)row * DM + c) = o;
      *(u32x2*)(XB + (size_t)row * DM + c) = (u32x2){pack2(o[0], o[1]), pack2(o[2], o[3])}; }
  }
}

__device__ __forceinline__ void step_ffn_conv(const bf16_t* H16, const float* cw, bf16_t* G16, int bid, int nb) {
  constexpr int CG = DFF / 8, RB = 16;
  const size_t total = (size_t)(SEQ / RB) * CG;
  for (size_t it = (size_t)bid * 512 + tid_(); it < total; it += (size_t)nb * 512) {
    const int cg8 = (int)(it % CG) * 8, t0 = (int)(it / CG) * RB;
    float wg[3][8], wv[3][8];
#pragma unroll
    for (int i = 0; i < 3; ++i) {
#pragma unroll
      for (int k = 0; k < 8; k += 4) { const f32x4 a = *(const f32x4*)(cw + (size_t)i * 2 * DFF + cg8 + k), b = *(const f32x4*)(cw + (size_t)i * 2 * DFF + DFF + cg8 + k);
        wg[i][k] = a[0]; wg[i][k + 1] = a[1]; wg[i][k + 2] = a[2]; wg[i][k + 3] = a[3]; wv[i][k] = b[0]; wv[i][k + 1] = b[1]; wv[i][k + 2] = b[2]; wv[i][k + 3] = b[3]; }
    }
    float g0[8], g1[8], v0[8], v1[8];
#pragma unroll
    for (int k = 0; k < 8; ++k) { g0[k] = g1[k] = v0[k] = v1[k] = 0.f; }
    if (t0 >= 2) {
      const u32x4 a = *(const u32x4*)(H16 + (size_t)(t0 - 2) * 2 * DFF + cg8), b = *(const u32x4*)(H16 + (size_t)(t0 - 2) * 2 * DFF + DFF + cg8);
      const u32x4 c = *(const u32x4*)(H16 + (size_t)(t0 - 1) * 2 * DFF + cg8), d = *(const u32x4*)(H16 + (size_t)(t0 - 1) * 2 * DFF + DFF + cg8);
#pragma unroll
      for (int k = 0; k < 4; ++k) { g0[2 * k] = __uint_as_float(a[k] << 16); g0[2 * k + 1] = __uint_as_float(a[k] & 0xffff0000u); v0[2 * k] = __uint_as_float(b[k] << 16); v0[2 * k + 1] = __uint_as_float(b[k] & 0xffff0000u);
        g1[2 * k] = __uint_as_float(c[k] << 16); g1[2 * k + 1] = __uint_as_float(c[k] & 0xffff0000u); v1[2 * k] = __uint_as_float(d[k] << 16); v1[2 * k + 1] = __uint_as_float(d[k] & 0xffff0000u); }
    }
#pragma unroll 1
    for (int tb = t0; tb < t0 + RB; tb += 8) {
      u32x4 ra[8], rb[8];
#pragma unroll
      for (int r = 0; r < 8; ++r) { ra[r] = *(const u32x4*)(H16 + (size_t)(tb + r) * 2 * DFF + cg8); rb[r] = *(const u32x4*)(H16 + (size_t)(tb + r) * 2 * DFF + DFF + cg8); }
#pragma unroll
      for (int r = 0; r < 8; ++r) {
        const u32x4 a = ra[r], b = rb[r]; const int t = tb + r;
        float g2[8], v2[8], o[8];
#pragma unroll
        for (int k = 0; k < 4; ++k) { g2[2 * k] = __uint_as_float(a[k] << 16); g2[2 * k + 1] = __uint_as_float(a[k] & 0xffff0000u); v2[2 * k] = __uint_as_float(b[k] << 16); v2[2 * k + 1] = __uint_as_float(b[k] & 0xffff0000u); }
#pragma unroll
        for (int k = 0; k < 8; ++k) { const float gg = wg[0][k] * g0[k] + wg[1][k] * g1[k] + wg[2][k] * g2[k]; const float vv = wv[0][k] * v0[k] + wv[1][k] * v1[k] + wv[2][k] * v2[k];
          o[k] = siluf_(gg) * vv; g0[k] = g1[k]; g1[k] = g2[k]; v0[k] = v1[k]; v1[k] = v2[k]; }
        u32x4 ov; ov[0] = pack2(o[0], o[1]); ov[1] = pack2(o[2], o[3]); ov[2] = pack2(o[4], o[5]); ov[3] = pack2(o[6], o[7]);
        *(u32x4*)(G16 + (size_t)t * DFF + cg8) = ov;
      }
    }
  }
}

__device__ __forceinline__ void gla_logcum(const Params& p, int j, int h, int n, float* CUM, const float* H32, float* TMP) {
  const int tid = tid_();
  const float* w2 = p.gla_w_gate2 + (size_t)j * 16 * (GLA_H * 64); const float* bg = p.gla_b_gate + (size_t)j * GLA_H * 64;
  float* GL = TMP; float* W2 = TMP + 1024; float* BG = W2 + 1024;
  for (int e = tid; e < 1024; e += 512) { GL[e] = H32[(size_t)(n * 64 + (e >> 4)) * EV_LD + EV_GLR + (e & 15)]; W2[e] = w2[(e >> 6) * (GLA_H * 64) + h * 64 + (e & 63)]; }
  if (tid < 64) BG[tid] = bg[h * 64 + tid];
  __syncthreads();
  for (int e = tid; e < 4096; e += 512) {
    const int t = e >> 6, d = e & 63; float x = BG[d];
#pragma unroll
    for (int r = 0; r < 16; ++r) x += GL[t * 16 + r] * W2[r * 64 + d];
    CUM[e] = (fminf(x, 0.f) - log1pf(__expf(-fabsf(x)))) * (1.f / 16.f);
  }
  __syncthreads();
  if (tid < 64) { float c = 0.f;
#pragma unroll 16
    for (int t = 0; t < 64; ++t) { c += CUM[t * 64 + tid]; CUM[t * 64 + tid] = c; } }
  __syncthreads();
}
__device__ __forceinline__ void gla_kv_item(const Params& p, int j, int h, int n, char* smem) {
  const float* H32 = (const float*)(p.ws + OFF_H32); float* KVS = (float*)(p.ws + OFF_KVS); float* DEC = (float*)(p.ws + OFF_DEC);
  float* CUM = (float*)smem; float* KD = CUM + 4096; float* VS = KD + 4096;
  const int tid = tid_();
  f32x4 vpre[4];
#pragma unroll
  for (int i = 0; i < 4; ++i) { const int e = tid + 512 * i, t = e >> 5, c4 = (e & 31) * 4; vpre[i] = *(const f32x4*)(H32 + (size_t)(n * 64 + t) * EV_LD + EV_GV + h * 128 + c4); }
  gla_logcum(p, j, h, n, CUM, H32, VS);
  for (int e = tid; e < 4096; e += 512) { const int t = e >> 6, d = e & 63; KD[e] = H32[(size_t)(n * 64 + t) * EV_LD + EV_GK + h * 64 + d] * __expf(CUM[63 * 64 + d] - CUM[e]); }
#pragma unroll
  for (int i = 0; i < 4; ++i) { const int e = tid + 512 * i, t = e >> 5, c4 = (e & 31) * 4; *(f32x4*)(VS + t * 128 + c4) = vpre[i]; }
  __syncthreads();
  const int dg = tid >> 5, vg = tid & 31;
  f32x4 acc[4] = {f4zero(), f4zero(), f4zero(), f4zero()};
#pragma unroll 4
  for (int t = 0; t < 64; ++t) { const f32x4 k4 = *(const f32x4*)(KD + t * 64 + dg * 4), v4 = *(const f32x4*)(VS + t * 128 + vg * 4);
#pragma unroll
    for (int i = 0; i < 4; ++i) acc[i] += k4[i] * v4; }
#pragma unroll
  for (int i = 0; i < 4; ++i) *(f32x4*)(KVS + ((size_t)(h * NCH + n) * 64 + dg * 4 + i) * 128 + vg * 4) = acc[i];
  if (tid < 64) DEC[(size_t)(h * NCH + n) * 64 + tid] = __expf(CUM[63 * 64 + tid]);
  __syncthreads();
}
__device__ __forceinline__ void gla_scan(const Params& p, int bid, int nb) {
  const float* __restrict__ KVS = (const float*)(p.ws + OFF_KVS); const float* __restrict__ DEC = (const float*)(p.ws + OFF_DEC); float* __restrict__ SPV = (float*)(p.ws + OFF_SPV);
  const int tid = tid_();
  if (tid < 256) for (int e = bid * 256 + tid; e < GLA_H * 64 * 128; e += nb * 256) {
    const int h = e / (64 * 128), d = (e >> 7) & 63, v = e & 127; float s = 0.f;
#pragma unroll 1
    for (int n0 = 0; n0 < NCH; n0 += 16) { float kv[16], dc[16];
#pragma unroll
      for (int k = 0; k < 16; ++k) { kv[k] = KVS[((size_t)(h * NCH + n0 + k) * 64 + d) * 128 + v]; dc[k] = DEC[(size_t)(h * NCH + n0 + k) * 64 + d]; }
#pragma unroll
      for (int k = 0; k < 16; ++k) { SPV[((size_t)(h * NCH + n0 + k) * 64 + d) * 128 + v] = s; s = s * dc[k] + kv[k]; } }
  }
}
__device__ __forceinline__ void gla_out_item(const Params& p, int j, int h, int n, char* smem) {
  constexpr int QP = 68;
  const float* H32 = (const float*)(p.ws + OFF_H32); const float* SP = (const float*)(p.ws + OFF_SPV) + (size_t)(h * NCH + n) * 64 * 128; bf16_t* CAT = (bf16_t*)(p.ws + OFF_CAT);
  float* CUM = (float*)smem; float* QE = CUM + 4096; float* KE = QE + 64 * QP; float* QEt = KE + 64 * QP; float* ATt = QEt + 64 * QP; float* VS = ATt + 64 * QP;
  float* SPs = QE;
  const int tid = tid_();
  f32x4 vpre[4], spre[4];
#pragma unroll
  for (int i = 0; i < 4; ++i) { const int e = tid + 512 * i, t = e >> 5, c4 = (e & 31) * 4; vpre[i] = *(const f32x4*)(H32 + (size_t)(n * 64 + t) * EV_LD + EV_GV + h * 128 + c4); spre[i] = *(const f32x4*)(SP + e * 4); }
  gla_logcum(p, j, h, n, CUM, H32, VS);
  for (int e = tid; e < 4096; e += 512) { const int t = e >> 6, d = e & 63; const float* hr = H32 + (size_t)(n * 64 + t) * EV_LD; const float c = CUM[e];
    const float qe = hr[EV_GQ + h * 64 + d] * 0.125f * __expf(c); QE[t * QP + d] = qe; QEt[d * QP + t] = qe; KE[t * QP + d] = hr[EV_GK + h * 64 + d] * __expf(-c); }
#pragma unroll
  for (int i = 0; i < 4; ++i) { const int e = tid + 512 * i, t = e >> 5, c4 = (e & 31) * 4; *(f32x4*)(VS + t * 128 + c4) = vpre[i]; }
  __syncthreads();
  const int cg_ = tid >> 5, lg = tid & 31;
  { float a[4][2] = {{0.f, 0.f}, {0.f, 0.f}, {0.f, 0.f}, {0.f, 0.f}};
#pragma unroll 2
    for (int d4 = 0; d4 < 16; ++d4) { f32x4 k0 = *(const f32x4*)(KE + lg * QP + d4 * 4), k1 = *(const f32x4*)(KE + (lg + 32) * QP + d4 * 4);
#pragma unroll
      for (int i = 0; i < 4; ++i) { const f32x4 q = *(const f32x4*)(QE + (cg_ * 4 + i) * QP + d4 * 4); a[i][0] += q[0] * k0[0] + q[1] * k0[1] + q[2] * k0[2] + q[3] * k0[3]; a[i][1] += q[0] * k1[0] + q[1] * k1[1] + q[2] * k1[2] + q[3] * k1[3]; } }
#pragma unroll
    for (int i = 0; i < 4; ++i) { const int c = cg_ * 4 + i; ATt[lg * QP + c] = (c >= lg) ? a[i][0] : 0.f; ATt[(lg + 32) * QP + c] = (c >= lg + 32) ? a[i][1] : 0.f; } }
  __syncthreads();
#pragma unroll
  for (int i = 0; i < 4; ++i) *(f32x4*)(SPs + (tid + 512 * i) * 4) = spre[i];
  __syncthreads();
  f32x4 acc[4] = {f4zero(), f4zero(), f4zero(), f4zero()};
#pragma unroll 4
  for (int s = 0; s < cg_ * 4 + 4; ++s) { const f32x4 a4 = *(const f32x4*)(ATt + s * QP + cg_ * 4), v4 = *(const f32x4*)(VS + s * 128 + lg * 4);
#pragma unroll
    for (int i = 0; i < 4; ++i) acc[i] += a4[i] * v4; }
#pragma unroll 4
  for (int d = 0; d < 64; ++d) { const f32x4 q4 = *(const f32x4*)(QEt + d * QP + cg_ * 4), s4 = *(const f32x4*)(SPs + d * 128 + lg * 4);
#pragma unroll
    for (int i = 0; i < 4; ++i) acc[i] += q4[i] * s4; }
  const f32x4 ng = *(const f32x4*)(p.gla_norm_g + (size_t)j * 128 + lg * 4);
#pragma unroll
  for (int i = 0; i < 4; ++i) {
    float ss = acc[i][0] * acc[i][0] + acc[i][1] * acc[i][1] + acc[i][2] * acc[i][2] + acc[i][3] * acc[i][3];
    ss += __shfl_xor(ss, 1); ss += __shfl_xor(ss, 2); ss += __shfl_xor(ss, 4); ss += __shfl_xor(ss, 8); ss += __shfl_xor(ss, 16);
    const float r = rsqrtf(ss * (1.f / 128.f) + 1e-6f); const int t = n * 64 + cg_ * 4 + i;
    const f32x4 gr = *(const f32x4*)(H32 + (size_t)t * EV_LD + EV_GR + h * 128 + lg * 4);
    const f32x4 o = acc[i] * r * ng;
    *(u32x2*)(CAT + (size_t)t * EVEN_OUT + h * 128 + lg * 4) = (u32x2){pack2(o[0] * siluf_(gr[0]), o[1] * siluf_(gr[1])), pack2(o[2] * siluf_(gr[2]), o[3] * siluf_(gr[3]))};
  }
  __syncthreads();
}

__device__ __forceinline__ void moba_kmean_item(const Params& p, int h, int blk, char* smem) {
  const bf16_t* MK = (const bf16_t*)(p.ws + OFF_MK); float* KM = (float*)(p.ws + OFF_KMEAN); float* PART = (float*)smem;
  const int tid = tid_(), d = tid & 127, part = tid >> 7; float s = 0.f;
#pragma unroll 16
  for (int k = 0; k < 64; ++k) s += bf2f(MK[(size_t)(blk * 256 + part * 64 + k) * MQ_LD + h * 128 + d]);
  PART[tid] = s; __syncthreads();
  if (tid < 128) KM[(size_t)(h * NBLK + blk) * 128 + tid] = (PART[tid] + PART[128 + tid] + PART[256 + tid] + PART[384 + tid]) * (1.f / 256.f);
  __syncthreads();
}
struct Top3 { float v0, v1, v2; int i0, i1, i2; };
__device__ __forceinline__ bool top_better(float v, int i, float w, int j) { return v > w || (v == w && i < j); }
__device__ __forceinline__ Top3 top_ins(Top3 t, float v, int i) {
  const bool b0 = top_better(v, i, t.v0, t.i0), b1 = top_better(v, i, t.v1, t.i1), b2 = top_better(v, i, t.v2, t.i2);
  Top3 r;
  r.v2 = b1 ? t.v1 : (b2 ? v : t.v2); r.i2 = b1 ? t.i1 : (b2 ? i : t.i2);
  r.v1 = b0 ? t.v0 : (b1 ? v : t.v1); r.i1 = b0 ? t.i0 : (b1 ? i : t.i1);
  r.v0 = b0 ? v : t.v0; r.i0 = b0 ? i : t.i0;
  return r;
}
template <bool GATH> __device__ __forceinline__ void moba_tile(const Params& p, int h, int arg0, int arg1, int arg2, char* smem) {
  constexpr int PB = 272;
  constexpr float NEG = -1e30f;
  const bf16_t* MQ = (const bf16_t*)(p.ws + OFF_MQ); const bf16_t* MK = (const bf16_t*)(p.ws + OFF_MK); const bf16_t* MVT = (const bf16_t*)(p.ws + OFF_MVT);
  const float* KM = (const float*)(p.ws + OFF_KMEAN); unsigned* MCNT = (unsigned*)(p.ws + OFF_MCNT); unsigned* MLIST = (unsigned*)(p.ws + OFF_MLIST);
  float* PO = (float*)(p.ws + OFF_PO); f32x2* PML = (f32x2*)(p.ws + OFF_PML);
  char* Qs = smem; char* Ks = Qs + 64 * PB; char* VTs = Ks + 128 * PB; int* ROWT = (int*)(VTs + 128 * PB); int* ROWS = ROWT + 64;
  float* MRG = (float*)Ks;
  const int tid = tid_(), w = tid >> 6, lane = tid & 63, fr = lane & 15, fq = lane >> 4, wq = w & 3, wh = w >> 2;
  const int t0 = GATH ? 0 : arg0 * 64, own = t0 >> 8;
  const float slope = exp2f(-8.f * (float)(h + 1) / (float)MOBA_H), scale = 0.08838834764831845f;
  const int kbase = GATH ? arg0 * 256 : own * 256;
  unsigned ent = 0u; const bool rv = GATH ? (arg1 + tid < arg2) : true;
  if (GATH && tid < 64) ent = MLIST[(size_t)(h * NBLK + arg0) * SEQ + (rv ? arg1 + tid : arg1)];
  u32x4 kreg[4], vreg[4];
  { const int key0 = kbase;
#pragma unroll
    for (int i = 0; i < 4; ++i) { const int e = tid + 512 * i, r = e >> 4, c = e & 15;
      kreg[i] = *(const u32x4*)(MK + (size_t)(key0 + r) * MQ_LD + h * 128 + c * 8); vreg[i] = *(const u32x4*)(MVT + (size_t)(h * 128 + r) * SEQ + key0 + c * 8); } }
  if (tid < 64) {
    if (GATH) { ROWT[tid] = (int)(ent >> 2); ROWS[tid] = rv ? (int)(ent & 3u) : -1; }
    else { ROWT[tid] = t0 + tid; ROWS[tid] = 3; } }
  lds_barrier();
  for (int e = tid; e < 64 * 16; e += 512) { const int r = e >> 4, c = e & 15; *(u32x4*)(Qs + r * PB + c * 16) = *(const u32x4*)(MQ + (size_t)ROWT[r] * MQ_LD + h * 128 + c * 8); }
  lds_barrier();
  if (!GATH) {
    float* KMs = (float*)Ks;
    for (int e = tid; e < own * 32; e += 512) *(f32x4*)(KMs + e * 4) = *(const f32x4*)(KM + (size_t)h * NBLK * 128 + e * 4);
    __syncthreads();
    const int q = tid >> 3, part = tid & 7; Top3 tp; tp.v0 = tp.v1 = tp.v2 = -INFINITY; tp.i0 = tp.i1 = tp.i2 = 1 << 20;
    for (int nb_ = part; nb_ < own; nb_ += 8) { const float* km = KMs + nb_ * 128; float s = 0.f;
#pragma unroll 2
      for (int c = 0; c < 16; ++c) { const u32x4 qq = *(const u32x4*)(Qs + q * PB + c * 16); const f32x4 ka = *(const f32x4*)(km + c * 8), kb = *(const f32x4*)(km + c * 8 + 4);
        s += __uint_as_float(qq[0] << 16) * ka[0] + __uint_as_float(qq[0] & 0xffff0000u) * ka[1] + __uint_as_float(qq[1] << 16) * ka[2] + __uint_as_float(qq[1] & 0xffff0000u) * ka[3]
           + __uint_as_float(qq[2] << 16) * kb[0] + __uint_as_float(qq[2] & 0xffff0000u) * kb[1] + __uint_as_float(qq[3] << 16) * kb[2] + __uint_as_float(qq[3] & 0xffff0000u) * kb[3]; }
      tp = top_ins(tp, s, nb_); }
#pragma unroll
    for (int m = 1; m < 8; m <<= 1) { const float a0 = __shfl_xor(tp.v0, m), a1 = __shfl_xor(tp.v1, m), a2 = __shfl_xor(tp.v2, m); const int b0 = __shfl_xor(tp.i0, m), b1 = __shfl_xor(tp.i1, m), b2 = __shfl_xor(tp.i2, m);
      tp = top_ins(tp, a0, b0); tp = top_ins(tp, a1, b1); tp = top_ins(tp, a2, b2); }
    unsigned* CL = (unsigned*)(ROWS + 64); unsigned* BASE = CL + 32;
    if (tid < 32) CL[tid] = 0u;
    __syncthreads();
    unsigned l0 = 0, l1 = 0, l2 = 0;
    if (part == 0) { if (tp.i0 < 32) l0 = atomicAdd(CL + tp.i0, 1u); if (tp.i1 < 32) l1 = atomicAdd(CL + tp.i1, 1u); if (tp.i2 < 32) l2 = atomicAdd(CL + tp.i2, 1u); }
    __syncthreads();
    if (tid < own && CL[tid] > 0u) BASE[tid] = atomicAdd(MCNT + h * NBLK + tid, CL[tid]);
    __syncthreads();
    if (part == 0) { const unsigned tt = (unsigned)(t0 + q);
      if (tp.i0 < 32) MLIST[(size_t)(h * NBLK + tp.i0) * SEQ + BASE[tp.i0] + l0] = (tt << 2) | 0u;
      if (tp.i1 < 32) MLIST[(size_t)(h * NBLK + tp.i1) * SEQ + BASE[tp.i1] + l1] = (tt << 2) | 1u;
      if (tp.i2 < 32) MLIST[(size_t)(h * NBLK + tp.i2) * SEQ + BASE[tp.i2] + l2] = (tt << 2) | 2u; }
  }
  bf16x8 qf[4];
#pragma unroll
  for (int kk = 0; kk < 4; ++kk) qf[kk] = *(const bf16x8*)(Qs + (wq * 16 + fr) * PB + kk * 64 + fq * 16);
  f32x4 oacc[8];
#pragma unroll
  for (int i = 0; i < 8; ++i) oacc[i] = f4zero();
  float mrow = NEG, lrow = 0.f;
  const int tq = ROWT[wq * 16 + fr], slot = ROWS[wq * 16 + fr];
  const int ntile = GATH ? 2 : ((own * 256 + 128 <= t0 + 63) ? 2 : 1);
#pragma unroll 1
  for (int ti = 0; ti < ntile; ++ti) {
    {
      const int key0 = kbase + ti * 128;
      lds_barrier();
#pragma unroll
      for (int i = 0; i < 4; ++i) { const int e = tid + 512 * i, r = e >> 4, c = e & 15; *(u32x4*)(Ks + r * PB + c * 16) = kreg[i]; *(u32x4*)(VTs + r * PB + c * 16) = vreg[i]; }
      if (ti + 1 < ntile) { const int key1 = key0 + 128;
#pragma unroll
        for (int i = 0; i < 4; ++i) { const int e = tid + 512 * i, r = e >> 4, c = e & 15;
          kreg[i] = *(const u32x4*)(MK + (size_t)(key1 + r) * MQ_LD + h * 128 + c * 8); vreg[i] = *(const u32x4*)(MVT + (size_t)(h * 128 + r) * SEQ + key1 + c * 8); } }
      lds_barrier();
      const int kb = wh * 64;
      f32x4 sacc[4];
#pragma unroll
      for (int nt = 0; nt < 4; ++nt) { sacc[nt] = f4zero();
#pragma unroll
        for (int kk = 0; kk < 4; ++kk) { const bf16x8 kf = *(const bf16x8*)(Ks + (kb + nt * 16 + fr) * PB + kk * 64 + fq * 16); sacc[nt] = __builtin_amdgcn_mfma_f32_16x16x32_bf16(kf, qf[kk], sacc[nt], 0, 0, 0); } }
      float mx = NEG;
#pragma unroll
      for (int nt = 0; nt < 4; ++nt)
#pragma unroll
        for (int jj = 0; jj < 4; ++jj) { const int tk = key0 + kb + nt * 16 + fq * 4 + jj; float s = sacc[nt][jj] * scale - slope * (float)(tq - tk);
          const bool ok = GATH ? true : (tk <= tq); s = ok ? s : NEG; sacc[nt][jj] = s; mx = fmaxf(mx, s); }
      mx = fmaxf(mx, __shfl_xor(mx, 16)); mx = fmaxf(mx, __shfl_xor(mx, 32));
      const float mnew = fmaxf(mrow, mx), alpha = __expf(mrow - mnew); mrow = mnew;
      float ps = 0.f;
#pragma unroll
      for (int nt = 0; nt < 4; ++nt)
#pragma unroll
        for (int jj = 0; jj < 4; ++jj) { const float pv = __expf(sacc[nt][jj] - mnew); sacc[nt][jj] = pv; ps += pv; }
      lrow = lrow * alpha + ps;
#pragma unroll
      for (int i = 0; i < 8; ++i) oacc[i] *= alpha;
#pragma unroll
      for (int k2 = 0; k2 < 2; ++k2) {
        u32x4 pk; pk[0] = pack2(sacc[2 * k2][0], sacc[2 * k2][1]); pk[1] = pack2(sacc[2 * k2][2], sacc[2 * k2][3]); pk[2] = pack2(sacc[2 * k2 + 1][0], sacc[2 * k2 + 1][1]); pk[3] = pack2(sacc[2 * k2 + 1][2], sacc[2 * k2 + 1][3]);
        bf16x8 pb; __builtin_memcpy(&pb, &pk, 16);
#pragma unroll
        for (int dt = 0; dt < 8; ++dt) {
          const char* vr = VTs + (dt * 16 + fr) * PB + (kb + 32 * k2 + fq * 4) * 2;
          const u32x2 lo = *(const u32x2*)vr, hi = *(const u32x2*)(vr + 32);
          u32x4 vv; vv[0] = lo[0]; vv[1] = lo[1]; vv[2] = hi[0]; vv[3] = hi[1]; bf16x8 vf; __builtin_memcpy(&vf, &vv, 16);
          oacc[dt] = __builtin_amdgcn_mfma_f32_16x16x32_bf16(vf, pb, oacc[dt], 0, 0, 0);
        }
      }
    }
  }
  lrow += __shfl_xor(lrow, 16); lrow += __shfl_xor(lrow, 32);
  __syncthreads();
  if (wh == 1) { float* mg = MRG + (size_t)wq * 34 * 64;
#pragma unroll
    for (int dt = 0; dt < 8; ++dt)
#pragma unroll
      for (int jj = 0; jj < 4; ++jj) mg[(dt * 4 + jj) * 64 + lane] = oacc[dt][jj];
    mg[32 * 64 + lane] = mrow; mg[33 * 64 + lane] = lrow; }
  __syncthreads();
  if (wh == 0 && slot >= 0) { const float* mg = MRG + (size_t)wq * 34 * 64; const float m2 = mg[32 * 64 + lane], l2 = mg[33 * 64 + lane];
    const float ms = fmaxf(mrow, m2), f1 = __expf(mrow - ms), f2 = __expf(m2 - ms); const float lt = lrow * f1 + l2 * f2, inv = 1.f / lt;
    const size_t pi = ((size_t)h * SEQ + tq) * 4 + slot;
#pragma unroll
    for (int dt = 0; dt < 8; ++dt) { f32x4 o;
#pragma unroll
      for (int jj = 0; jj < 4; ++jj) o[jj] = (oacc[dt][jj] * f1 + mg[(dt * 4 + jj) * 64 + lane] * f2) * inv;
      *(f32x4*)(PO + pi * 128 + dt * 16 + fq * 4) = o; }
    if (fq == 0) PML[pi] = (f32x2){ms, lt}; }
  __syncthreads();
}
__device__ __forceinline__ void moba_gathered(const Params& p, char* smem, int bid, int nb) {
  const unsigned* MCNT = (const unsigned*)(p.ws + OFF_MCNT);
  int* PC = (int*)(smem + 120 * 1024); int* PF = PC + 256;
  const int tid = tid_();
  if (tid < 256) PC[tid] = (tid < MOBA_H * NBLK) ? (int)((MCNT[tid] + 63u) >> 6) : 0;
  __syncthreads();
  if (tid < 256) { int sum = 0; for (int k = 0; k < tid; ++k) sum += PC[k]; PF[tid] = sum; }
  __syncthreads();
  const int total = PF[255] + PC[255];
  const int vb = ((nb & 7) == 0) ? (bid & 7) * (nb >> 3) + (bid >> 3) : bid;
  for (int g = vb; g < total; g += nb) {
    int lo = 0, hi = 256;
    while (hi - lo > 1) { const int mid = (lo + hi) >> 1; if (PF[mid] <= g) lo = mid; else hi = mid; }
    moba_tile<true>(p, lo / NBLK, lo % NBLK, (g - PF[lo]) * 64, (int)MCNT[lo], smem);
  }
}
__device__ __forceinline__ void moba_combine(const Params& p, int bid, int nb) {
  const float* PO = (const float*)(p.ws + OFF_PO); const f32x2* PML = (const f32x2*)(p.ws + OFF_PML); bf16_t* CAT = (bf16_t*)(p.ws + OFF_CAT);
  const int grp = tid_() >> 5, l = tid_() & 31;
  for (int it = bid * 16 + grp; it < SEQ * MOBA_H; it += nb * 16) {
    const int t = it / MOBA_H, h = it % MOBA_H, own = t >> 8, nv = own < 3 ? own : 3; const size_t pi = ((size_t)h * SEQ + t) * 4;
    f32x2 ml[4]; f32x4 po[4];
    ml[3] = PML[pi + 3]; po[3] = *(const f32x4*)(PO + (pi + 3) * 128 + l * 4);
#pragma unroll
    for (int k = 0; k < 3; ++k) { if (k < nv) { ml[k] = PML[pi + k]; po[k] = *(const f32x4*)(PO + (pi + k) * 128 + l * 4); } else { ml[k] = (f32x2){-1e30f, 0.f}; po[k] = f4zero(); } }
    float mm = fmaxf(fmaxf(ml[0][0], ml[1][0]), fmaxf(ml[2][0], ml[3][0]));
    float wsum = 0.f; f32x4 acc = f4zero();
#pragma unroll
    for (int k = 0; k < 4; ++k) { const float wk = ml[k][1] * __expf(ml[k][0] - mm); wsum += wk; acc += po[k] * wk; }
    const float inv = 1.f / wsum;
    *(u32x2*)(CAT + (size_t)t * EVEN_OUT + GLA_H * 128 + h * 128 + l * 4) = (u32x2){pack2(acc[0] * inv, acc[1] * inv), pack2(acc[2] * inv, acc[3] * inv)};
  }
}

__device__ __forceinline__ void gdn_local_item(const Params& p, int j, int h, int n, char* smem) {
  constexpr int SP_ = 260, KP = 132;
  const float* H32 = (const float*)(p.ws + OFF_H32);
  float* SOL = (float*)smem; float* KS = SOL + 64 * SP_; float* LM = KS + 64 * KP; float* BETA = LM + 2 * 64 * 36;   float* GG = BETA + 64; float* GC = GG + 64;
  const size_t base = (size_t)(h * NCH + n);
  float* Ug = (float*)(p.ws + OFF_GU) + base * 8192; bf16_t* Wg = (bf16_t*)(p.ws + OFF_GW) + base * 8192; bf16_t* QDg = (bf16_t*)(p.ws + OFF_GQD) + base * 8192; bf16_t* KDg = (bf16_t*)(p.ws + OFF_GKD) + base * 8192;
  bf16_t* ATg = (bf16_t*)(p.ws + OFF_ATT) + base * 4096; float* EGL = (float*)(p.ws + OFF_EGL);
  const int tid = tid_(), t0 = n * 64;
  { const int cs = tid & 31, rg = tid >> 5, c4 = cs * 4; const float* cwb = p.gdn_conv_w + (size_t)j * 4 * (3 * GDN_H * 128);
#pragma unroll
    for (int part = 0; part < 3; ++part) { const int col = part * GDN_H * 128 + h * 128 + c4; f32x4 wv[4], xv[7];
#pragma unroll
      for (int jj = 0; jj < 4; ++jj) wv[jj] = *(const f32x4*)(cwb + (size_t)jj * (3 * GDN_H * 128) + col);
#pragma unroll
      for (int r = 0; r < 7; ++r) { const int t = t0 + rg * 4 - 3 + r; xv[r] = (t >= 0) ? *(const f32x4*)(H32 + (size_t)t * OD_LD + OD_QKV + col) : f4zero(); }
#pragma unroll
      for (int i = 0; i < 4; ++i) { f32x4 o = wv[0] * xv[i] + wv[1] * xv[i + 1] + wv[2] * xv[i + 2] + wv[3] * xv[i + 3];
        o[0] = siluf_(o[0]); o[1] = siluf_(o[1]); o[2] = siluf_(o[2]); o[3] = siluf_(o[3]);
        float* dst = (part == 0) ? (SOL + (rg * 4 + i) * SP_ + 128 + c4) : (part == 1) ? (KS + (rg * 4 + i) * KP + c4) : (SOL + (rg * 4 + i) * SP_ + c4);
        *(f32x4*)dst = o; } } }
  if (tid < 64) { const int t = t0 + tid; BETA[tid] = sigmoidf_(H32[(size_t)t * OD_LD + OD_BETA + h]);
    GG[tid] = -expf(p.gdn_a_log[j * GDN_H + h]) * softplusf_(H32[(size_t)t * OD_LD + OD_DEC + h] + p.gdn_dt_bias[j * GDN_H + h]); }
  __syncthreads();
  const int row = tid >> 3, seg = tid & 7;
  { float* qp = SOL + row * SP_ + 128 + seg * 16; float* kp = KS + row * KP + seg * 16; float sq = 0.f, sk = 0.f;
#pragma unroll
    for (int c = 0; c < 16; ++c) { sq += qp[c] * qp[c]; sk += kp[c] * kp[c]; }
    sq += __shfl_xor(sq, 1); sk += __shfl_xor(sk, 1); sq += __shfl_xor(sq, 2); sk += __shfl_xor(sk, 2); sq += __shfl_xor(sq, 4); sk += __shfl_xor(sk, 4);
    const float rq = rsqrtf(sq + 1e-6f) * 0.08838834764831845f, rk = rsqrtf(sk + 1e-6f);
#pragma unroll
    for (int c = 0; c < 16; ++c) { qp[c] *= rq; kp[c] *= rk; }
    char* Kb = (char*)LM; char* Qb = smem + 122880;
#pragma unroll
    for (int c = 0; c < 16; c += 8) { *(u32x4*)(Kb + row * 272 + (seg * 16 + c) * 2) = (u32x4){pack2(kp[c], kp[c + 1]), pack2(kp[c + 2], kp[c + 3]), pack2(kp[c + 4], kp[c + 5]), pack2(kp[c + 6], kp[c + 7])};
      *(u32x4*)(Qb + row * 272 + (seg * 16 + c) * 2) = (u32x4){pack2(qp[c], qp[c + 1]), pack2(qp[c + 2], qp[c + 3]), pack2(qp[c + 4], qp[c + 5]), pack2(qp[c + 6], qp[c + 7])}; } }
  if (tid == 0) { float c = 0.f;
#pragma unroll 16
    for (int t = 0; t < 64; ++t) { c += GG[t]; GC[t] = c; } }
  __syncthreads();
  {
    const char* Kb = (const char*)LM; const char* Qb = smem + 122880;
    const int w = tid >> 6, lane = tid & 63, fr = lane & 15, fq = lane >> 4, it = w >> 1, jt0 = 2 * (w & 1);
    f32x4 aL[2] = {f4zero(), f4zero()}, aA[2] = {f4zero(), f4zero()};
#pragma unroll
    for (int kk = 0; kk < 4; ++kk) {
      const bf16x8 ki = *(const bf16x8*)(Kb + (it * 16 + fr) * 272 + kk * 64 + fq * 16), qi = *(const bf16x8*)(Qb + (it * 16 + fr) * 272 + kk * 64 + fq * 16);
#pragma unroll
      for (int jj = 0; jj < 2; ++jj) { const bf16x8 kj = *(const bf16x8*)(Kb + ((jt0 + jj) * 16 + fr) * 272 + kk * 64 + fq * 16);
        aL[jj] = __builtin_amdgcn_mfma_f32_16x16x32_bf16(ki, kj, aL[jj], 0, 0, 0); aA[jj] = __builtin_amdgcn_mfma_f32_16x16x32_bf16(qi, kj, aA[jj], 0, 0, 0); } }
    __syncthreads();
#pragma unroll
    for (int jj = 0; jj < 2; ++jj)
#pragma unroll
      for (int r = 0; r < 4; ++r) { const int ii = it * 16 + fq * 4 + r, jx = (jt0 + jj) * 16 + fr; const float dec = (ii >= jx) ? __expf(GC[ii] - GC[jx]) : 0.f;
        LM[(jx & 1) * (64 * 36) + ii * 36 + (jx >> 1)] = (ii > jx) ? BETA[ii] * aL[jj][r] * dec : 0.f; ATg[ii * 64 + jx] = f2bf(aA[jj][r] * dec); } }
  { const float eg = __expf(GC[row]), ek = __expf(GC[63] - GC[row]); const float* qp = SOL + row * SP_ + 128 + seg * 16; const float* kp = KS + row * KP + seg * 16;
#pragma unroll
    for (int c = 0; c < 16; c += 4) { const f32x4 q = *(const f32x4*)(qp + c), k = *(const f32x4*)(kp + c); { const f32x4 qq = q * eg; *(u32x2*)(QDg + row * 128 + seg * 16 + c) = (u32x2){pack2(qq[0], qq[1]), pack2(qq[2], qq[3])}; }
#pragma unroll
      for (int e = 0; e < 4; ++e) KDg[(seg * 16 + c + e) * 64 + row] = f2bf(k[e] * ek); } }
  __syncthreads();
  { const float bt = BETA[row], be = bt * __expf(GC[row]); float* vp = SOL + row * SP_ + seg * 16; float* wp = SOL + row * SP_ + 128 + seg * 16; const float* kp = KS + row * KP + seg * 16;
#pragma unroll
    for (int c = 0; c < 16; ++c) { vp[c] *= bt; wp[c] = kp[c] * be; } }
  __syncthreads();
  { const int col = tid >> 1, half = tid & 1; const float* lmh = LM + half * (64 * 36);
    float x[32];
#pragma unroll
    for (int k = 0; k < 32; ++k) x[k] = 0.f;
#pragma unroll
    for (int i = 0; i < 64; ++i) {
      const float rhs = SOL[i * SP_ + col]; float part = 0.f;
#pragma unroll
      for (int k4 = 0; k4 < (i + 1) / 2; k4 += 4) { const f32x4 l4 = *(const f32x4*)(lmh + i * 36 + k4);
#pragma unroll
        for (int e = 0; e < 4; ++e) if (k4 + e < (i + 1) / 2) part += l4[e] * x[k4 + e]; }
      const float nv = rhs - (part + dpp_mov<0xB1>(part));
      x[i >> 1] = ((i & 1) == half) ? nv : x[i >> 1];
      if (i > 0) SOL[i * SP_ + col] = nv;
    } }
  __syncthreads();
#pragma unroll
  for (int c = 0; c < 16; c += 4) { const f32x4 uu = *(const f32x4*)(SOL + row * SP_ + seg * 16 + c);
#pragma unroll
    for (int e = 0; e < 4; ++e) Ug[(seg * 16 + c + e) * 64 + row] = uu[e];
    { const f32x4 ww = *(const f32x4*)(SOL + row * SP_ + 128 + seg * 16 + c); *(u32x2*)(Wg + row * 128 + seg * 16 + c) = (u32x2){pack2(ww[0], ww[1]), pack2(ww[2], ww[3])}; } }
  if (tid == 0) EGL[base] = __expf(GC[63]);
  __syncthreads();
}
struct GdnMRegs { bf16x8 a12[4], a4[2]; f32x4 x[2]; float egl; };
__device__ __forceinline__ void gdn_mload(GdnMRegs& r, const char* ws, int h, int n, int w, int fr, int fq, int j0) {
  const size_t base = (size_t)(h * NCH + n);
  const float* UTn = (const float*)(ws + OFF_GU) + base * 8192; const bf16_t* Wn = (const bf16_t*)(ws + OFF_GW) + base * 8192; const bf16_t* QDn = (const bf16_t*)(ws + OFF_GQD) + base * 8192;
  const bf16_t* KDTn = (const bf16_t*)(ws + OFF_GKD) + base * 8192; const bf16_t* ATn = (const bf16_t*)(ws + OFF_ATT) + base * 4096;
  const bf16_t* a12p = ((w < 4) ? Wn : QDn) + (16 * (w & 3) + fr) * 128 + fq * 8;
#pragma unroll
  for (int kk = 0; kk < 4; ++kk) r.a12[kk] = *(const bf16x8*)(a12p + kk * 32);
  const bf16_t* a4p = KDTn + (16 * w + fr) * 64 + fq * 8;
#pragma unroll
  for (int kk = 0; kk < 2; ++kk) r.a4[kk] = *(const bf16x8*)(a4p + kk * 32);
  const char* xp = (w < 4) ? (const char*)(UTn + (j0 + fr) * 64 + 16 * w + fq * 4) : (const char*)(ATn + (16 * (w - 4) + fr) * 64 + fq * 8); const int xs = (w < 4) ? 16 * 64 * 4 : 64;
#pragma unroll
  for (int i = 0; i < 2; ++i) r.x[i] = *(const f32x4*)(xp + i * xs);
  r.egl = ((const float*)(ws + OFF_EGL))[base];
}
constexpr int GS_SP = 272, GS_VP = 144;
__device__ __forceinline__ void gdn_mstep(const GdnMRegs& cur, f32x4 (&sacc)[2], char* ST, char* VT, float* O32, int n, int h, int j0, int w, int fr, int fq) {
  f32x4 acc[2] = {f4zero(), f4zero()};
#pragma unroll
  for (int kk = 0; kk < 4; ++kk) { const bf16x8 af = cur.a12[kk];
#pragma unroll
    for (int jt = 0; jt < 2; ++jt) { const bf16x8 bfr = *(const bf16x8*)(ST + (jt * 16 + fr) * GS_SP + (kk * 32 + fq * 8) * 2); acc[jt] = __builtin_amdgcn_mfma_f32_16x16x32_bf16(af, bfr, acc[jt], 0, 0, 0); } }
  if (w < 4) {
#pragma unroll
    for (int jt = 0; jt < 2; ++jt) { const f32x4 vn = cur.x[jt] - acc[jt]; *(u32x2*)(VT + (jt * 16 + fr) * GS_VP + (16 * w + fq * 4) * 2) = (u32x2){pack2(vn[0], vn[1]), pack2(vn[2], vn[3])}; } }
  lds_barrier();
  bf16x8 vf[2][2];
#pragma unroll
  for (int kk = 0; kk < 2; ++kk)
#pragma unroll
    for (int jt = 0; jt < 2; ++jt) vf[kk][jt] = *(const bf16x8*)(VT + (jt * 16 + fr) * GS_VP + (kk * 32 + fq * 8) * 2);
  if (w >= 4) {
#pragma unroll
    for (int kk = 0; kk < 2; ++kk) { bf16x8 af; __builtin_memcpy(&af, &cur.x[kk], 16);
#pragma unroll
      for (int jt = 0; jt < 2; ++jt) acc[jt] = __builtin_amdgcn_mfma_f32_16x16x32_bf16(af, vf[kk][jt], acc[jt], 0, 0, 0); }
#pragma unroll
    for (int jt = 0; jt < 2; ++jt)
#pragma unroll
      for (int r = 0; r < 4; ++r) O32[(size_t)(n * 64 + 16 * (w - 4) + fq * 4 + r) * (GDN_H * 128) + h * 128 + j0 + jt * 16 + fr] = acc[jt][r];
  }
#pragma unroll
  for (int jt = 0; jt < 2; ++jt) sacc[jt] *= cur.egl;
#pragma unroll
  for (int kk = 0; kk < 2; ++kk) { const bf16x8 af = cur.a4[kk];
#pragma unroll
    for (int jt = 0; jt < 2; ++jt) sacc[jt] = __builtin_amdgcn_mfma_f32_16x16x32_bf16(af, vf[kk][jt], sacc[jt], 0, 0, 0); }
#pragma unroll
  for (int jt = 0; jt < 2; ++jt) *(u32x2*)(ST + (jt * 16 + fr) * GS_SP + (16 * w + fq * 4) * 2) = (u32x2){pack2(sacc[jt][0], sacc[jt][1]), pack2(sacc[jt][2], sacc[jt][3])};
  lds_barrier();
}
__device__ __forceinline__ void gdn_scan_item(const Params& p, int h, int sl, char* smem) {
  char* ST = smem; char* VT = ST + 32 * GS_SP;
  float* O32 = (float*)(p.ws + OFF_O32);
  const int tid = tid_(), w = tid >> 6, lane = tid & 63, fr = lane & 15, fq = lane >> 4, j0 = sl * 32;
  { float z = 0.f; LAUNDER_V(z); for (int e = tid; e < 32 * GS_SP / 4; e += 512) ((float*)ST)[e] = z; }
  f32x4 sacc[2] = {f4zero(), f4zero()};
  GdnMRegs a0, a1, b0, b1;
  gdn_mload(a0, p.ws, h, 0, w, fr, fq, j0); gdn_mload(a1, p.ws, h, 1, w, fr, fq, j0);
  lds_barrier();
#pragma unroll 1
  for (int n = 0; n < NCH; n += 4) {
    DRAIN_VM();
    gdn_mload(b0, p.ws, h, n + 2, w, fr, fq, j0); gdn_mload(b1, p.ws, h, n + 3, w, fr, fq, j0);
    gdn_mstep(a0, sacc, ST, VT, O32, n, h, j0, w, fr, fq);
    gdn_mstep(a1, sacc, ST, VT, O32, n + 1, h, j0, w, fr, fq);
    DRAIN_VM();
    { const int m0 = (n + 4 < NCH) ? n + 4 : n, m1 = (n + 5 < NCH) ? n + 5 : n + 1;
      gdn_mload(a0, p.ws, h, m0, w, fr, fq, j0); gdn_mload(a1, p.ws, h, m1, w, fr, fq, j0); }
    gdn_mstep(b0, sacc, ST, VT, O32, n + 2, h, j0, w, fr, fq);
    gdn_mstep(b1, sacc, ST, VT, O32, n + 3, h, j0, w, fr, fq);
  }
}
__device__ __forceinline__ void gdn_final(const Params& p, int j, int bid, int nb) {
  const float* H32 = (const float*)(p.ws + OFF_H32); const float* O32 = (const float*)(p.ws + OFF_O32); bf16_t* CAT = (bf16_t*)(p.ws + OFF_CAT);
  const int grp = tid_() >> 5, l = tid_() & 31;
  const f32x4 ng = *(const f32x4*)(p.gdn_norm_g + (size_t)j * 128 + l * 4);
  for (int it = bid * 16 + grp; it < SEQ * GDN_H; it += nb * 16) {
    const int t = it / GDN_H, h = it % GDN_H;
    const f32x4 o = *(const f32x4*)(O32 + (size_t)t * (GDN_H * 128) + h * 128 + l * 4), z = *(const f32x4*)(H32 + (size_t)t * OD_LD + OD_Z + h * 128 + l * 4);
    float ss = o[0] * o[0] + o[1] * o[1] + o[2] * o[2] + o[3] * o[3];
    ss += __shfl_xor(ss, 1); ss += __shfl_xor(ss, 2); ss += __shfl_xor(ss, 4); ss += __shfl_xor(ss, 8); ss += __shfl_xor(ss, 16);
    const float r = rsqrtf(ss * (1.f / 128.f) + 1e-6f); const f32x4 v = o * r * ng;
    *(u32x2*)(CAT + (size_t)t * ODD_OUT + h * 128 + l * 4) = (u32x2){pack2(v[0] * siluf_(z[0]), v[1] * siluf_(z[1])), pack2(v[2] * siluf_(z[2]), v[3] * siluf_(z[3]))};
  }
}

template <bool OUT> __device__ __forceinline__ void s5_item(const Params& p, int j, int g, int oct, char* smem) {
  constexpr int XP = 68;
  const float* H32 = (const float*)(p.ws + OFF_H32); const float* C = (const float*)(p.ws + OFF_S5C + j * SZ_S5C1); f32x2* XEND = (f32x2*)(p.ws + OFF_XEND); bf16_t* YS = (bf16_t*)(p.ws + OFF_YS);
  float* XR = (float*)smem; float* XI = XR + 8 * 16 * XP; float* US = XI + 8 * 16 * XP;
  const int tid = tid_(), w = tid >> 6, lane = tid & 63, n = oct * 8 + w, gp = g * S5_P + lane, fr = lane & 15, fq = lane >> 4;
  { const float* up = H32 + (size_t)(n * 64 + lane) * OD_LD + OD_U + g * 16; float* ud = US + (w * 64 + lane) * 16;
#pragma unroll
    for (int c = 0; c < 16; c += 4) *(f32x4*)(ud + c) = *(const f32x4*)(up + c); }
  bf16x8 cf[4];
  if (OUT) {
#pragma unroll
    for (int kk = 0; kk < 4; ++kk) { const float* cp = ((kk < 2) ? p.s5_c_re : p.s5_c_im) + (((size_t)j * S5_G + g) * 16 + fr) * 64 + (kk & 1) * 32 + fq * 8;
      const f32x4 c0 = *(const f32x4*)cp, c1 = *(const f32x4*)(cp + 4); const float sg = (kk < 2) ? 1.f : -1.f;
      u32x4 pk; pk[0] = pack2(sg * c0[0], sg * c0[1]); pk[1] = pack2(sg * c0[2], sg * c0[3]); pk[2] = pack2(sg * c1[0], sg * c1[1]); pk[3] = pack2(sg * c1[2], sg * c1[3]); __builtin_memcpy(&cf[kk], &pk, 16); } }
  const float ar = C[gp], ai = C[S5_G * S5_P + gp];
  float bbr[16], bbi[16];
#pragma unroll
  for (int c = 0; c < 16; c += 4) { const f32x4 a = *(const f32x4*)(C + 4 * S5_G * S5_P + (size_t)gp * 16 + c), b = *(const f32x4*)(C + 20 * S5_G * S5_P + (size_t)gp * 16 + c);
    bbr[c] = a[0]; bbr[c + 1] = a[1]; bbr[c + 2] = a[2]; bbr[c + 3] = a[3]; bbi[c] = b[0]; bbi[c + 1] = b[1]; bbi[c + 2] = b[2]; bbi[c + 3] = b[3]; }
  float xr = 0.f, xi = 0.f;
  if (OUT) { const float a64r = C[2 * S5_G * S5_P + gp], a64i = C[3 * S5_G * S5_P + gp];
#pragma unroll 1
    for (int m0 = 0; m0 < n; m0 += 16) { f32x2 xe[16];
#pragma unroll
      for (int k = 0; k < 16; ++k) xe[k] = XEND[(size_t)(((m0 + k < n) ? m0 + k : 0) * S5_G + g) * S5_P + lane];
#pragma unroll
      for (int k = 0; k < 16; ++k) if (m0 + k < n) { const float nr = a64r * xr - a64i * xi + xe[k][0], ni = a64r * xi + a64i * xr + xe[k][1]; xr = nr; xi = ni; } } }
  __syncthreads();
#pragma unroll 1
  for (int slab = 0; slab < 4; ++slab) {
#pragma unroll 2
    for (int tt = 0; tt < 16; ++tt) {
      const float* up = US + (w * 64 + slab * 16 + tt) * 16; float br = 0.f, bi = 0.f;
#pragma unroll
      for (int c = 0; c < 16; c += 4) { const f32x4 u4 = *(const f32x4*)(up + c);
#pragma unroll
        for (int e = 0; e < 4; ++e) { br += bbr[c + e] * u4[e]; bi += bbi[c + e] * u4[e]; } }
      const float nr = ar * xr - ai * xi + br, ni = ar * xi + ai * xr + bi; xr = nr; xi = ni;
      if (OUT) { XR[(w * 16 + tt) * XP + lane] = xr; XI[(w * 16 + tt) * XP + lane] = xi; }
    }
    if (OUT) {
      __syncthreads();
      f32x4 y = f4zero();
#pragma unroll
      for (int kk = 0; kk < 4; ++kk) { const float* xp = ((kk < 2) ? XR : XI) + (w * 16 + fr) * XP + (kk & 1) * 32 + fq * 8;
        const f32x4 x0 = *(const f32x4*)xp, x1 = *(const f32x4*)(xp + 4);
        u32x4 pk; pk[0] = pack2(x0[0], x0[1]); pk[1] = pack2(x0[2], x0[3]); pk[2] = pack2(x1[0], x1[1]); pk[3] = pack2(x1[2], x1[3]); bf16x8 xf; __builtin_memcpy(&xf, &pk, 16);
        y = __builtin_amdgcn_mfma_f32_16x16x32_bf16(cf[kk], xf, y, 0, 0, 0); }
      const int t = n * 64 + slab * 16 + fr;
      const f32x4 u4 = *(const f32x4*)(US + (w * 64 + slab * 16 + fr) * 16 + fq * 4), d4 = *(const f32x4*)(p.s5_d + ((size_t)j * S5_G + g) * 16 + fq * 4);
      y += d4 * u4;
      *(u32x2*)(YS + (size_t)t * S5_CH + g * 16 + fq * 4) = (u32x2){pack2(geluf_(y[0]), geluf_(y[1])), pack2(geluf_(y[2]), geluf_(y[3]))};
      __syncthreads();
    }
  }
  if (!OUT) XEND[(size_t)(n * S5_G + g) * S5_P + lane] = (f32x2){xr, xi};
}

__device__ __forceinline__ void s5_carry(const Params& p, int j, int bid, int nb) {
  const float* C = (const float*)(p.ws + OFF_S5C + j * SZ_S5C1); const f32x2* __restrict__ XEND = (const f32x2*)(p.ws + OFF_XEND); f32x2* __restrict__ CARRY = (f32x2*)(p.ws + OFF_CARRY);
  for (int e = bid * 512 + tid_(); e < S5_G * S5_P; e += nb * 512) {
    const float a64r = C[2 * S5_G * S5_P + e], a64i = C[3 * S5_G * S5_P + e]; float xr = 0.f, xi = 0.f;
#pragma unroll 1
    for (int n0 = 0; n0 < NCH; n0 += 16) { f32x2 xe[16];
#pragma unroll
      for (int k = 0; k < 16; ++k) xe[k] = XEND[(size_t)(n0 + k) * S5_G * S5_P + e];
#pragma unroll
      for (int k = 0; k < 16; ++k) { CARRY[(size_t)(n0 + k) * S5_G * S5_P + e] = (f32x2){xr, xi}; const float nr = a64r * xr - a64i * xi + xe[k][0], ni = a64r * xi + a64i * xr + xe[k][1]; xr = nr; xi = ni; } }
  }
}

__device__ __forceinline__ void glr_pass(const bf16_t* XB, const bf16_t* Wg, float* H32, int bid, int nb) {
  const int w = tid_() >> 6, lane = tid_() & 63, fr = lane & 15, fq = lane >> 4;
  for (int tile = bid * 8 + w; tile < SEQ / 16; tile += nb * 8) {
    const bf16_t* ap = XB + (size_t)(tile * 16 + fr) * DM + fq * 8; const bf16_t* bp = Wg + (size_t)fr * DM + fq * 8;
    f32x4 acc = f4zero();
#pragma unroll 8
    for (int kk = 0; kk < DM / 32; ++kk) { const bf16x8 a = *(const bf16x8*)(ap + kk * 32), b = *(const bf16x8*)(bp + kk * 32); acc = __builtin_amdgcn_mfma_f32_16x16x32_bf16(a, b, acc, 0, 0, 0); }
#pragma unroll
    for (int jj = 0; jj < 4; ++jj) H32[(size_t)(tile * 16 + fq * 4 + jj) * EV_LD + EV_GLR + fr] = acc[jj];
  }
}

#ifndef EMU
__device__ __forceinline__ void subgrid_barrier(unsigned* cnt, unsigned count, unsigned* tmo) {
  asm volatile("s_waitcnt vmcnt(0)" ::: "memory");
  __syncthreads();
  if (threadIdx.x == 0) {
    __builtin_amdgcn_fence(__ATOMIC_RELEASE, "agent");
    asm volatile("s_waitcnt vmcnt(0)" ::: "memory");
    __hip_atomic_fetch_add(cnt, 1u, __ATOMIC_RELAXED, __HIP_MEMORY_SCOPE_AGENT);
    unsigned sp = 0;
    while (__hip_atomic_load(cnt, __ATOMIC_RELAXED, __HIP_MEMORY_SCOPE_AGENT) < count) { __builtin_amdgcn_s_sleep(1);
      if ((++sp & 255u) == 0u) { if (__hip_atomic_load(tmo, __ATOMIC_RELAXED, __HIP_MEMORY_SCOPE_AGENT)) break; if (sp > (1u << 18)) { atomicAdd(tmo, 1u); break; } } }
    __builtin_amdgcn_fence(__ATOMIC_ACQUIRE, "agent");
    asm volatile("s_waitcnt vmcnt(0)" ::: "memory");
  }
  __syncthreads();
}
#else
__device__ __forceinline__ void subgrid_barrier(unsigned*, unsigned, unsigned*) {}
#endif

#ifdef EMU
#define SUBGRID_GLU()
#else
#define SUBGRID_GLU() do { subgrid_barrier((unsigned*)(ws + OFF_BAR) + 3600 + 64 * L, (unsigned)(nb - NSCAN), (unsigned*)(ws + OFF_BAR) + 128); \
    EpiGlu E{(const bf16_t*)(ws + OFF_YS), p.s5_glu_b + (size_t)j * S5_CH, CAT}; run_gemm(smem, (const bf16_t*)(ws + OFF_YS), (const bf16_t*)(ws + OFF_WGLU + j * SZ_WGLU), S5_CH, S5_CH, E, bid - NSCAN, nb - NSCAN); } while (0)
#endif
__device__ __forceinline__ bool run_step(const Params& p, int step, char* smem, int bid, int nb) {
  LAUNDER_S(bid); LAUNDER_S(nb);
  char* ws = p.ws;
  if (step == 0) { step_prep(p, smem, bid, nb); return true; }
  const int L = (step - 1) / STEPS_PER_LAYER, s = (step - 1) % STEPS_PER_LAYER, j = L >> 1; const bool even = (L & 1) == 0;
  bf16_t* XB = (bf16_t*)(ws + OFF_XB); float* X32 = (float*)(ws + OFF_X32); float* Y32 = (float*)(ws + OFF_Y32); float* H32 = (float*)(ws + OFF_H32); bf16_t* CAT = (bf16_t*)(ws + OFF_CAT);
  float* stats_mix = (float*)(ws + OFF_STATS) + (size_t)(L * 2) * SEQ * 2; float* stats_ffn = stats_mix + (size_t)SEQ * 2;
  switch (s) {
    case 0:
      if (even) { EpiEvenIn E{H32, (bf16_t*)(ws + OFF_MQ), (bf16_t*)(ws + OFF_MK), (bf16_t*)(ws + OFF_MVT)}; run_gemm(smem, XB, (const bf16_t*)(ws + OFF_WINE + j * SZ_WINE), EVEN_NMAIN, DM, E, bid, nb);
        glr_pass(XB, (const bf16_t*)(ws + OFF_WINE + j * SZ_WINE) + (size_t)EVEN_NMAIN * DM, H32, bid, nb); }
      else { EpiOddIn E{H32}; run_gemm(smem, XB, (const bf16_t*)(ws + OFF_WINO + j * SZ_WINO), ODD_NP, DM, E, bid, nb); }
      return true;
    case 1:
      if (even) {
        for (int it = bid; it < GLA_H * NCH; it += nb) gla_kv_item(p, j, it % GLA_H, it / GLA_H, smem);
        for (int it = bid; it < MOBA_H * NBLK; it += nb) moba_kmean_item(p, it % MOBA_H, it / MOBA_H, smem);
        if (bid == 0 && tid_() < MOBA_H * NBLK) ((unsigned*)(ws + OFF_MCNT))[tid_()] = 0u;
      } else {
        for (int it = bid; it < GDN_H * NCH; it += nb) gdn_local_item(p, j, it % GDN_H, it / GDN_H, smem);
        for (int it = bid; it < S5_G * (NCH / 8); it += nb) { s5_item<false>(p, j, it % S5_G, it / S5_G, smem); __syncthreads(); }
      }
      return true;
    case 2:
      if (even) {
        gla_scan(p, bid, nb);
        for (int it = nb - 1 - bid; it < MOBA_H * NCH; it += nb) moba_tile<false>(p, it % MOBA_H, NCH - 1 - it / MOBA_H, 0, 0, smem);
      } else {
        constexpr int NSCAN = GDN_H * 4;
        if (nb > 2 * NSCAN) {
          if (bid < NSCAN) gdn_scan_item(p, bid % GDN_H, bid / GDN_H, smem);
          else { for (int it = bid - NSCAN; it < S5_G * (NCH / 8); it += nb - NSCAN) { s5_item<true>(p, j, it % S5_G, it / S5_G, smem); __syncthreads(); }
            SUBGRID_GLU();
            conv_group(p, L, smem, bid - NSCAN, nb - NSCAN); }
        } else {
          for (int it = bid; it < NSCAN; it += nb) gdn_scan_item(p, it % GDN_H, it / GDN_H, smem);
          for (int it = bid; it < S5_G * (NCH / 8); it += nb) { s5_item<true>(p, j, it % S5_G, it / S5_G, smem); __syncthreads(); }
          conv_group(p, L, smem, bid, nb);
        }
      }
      return true;
    case 3:
      if (even) { for (int it = bid; it < GLA_H * NCH; it += nb) gla_out_item(p, j, it % GLA_H, it / GLA_H, smem); moba_gathered(p, smem, bid, nb); }
      else {
        gdn_final(p, j, bid, nb);
      }
      return true;
    case 4:
      if (even) { moba_combine(p, bid, nb); return true; }
      if (GLU_IN_WINDOW && nb > 2 * GDN_H * 4) return false;
      { EpiGlu E{(const bf16_t*)(ws + OFF_YS), p.s5_glu_b + (size_t)j * S5_CH, CAT}; run_gemm(smem, (const bf16_t*)(ws + OFF_YS), (const bf16_t*)(ws + OFF_WGLU + j * SZ_WGLU), S5_CH, S5_CH, E, bid, nb); }
      return true;
    case 5: {
      const float* pst = stats_mix - (size_t)SEQ * 2;
      EpiRes E{L == 0 ? p.x : nullptr, pst, p.ln_ffn_g + (size_t)(L > 0 ? L - 1 : 0) * DM, p.ln_ffn_b + (size_t)(L > 0 ? L - 1 : 0) * DM, Y32, stats_mix};
      if (even) run_gemm(smem, CAT, (const bf16_t*)(ws + OFF_WOUTE + j * SZ_WOUTE), DM, EVEN_OUT, E, bid, nb);
      else run_gemm(smem, CAT, (const bf16_t*)(ws + OFF_WOUTO + j * SZ_WOUTO), DM, ODD_OUT, E, bid, nb);
      return true; }
    case 6: step_ln(Y32, stats_mix, p.ln_mix_g + (size_t)L * DM, p.ln_mix_b + (size_t)L * DM, nullptr, XB, bid, nb); return true;
    case 7: { EpiBf16 E{(bf16_t*)(ws + OFF_H16), 2 * DFF}; run_gemm(smem, XB, (const bf16_t*)(ws + OFF_WUP + L * SZ_WUP), 2 * DFF, DM, E, bid, nb); return true; }
    case 8: step_ffn_conv((const bf16_t*)(ws + OFF_H16), p.ffn_conv_w + (size_t)L * 3 * 2 * DFF, (bf16_t*)(ws + OFF_G16), bid, nb); return true;
    case 9: { EpiRes E{nullptr, stats_mix, p.ln_mix_g + (size_t)L * DM, p.ln_mix_b + (size_t)L * DM, Y32, stats_ffn}; run_gemm(smem, (const bf16_t*)(ws + OFF_G16), (const bf16_t*)(ws + OFF_WDN + L * SZ_WDN), DM, DFF, E, bid, nb); return true; }
    case 10: step_ln(Y32, stats_ffn, p.ln_ffn_g + (size_t)L * DM, p.ln_ffn_b + (size_t)L * DM, (L == DEPTH - 1) ? p.out : nullptr, XB, bid, nb); return true;
  }
  return false;
}

#ifndef EMU
#define XB_TMO      128
#define XB_XCNT(j)  (256  + 64 * (j))
#define XB_XSUB(j)  (1280 + 64 * (j))
#define XB_XGEN(j)  (2304 + 64 * (j))
#define XB_TOP      3328
#define XB_TOPGEN   3392
#define XCD_BAR_WORDS 3456
#define XB_SPIN_CAP (1u << 18)
#define LAS __attribute__((address_space(3)))
__device__ __forceinline__ unsigned xb_ld(unsigned* p)              { return __hip_atomic_load(p, __ATOMIC_RELAXED, __HIP_MEMORY_SCOPE_AGENT); }
__device__ __forceinline__ unsigned xb_add(unsigned* p, unsigned v) { return __hip_atomic_fetch_add(p, v, __ATOMIC_RELAXED, __HIP_MEMORY_SCOPE_AGENT); }
__device__ __forceinline__ unsigned xb_xcc_id() { return (unsigned)__builtin_amdgcn_s_getreg((3 << 11) | 20) & 0xFu; }
#define XB_SPIN(cond, bar) do { unsigned _sp = 0; while (cond) { __builtin_amdgcn_s_sleep(1); \
    if ((++_sp & 255u) == 0u) { if (xb_ld(&(bar)[XB_TMO])) break; if (_sp > XB_SPIN_CAP) { atomicAdd(&(bar)[XB_TMO], 1u); break; } } } } while (0)
__device__ __forceinline__ void xcd_barrier_complete(unsigned* bar, unsigned x, unsigned& nloc, unsigned& nx) {
  const unsigned G = gridDim.x;
  unsigned sum, cnt, mine, sp = 0u;
  for (;;) {
    sum = 0u; cnt = 0u; mine = 0u;
#pragma unroll
    for (unsigned j = 0; j < 16; ++j) { const unsigned c = xb_ld(&bar[XB_XCNT(j)]); sum += c; cnt += (c > 0u) ? 1u : 0u; mine = (j == x) ? c : mine; }
    if (sum == G) break;
    __builtin_amdgcn_s_sleep(1);
    if ((++sp & 255u) == 0u) { if (xb_ld(&bar[XB_TMO])) break; if (sp > XB_SPIN_CAP) { atomicAdd(&bar[XB_TMO], 1u); break; } }
  }
  nloc = mine > 0u ? mine : 1u; nx = cnt > 0u ? cnt : 1u;
}
__device__ __forceinline__ void xcd_barrier(unsigned* bar, volatile LAS unsigned* st) {
  asm volatile("s_waitcnt vmcnt(0)" ::: "memory");
  __syncthreads();
  if (threadIdx.x == 0) {
    const unsigned x = xb_xcc_id();
    __builtin_amdgcn_s_waitcnt(0);
    unsigned nloc = st[0], nx = st[1];
    if (nloc == 0u) { xcd_barrier_complete(bar, x, nloc, nx); st[0] = nloc; st[1] = nx; }
    const unsigned old = xb_add(&bar[XB_XSUB(x)], 1u);
    const unsigned gen = old / nloc;
    if (old + 1u == (gen + 1u) * nloc) {
      __builtin_amdgcn_fence(__ATOMIC_RELEASE, "agent");
      asm volatile("s_waitcnt vmcnt(0)" ::: "memory");
      const unsigned og = xb_add(&bar[XB_TOP], 1u);
      const unsigned tg = og / nx;
      if (og + 1u == (tg + 1u) * nx) xb_add(&bar[XB_TOPGEN], 1u);
      else XB_SPIN(xb_ld(&bar[XB_TOPGEN]) == tg, bar);
      __builtin_amdgcn_fence(__ATOMIC_ACQUIRE, "agent");
      xb_add(&bar[XB_XGEN(x)], 1u);
      asm volatile("s_waitcnt vmcnt(0)" ::: "memory");
    } else {
      XB_SPIN(xb_ld(&bar[XB_XGEN(x)]) == gen, bar);
      __builtin_amdgcn_fence(__ATOMIC_ACQUIRE, "agent");
      asm volatile("s_waitcnt vmcnt(0)" ::: "memory");
    }
  }
  __syncthreads();
}

typedef __attribute__((address_space(4))) const Params* KParamsPtr;
__global__ void __launch_bounds__(512, 2) hybrid_megakernel(Params p_unused) {
  extern __shared__ __attribute__((aligned(16))) char smem[];
  __shared__ uint4 xb_words;
  cg::grid_group grid = cg::this_grid();
  const int bid = blockIdx.x, nb = gridDim.x;
  KParamsPtr q0 = (KParamsPtr)__builtin_amdgcn_kernarg_segment_ptr();
  const int sb = q0->step_begin, se = q0->step_end;
  if (threadIdx.x == 0) { xb_words = make_uint4(0u, 0u, 0u, 0u); (void)xb_add(&((unsigned*)(q0->ws + OFF_BAR))[XB_XCNT(xb_xcc_id())], 1u); }
  __syncthreads();
#ifdef PROBE_MASK
  __shared__ unsigned long long tacc_s[2];
  if (threadIdx.x == 0) tacc_s[0] = 0;
#endif
  for (int s = sb; s < se; ++s) {
    KParamsPtr q = q0; asm volatile("" : "+s"(q));
    Params lp; __builtin_memcpy(&lp, q, sizeof(Params));
#ifdef PROBE_MASK
    const unsigned long long t0 = wall_clock64();
#endif
    const bool did = run_step(lp, s, smem, bid, nb);
#ifdef PROBE_MASK
    const bool more = true;
#else
    const bool more = s + 1 < se;
#endif
    if (did && more) {
      if (s == sb) grid.sync();
      else xcd_barrier((unsigned*)(q0->ws + OFF_BAR), (volatile LAS unsigned*)&xb_words);
    }
#ifdef PROBE_MASK
    { const unsigned long long t1 = wall_clock64(); const int bit = (s == 0) ? 22 : (((s - 1) / STEPS_PER_LAYER) & 1) * 11 + (s - 1) % STEPS_PER_LAYER;
      if (((PROBE_MASK >> bit) & 1u) && threadIdx.x == 0) tacc_s[0] += t1 - t0; }
#endif
  }
#ifdef PROBE_MASK
  __syncthreads();
  if (bid == 0) { const unsigned n = (unsigned)(tacc_s[0] / 20); float* out = q0->out;
    for (unsigned i = threadIdx.x; i < n; i += 512) out[((size_t)i * 271) % ((size_t)SEQ * DM)] += 0.1f; }
#endif
}

extern "C" void kernel_launch(void* const* d_in, const int* in_sizes, int n_in, void* d_out, int out_size, void* d_ws, size_t ws_size, hipStream_t stream) {
  static int grid_blocks = 0;
  if (!grid_blocks) {
    int dev = 0, cus = 0, per_cu = 0;
    hipGetDevice(&dev);
    hipDeviceGetAttribute(&cus, hipDeviceAttributeMultiprocessorCount, dev);
    hipFuncSetAttribute((const void*)hybrid_megakernel, hipFuncAttributeMaxDynamicSharedMemorySize, LDS_BYTES);
    hipOccupancyMaxActiveBlocksPerMultiprocessor(&per_cu, hybrid_megakernel, 512, LDS_BYTES);
    if (per_cu < 1) per_cu = 1;
    if (per_cu > 1) per_cu = 1;
    grid_blocks = cus * per_cu;
  }
  if (ws_size < WS_NEEDED) { fprintf(stderr, "workspace too small: %zu < %zu\n", ws_size, (size_t)WS_NEEDED); return; }
  Params p{};
  const float** pp = (const float**)&p;
  for (int i = 0; i < 29; ++i) pp[i] = (const float*)d_in[i];
  p.out = (float*)d_out; p.ws = (char*)d_ws; p.step_begin = 0; p.step_end = N_STEPS;
  hipMemsetAsync((char*)d_ws + OFF_BAR, 0, SZ_BAR, stream);
  void* args[] = {&p};
  hipError_t e = hipLaunchCooperativeKernel((const void*)hybrid_megakernel, dim3(grid_blocks), dim3(512), args, LDS_BYTES, stream);
  if (e != hipSuccess) fprintf(stderr, "cooperative launch failed: %s (grid %d)\n", hipGetErrorString(e), grid_blocks);
}
#endif
```

```cpp
#ifdef EMU
#include "emu.h"
#else
#include <hip/hip_runtime.h>
#include <hip/hip_cooperative_groups.h>
#include <cstdio>
namespace cg = cooperative_groups;
#endif

typedef unsigned short bf16_t;
typedef short bf16x8 __attribute__((ext_vector_type(8)));
typedef float f32x4 __attribute__((ext_vector_type(4)));
typedef float f32x2 __attribute__((ext_vector_type(2)));
typedef unsigned u32x4 __attribute__((ext_vector_type(4)));
typedef unsigned u32x2 __attribute__((ext_vector_type(2)));

#ifdef EMU_SMALL
constexpr int SEQ = EMU_SEQ, DM = 256, DEPTH = 2, GLA_H = 2, MOBA_H = 2, GDN_H = 2, S5_CH = 256, DFF = 512;
constexpr float ALPHA = 1.4142135623730951f;
#else
constexpr int SEQ = 8192, DM = 2048, DEPTH = 4, GLA_H = 8, MOBA_H = 8, GDN_H = 8, S5_CH = 1024, DFF = 5632;
constexpr float ALPHA = 1.681792830507429f;
#endif
constexpr int N_EVEN = (DEPTH + 1) / 2, N_ODD = DEPTH / 2;
constexpr int NCH = SEQ / 64, NBLK = SEQ / 256;
constexpr int S5_G = S5_CH / 16, S5_P = 64;
constexpr int EV_GQ = 0, EV_GK = GLA_H * 64, EV_GV = 2 * GLA_H * 64, EV_GLR = EV_GV + GLA_H * 128, EV_GR = EV_GLR + 16,
              EV_MQ = EV_GR + GLA_H * 128, EV_MK = EV_MQ + MOBA_H * 128, EV_MV = EV_MK + MOBA_H * 128, EVEN_IN = EV_MV + MOBA_H * 128;
constexpr int EV_LD = EV_MQ;
constexpr int OD_QKV = 0, OD_Z = 3 * GDN_H * 128, OD_BETA = OD_Z + GDN_H * 128, OD_DEC = OD_BETA + GDN_H, OD_U = OD_DEC + GDN_H, ODD_IN = OD_U + S5_CH;
constexpr int OD_LD = ODD_IN;
constexpr int EVEN_OUT = GLA_H * 128 + MOBA_H * 128, ODD_OUT = GDN_H * 128 + S5_CH;
constexpr int EVEN_NMAIN = EVEN_IN - 16;
static_assert(EVEN_NMAIN % 256 == 0, "even projection main part must tile by 256");
constexpr int EVEN_NP = EVEN_NMAIN + 256, ODD_NP = ((ODD_IN + 255) / 256) * 256;
constexpr int MQ_LD = MOBA_H * 128;
constexpr int STEPS_PER_LAYER = 11, N_STEPS = 1 + DEPTH * STEPS_PER_LAYER;
constexpr int LDS_BYTES = 143360;
#ifdef EMU
constexpr bool GLU_IN_WINDOW = false;
#else
constexpr bool GLU_IN_WINDOW = true;
#endif

constexpr size_t al256(size_t x) { return (x + 255) & ~(size_t)255; }
constexpr size_t cmax(size_t a, size_t b) { return a > b ? a : b; }
constexpr size_t SZ_WINE = al256((size_t)EVEN_NP * DM * 2), SZ_WOUTE = al256((size_t)DM * EVEN_OUT * 2), SZ_WINO = al256((size_t)ODD_NP * DM * 2),
                 SZ_WGLU = al256((size_t)S5_CH * S5_CH * 2), SZ_WOUTO = al256((size_t)DM * ODD_OUT * 2), SZ_WUP = al256((size_t)2 * DFF * DM * 2), SZ_WDN = al256((size_t)DM * DFF * 2);
constexpr size_t OFF_WINE = 0, OFF_WOUTE = OFF_WINE + N_EVEN * SZ_WINE, OFF_WINO = OFF_WOUTE + N_EVEN * SZ_WOUTE, OFF_WGLU = OFF_WINO + N_ODD * SZ_WINO,
                 OFF_WOUTO = OFF_WGLU + N_ODD * SZ_WGLU, OFF_WUP = OFF_WOUTO + N_ODD * SZ_WOUTO, OFF_WDN = OFF_WUP + DEPTH * SZ_WUP, OFF_ACT = OFF_WDN + DEPTH * SZ_WDN;
constexpr size_t SZ_XB = al256((size_t)SEQ * DM * 2), SZ_X32 = al256((size_t)SEQ * DM * 4), SZ_H32 = al256((size_t)SEQ * cmax(EV_LD, OD_LD) * 4),
                 SZ_CAT = al256((size_t)SEQ * cmax(EVEN_OUT, ODD_OUT) * 2), SZ_STATS = al256((size_t)DEPTH * 2 * SEQ * 2 * 4),
                 SZ_S5C1 = al256((size_t)36 * S5_G * S5_P * 4), SZ_KMEAN = al256((size_t)MOBA_H * NBLK * 128 * 4);
constexpr size_t OFF_BAR = OFF_ACT, SZ_BAR = 16384;
constexpr size_t OFF_XB = OFF_BAR + SZ_BAR, OFF_X32 = OFF_XB + SZ_XB, OFF_Y32 = OFF_X32 + SZ_X32, OFF_H32 = OFF_Y32 + SZ_X32, OFF_CAT = OFF_H32 + SZ_H32, OFF_STATS = OFF_CAT + SZ_CAT,
                 OFF_S5C = OFF_STATS + SZ_STATS, OFF_KMEAN = OFF_S5C + N_ODD * SZ_S5C1, OFF_SCR = OFF_KMEAN + SZ_KMEAN;
constexpr size_t SZ_H16 = al256((size_t)SEQ * 2 * DFF * 2), SZ_G16 = al256((size_t)SEQ * DFF * 2);
constexpr size_t OFF_H16 = OFF_SCR, OFF_G16 = OFF_H16 + SZ_H16, END_FFN = OFF_G16 + SZ_G16;
constexpr size_t SZ_MQ = al256((size_t)SEQ * MQ_LD * 2), SZ_KVS = al256((size_t)GLA_H * NCH * 64 * 128 * 4), SZ_DEC = al256((size_t)GLA_H * NCH * 64 * 4);
constexpr size_t OFF_MQ = OFF_SCR, OFF_MK = OFF_MQ + SZ_MQ, OFF_MVT = OFF_MK + SZ_MQ, OFF_KVS = OFF_MVT + SZ_MQ, OFF_DEC = OFF_KVS + SZ_KVS, OFF_SPV = OFF_DEC + SZ_DEC, OFF_MCNT = OFF_SPV + SZ_KVS, OFF_MLIST = OFF_MCNT + 4096, OFF_PO = OFF_MLIST + al256((size_t)MOBA_H * NBLK * SEQ * 4),
                 OFF_PML = OFF_PO + al256((size_t)MOBA_H * SEQ * 4 * 128 * 4), END_EVEN = OFF_PML + al256((size_t)MOBA_H * SEQ * 4 * 2 * 4);
constexpr size_t SZ_GD = al256((size_t)GDN_H * NCH * 64 * 128 * 4), SZ_ATT = al256((size_t)GDN_H * NCH * 64 * 64 * 4), SZ_EGL = al256((size_t)GDN_H * NCH * 4),
                 SZ_O32 = al256((size_t)SEQ * GDN_H * 128 * 4), SZ_XEND = al256((size_t)NCH * S5_G * S5_P * 2 * 4), SZ_YS = al256((size_t)SEQ * S5_CH * 2);
constexpr size_t OFF_GU_ = 0;
constexpr size_t OFF_GU = OFF_SCR, OFF_GW = OFF_GU + SZ_GD, OFF_GQD = OFF_GW + SZ_GD, OFF_GKD = OFF_GQD + SZ_GD, OFF_ATT = OFF_GKD + SZ_GD, OFF_EGL = OFF_ATT + SZ_ATT,
                 OFF_O32 = OFF_EGL + SZ_EGL, OFF_XEND = OFF_O32 + SZ_O32, OFF_YS = OFF_XEND + SZ_XEND, OFF_CARRY = OFF_YS + SZ_YS, END_ODD = OFF_CARRY + SZ_XEND;
constexpr size_t WS_NEEDED = cmax(END_FFN, cmax(END_EVEN, END_ODD));

struct Params {
  const float *x, *even_w_in, *gla_w_gate2, *gla_b_gate, *gla_norm_g, *even_w_out, *odd_w_in, *gdn_conv_w, *gdn_a_log, *gdn_dt_bias, *gdn_norm_g,
      *s5_a_re, *s5_a_im, *s5_b_re, *s5_b_im, *s5_c_re, *s5_c_im, *s5_d, *s5_log_step, *s5_glu_w, *s5_glu_b, *odd_w_out, *ln_mix_g, *ln_mix_b,
      *ffn_w_up, *ffn_conv_w, *ffn_w_down, *ln_ffn_g, *ln_ffn_b;
  float* out; char* ws; int step_begin, step_end;
};

#ifdef EMU
__device__ __forceinline__ int tid_() { return threadIdx.x; }
#define LAUNDER_S(x)
#define SCHED_FENCE()
#define LAUNDER_V(x)
#define DRAIN_VM()
__device__ __forceinline__ void lds_barrier() { __syncthreads(); }
#else
__device__ __forceinline__ void lds_barrier() { asm volatile("s_waitcnt lgkmcnt(0)\n\ts_barrier" ::: "memory"); }
__device__ __forceinline__ int tid_() { int t = threadIdx.x; asm volatile("" : "+v"(t)); return t; }
#define LAUNDER_S(x) asm volatile("" : "+s"(x))
#define DRAIN_VM() __builtin_amdgcn_s_waitcnt(0x0F70)
#define SCHED_FENCE() __builtin_amdgcn_sched_barrier(0)
#define LAUNDER_V(x) asm volatile("" : "+v"(x))
#endif

__device__ __forceinline__ bf16_t f2bf(float f) { unsigned u = __float_as_uint(f); u += 0x7FFFu + ((u >> 16) & 1u); return (bf16_t)(u >> 16); }
__device__ __forceinline__ float bf2f(bf16_t b) { return __uint_as_float(((unsigned)b) << 16); }
#ifdef EMU
__device__ __forceinline__ unsigned pack2(float lo, float hi) { return (unsigned)f2bf(lo) | ((unsigned)f2bf(hi) << 16); }
#else
typedef __bf16 bf16v2_t __attribute__((ext_vector_type(2)));
__device__ __forceinline__ unsigned pack2(float lo, float hi) { const bf16v2_t v = __builtin_convertvector((f32x2){lo, hi}, bf16v2_t); return __builtin_bit_cast(unsigned, v); }
#endif
__device__ __forceinline__ float sigmoidf_(float x) { return 1.f / (1.f + __expf(-x)); }
__device__ __forceinline__ float siluf_(float x) { return x / (1.f + __expf(-x)); }
__device__ __forceinline__ float softplusf_(float x) { return fmaxf(x, 0.f) + log1pf(__expf(-fabsf(x))); }
__device__ __forceinline__ float geluf_(float x) { float u = 0.7978845608028654f * (x + 0.044715f * x * x * x); float e = __expf(2.f * u); float th = 1.f - 2.f / (e + 1.f); return 0.5f * x * (1.f + th); }
__device__ __forceinline__ f32x4 shfl_xor4(f32x4 v, int m) {
#ifdef EMU
  return __shfl_xor(v, m);
#else
  f32x4 r; r[0] = __shfl_xor(v[0], m); r[1] = __shfl_xor(v[1], m); r[2] = __shfl_xor(v[2], m); r[3] = __shfl_xor(v[3], m); return r;
#endif
}
__device__ __forceinline__ f32x4 f4zero() { return (f32x4){0.f, 0.f, 0.f, 0.f}; }
template <int CTRL> __device__ __forceinline__ float dpp_mov(float v) {
#ifdef EMU
  const int l = tid_() & 63; const int src = (CTRL == 0xB1) ? (l ^ 1) : (CTRL == 0x4E) ? (l ^ 2) : ((l & ~7) | (7 - (l & 7)));
  return __shfl(v, src);
#else
  return __builtin_bit_cast(float, __builtin_amdgcn_update_dpp(0, __builtin_bit_cast(int, v), CTRL, 0xF, 0xF, true));
#endif
}
__device__ __forceinline__ f32x4 red4_f4(f32x4 v) {
#pragma unroll
  for (int e = 0; e < 4; ++e) { v[e] += dpp_mov<0xB1>(v[e]); v[e] += dpp_mov<0x4E>(v[e]); }
  return v;
}
__device__ __forceinline__ f32x4 red8_f4(f32x4 v) {
#pragma unroll
  for (int e = 0; e < 4; ++e) { v[e] += dpp_mov<0xB1>(v[e]); v[e] += dpp_mov<0x4E>(v[e]); v[e] += dpp_mov<0x141>(v[e]); }
  return v;
}

namespace pg8 {
constexpr int BM = 256, BK = 64, HALF = 128, HTB = HALF * BK * 2, STAGE_BYTES = 8 * HTB, NXCD = 8, WGM = 8;
__host__ __device__ __forceinline__ int lds_byte(int r, int c) { const int st = (r >> 4) * 2 + (c >> 5), rr = r & 15, cc = c & 31, ob = rr * 64 + cc * 2; return st * 1024 + (ob ^ (((ob >> 9) & 1) << 5)); }
__host__ __device__ __forceinline__ void stage_rc(int b, int& R, int& C) { const int st = b / 1024, sb = b % 1024, swz = sb ^ (((sb >> 9) & 1) << 5); R = (st >> 1) * 16 + swz / 64; C = (st & 1) * 32 + (swz % 64) / 2; }
__host__ __device__ __forceinline__ int perm32(int rho) { const int n = rho >> 4, i = rho & 15; return 8 * (i >> 2) + 4 * n + (i & 3); }
struct Unit { int pm, pn; };
struct Gemm { const bf16_t* A; const bf16_t* Bt; int M, N, K; };
struct StaticOrder {
  int nM, nN, nwg, G, c;
  __host__ __device__ void init(int M, int N, int G_, int c_) { nM = M / BM; nN = N / BM; nwg = nM * nN; G = G_; c = c_; }
  __host__ __device__ bool next(int i, Unit& u) const {
    const long L = (long)i * G + c; if (L >= nwg) return false;
    int wgid = (int)L; { const int q = nwg / NXCD, r = nwg % NXCD, xcd = wgid % NXCD, off = wgid / NXCD; wgid = (xcd < r ? xcd * (q + 1) : r * (q + 1) + (xcd - r) * q) + off; }
    const int nig = WGM * nN, gid = wgid / nig, fm = gid * WGM, gsz = (nM - fm) < WGM ? (nM - fm) : WGM;
    u.pm = fm + ((wgid % nig) % gsz); u.pn = (wgid % nig) / gsz; return true;
  }
};
#ifndef EMU
#define PG8_LAS __attribute__((address_space(3)))
template <class Epi>
__device__ __forceinline__ void gemm_phase(char* smem, const Gemm g, const StaticOrder& S, const Epi& E) {
  PG8_LAS unsigned char* lds = (PG8_LAS unsigned char*)smem;
  const int tid = tid_(), wid = __builtin_amdgcn_readfirstlane(tid >> 6), lane = tid & 63, wr = wid >> 2, wc = wid & 3, fr = lane & 15, fq = lane >> 4;
  const int K = g.K, nt = K / BK;
  unsigned voffA[2], voffB[2];
#pragma unroll
  for (int i = 0; i < 2; ++i) { int R, C; stage_rc(tid * 16 + i * 8192, R, C); const int Rb = Epi::PERM ? ((R & ~31) + perm32(R & 31)) : R; voffA[i] = (unsigned)(R * K + C) * 2u; voffB[i] = (unsigned)(Rb * K + C) * 2u; }
  const size_t kstep = (size_t)(BK * 2);
  const size_t hstep = (size_t)HALF * K * 2;
  const size_t tstep = 2 * hstep;
  const unsigned ldsw = (unsigned)wid * 1024u;
  const int aoff = lds_byte(wr * 64 + fr, fq * 8), boff = lds_byte(wc * 32 + fr, fq * 8);
#define PG8_SA(b, h) (((b) * 2 + (h)) * HTB)
#define PG8_SB(b, h) ((4 + (b) * 2 + (h)) * HTB)
#define PG8_STAGE(bufoff, gbase, voff) do { _Pragma("unroll") for (int _i = 0; _i < 2; ++_i) \
    __builtin_amdgcn_global_load_lds((const unsigned*)((const char*)(gbase) + (voff)[_i]), (PG8_LAS unsigned*)(lds + (bufoff) + ldsw + _i * 8192), 16, 0, 0); } while (0)
#define PG8_LDA(dst, b, h) do { _Pragma("unroll") for (int m = 0; m < 4; ++m) _Pragma("unroll") for (int k = 0; k < 2; ++k) dst[m][k] = *(const PG8_LAS bf16x8*)(lds + PG8_SA(b, h) + aoff + m * 2048 + k * 1024); } while (0)
#define PG8_LDB(dst, b, h) do { _Pragma("unroll") for (int n = 0; n < 2; ++n) _Pragma("unroll") for (int k = 0; k < 2; ++k) dst[n][k] = *(const PG8_LAS bf16x8*)(lds + PG8_SB(b, h) + boff + n * 2048 + k * 1024); } while (0)
#define PG8_MMA(ai, bj, At, Bt) do { __builtin_amdgcn_s_setprio(1); _Pragma("unroll") for (int m = 0; m < 4; ++m) _Pragma("unroll") for (int n = 0; n < 2; ++n) _Pragma("unroll") for (int k = 0; k < 2; ++k) \
    acc[ai][bj][m][n] = __builtin_amdgcn_mfma_f32_16x16x32_bf16(Bt[n][k], At[m][k], acc[ai][bj][m][n], 0, 0, 0); __builtin_amdgcn_s_setprio(0); } while (0)
#define PG8_WAIT_V(n) asm volatile("s_waitcnt vmcnt(" #n ")" ::: "memory")
#define PG8_WAIT_L(n) asm volatile("s_waitcnt lgkmcnt(" #n ")" ::: "memory")
#define PG8_BAR __builtin_amdgcn_s_barrier()
#define PG8_SCHED __builtin_amdgcn_sched_barrier(0)
  Unit cur, nxt; int ui = 0;
  if (!S.next(0, cur)) return;
  f32x4 acc[2][2][4][2];
#pragma unroll
  for (int a = 0; a < 2; ++a)
#pragma unroll
    for (int b = 0; b < 2; ++b)
#pragma unroll
      for (int m = 0; m < 4; ++m)
#pragma unroll
        for (int n = 0; n < 2; ++n) acc[a][b][m][n] = (f32x4){0.f, 0.f, 0.f, 0.f};
  bf16x8 At[4][2], B0[2][2], B1[2][2];
  const char* cA = (const char*)g.A + (size_t)cur.pm * tstep; const char* cB = (const char*)g.Bt + (size_t)cur.pn * tstep;
  PG8_STAGE(PG8_SB(0, 0), cB, voffB); PG8_STAGE(PG8_SA(0, 0), cA, voffA); PG8_STAGE(PG8_SB(0, 1), cB + hstep, voffB); PG8_STAGE(PG8_SA(0, 1), cA + hstep, voffA);
  if (wr == 1) PG8_BAR;
  PG8_WAIT_V(4); PG8_BAR;
  PG8_STAGE(PG8_SB(1, 0), cB + kstep, voffB); PG8_STAGE(PG8_SA(1, 0), cA + kstep, voffA); PG8_STAGE(PG8_SB(1, 1), cB + hstep + kstep, voffB);
  PG8_WAIT_V(6); PG8_BAR;
  for (;;) {
    const bool has_next = S.next(ui + 1, nxt);
    const char* nA = has_next ? (const char*)g.A + (size_t)nxt.pm * tstep : cA; const char* nB = has_next ? (const char*)g.Bt + (size_t)nxt.pn * tstep : cB;
    for (int t = 0; t < nt; t += 2) {
      const bool last = (t == nt - 2);
      const char* a1 = cA + (size_t)(t + 1) * kstep;
      const char* a2 = last ? nA : cA + (size_t)(t + 2) * kstep; const char* b2 = last ? nB : cB + (size_t)(t + 2) * kstep;
      const char* a3 = a2 + kstep; const char* b3 = b2 + kstep;
      PG8_LDB(B0, 0, 0); PG8_SCHED; PG8_LDA(At, 0, 0); PG8_STAGE(PG8_SA(1, 1), a1 + hstep, voffA);
      PG8_WAIT_L(8); PG8_BAR; PG8_WAIT_L(0); PG8_MMA(0, 0, At, B0); PG8_BAR; PG8_SCHED;
      PG8_LDB(B1, 0, 1); PG8_STAGE(PG8_SB(0, 0), b2, voffB);
      PG8_BAR; PG8_WAIT_L(0); PG8_MMA(0, 1, At, B1); PG8_BAR;
      PG8_LDA(At, 0, 1); PG8_STAGE(PG8_SA(0, 0), a2, voffA);
      PG8_BAR; PG8_WAIT_L(0); PG8_MMA(1, 0, At, B0); PG8_BAR; PG8_SCHED;
      PG8_STAGE(PG8_SB(0, 1), b2 + hstep, voffB);
      PG8_WAIT_V(6); PG8_BAR; PG8_MMA(1, 1, At, B1); PG8_BAR;
      PG8_LDB(B0, 1, 0); PG8_SCHED; PG8_LDA(At, 1, 0); PG8_STAGE(PG8_SA(0, 1), a2 + hstep, voffA);
      PG8_WAIT_L(8); PG8_BAR; PG8_WAIT_L(0); PG8_MMA(0, 0, At, B0); PG8_BAR; PG8_SCHED;
      PG8_LDB(B1, 1, 1); PG8_STAGE(PG8_SB(1, 0), b3, voffB);
      PG8_BAR; PG8_WAIT_L(0); PG8_MMA(0, 1, At, B1); PG8_BAR;
      PG8_LDA(At, 1, 1); PG8_STAGE(PG8_SA(1, 0), a3, voffA);
      PG8_BAR; PG8_WAIT_L(0); PG8_MMA(1, 0, At, B0); PG8_BAR; PG8_SCHED;
      PG8_STAGE(PG8_SB(1, 1), b3 + hstep, voffB);
      PG8_WAIT_V(6); PG8_BAR; PG8_MMA(1, 1, At, B1); PG8_BAR;
    }
    E(acc, cur, wr, wc, fr, fq);
    if (!has_next) break;
#pragma unroll
    for (int a = 0; a < 2; ++a)
#pragma unroll
      for (int b = 0; b < 2; ++b)
#pragma unroll
        for (int m = 0; m < 4; ++m)
#pragma unroll
          for (int n = 0; n < 2; ++n) acc[a][b][m][n] = (f32x4){0.f, 0.f, 0.f, 0.f};
    cur = nxt; cA = nA; cB = nB; ++ui;
  }
  PG8_WAIT_V(0);
  if (wr == 0) PG8_BAR;
  PG8_BAR;
#undef PG8_SA
#undef PG8_SB
#undef PG8_STAGE
#undef PG8_LDA
#undef PG8_LDB
#undef PG8_MMA
#undef PG8_WAIT_V
#undef PG8_WAIT_L
#undef PG8_BAR
#undef PG8_SCHED
}
#else
template <class Epi>
void gemm_phase(char* smem, const Gemm g, const StaticOrder& S, const Epi& E) {
  const int tid = tid_(), wid = tid >> 6, lane = tid & 63, wr = wid >> 2, wc = wid & 3, fr = lane & 15, fq = lane >> 4;
  Unit u;
  for (int i = 0; S.next(i, u); ++i) {
    f32x4 acc[2][2][4][2];
    for (int ai = 0; ai < 2; ++ai) for (int bj = 0; bj < 2; ++bj) for (int m = 0; m < 4; ++m) for (int n = 0; n < 2; ++n) for (int j = 0; j < 4; ++j) {
      int row = u.pm * 256 + ai * 128 + wr * 64 + m * 16 + fr, col = u.pn * 256 + bj * 128 + wc * 32 + (Epi::PERM ? (fq * 8 + n * 4) : (n * 16 + fq * 4)) + j;
      const bf16_t* a = g.A + (size_t)row * g.K; const bf16_t* b = g.Bt + (size_t)col * g.K; float s = 0.f;
      for (int k = 0; k < g.K; ++k) s += bf2f(a[k]) * bf2f(b[k]);
      acc[ai][bj][m][n][j] = s;
    }
    E(acc, u, wr, wc, fr, fq);
  }
}
#endif
}
using pg8::Unit;

#define EPI_LOOP_BEGIN _Pragma("unroll") for (int ai = 0; ai < 2; ++ai) _Pragma("unroll") for (int m = 0; m < 4; ++m) { const int row = u.pm * 256 + ai * 128 + wr * 64 + m * 16 + fr;
#define EPI_FRAG_LOOP _Pragma("unroll") for (int bj = 0; bj < 2; ++bj) _Pragma("unroll") for (int n = 0; n < 2; ++n) { const int col = EPI_COLMAP(u.pn * 256 + bj * 128 + wc * 32 + n * 16 + fq * 4); const f32x4 v = acc[ai][bj][m][n];
#define EPI_COLMAP(c) (c)
#undef EPI_COLMAP
#define EPI_COLMAP(c) ((c) + (((c) >= EV_GLR) ? 16 : 0))
struct EpiEvenIn {
  static constexpr bool PERM = false;
  float* H32; bf16_t *MQ, *MK, *MVT;
  __device__ __forceinline__ void operator()(const f32x4 (&acc)[2][2][4][2], const Unit& u, int wr, int wc, int fr, int fq) const {
    EPI_LOOP_BEGIN
      EPI_FRAG_LOOP
        const int gcol = col; (void)gcol;
        if (col < EV_MQ) *(f32x4*)(H32 + (size_t)row * EV_LD + col) = v;
        else if (col < EV_MK) *(u32x2*)(MQ + (size_t)row * MQ_LD + (col - EV_MQ)) = (u32x2){pack2(v[0], v[1]), pack2(v[2], v[3])};
        else if (col < EV_MV) *(u32x2*)(MK + (size_t)row * MQ_LD + (col - EV_MK)) = (u32x2){pack2(v[0], v[1]), pack2(v[2], v[3])};
        else if (col < EVEN_IN) { bf16_t* d = MVT + (size_t)(col - EV_MV) * SEQ + row; d[0] = f2bf(v[0]); d[SEQ] = f2bf(v[1]); d[2 * (size_t)SEQ] = f2bf(v[2]); d[3 * (size_t)SEQ] = f2bf(v[3]); }
      }
    }
  }
};
#undef EPI_COLMAP
#define EPI_COLMAP(c) (c)
struct EpiOddIn {
  static constexpr bool PERM = false;
  float* H32;
  __device__ __forceinline__ void operator()(const f32x4 (&acc)[2][2][4][2], const Unit& u, int wr, int wc, int fr, int fq) const {
    EPI_LOOP_BEGIN
      EPI_FRAG_LOOP
        if (col < ODD_IN) *(f32x4*)(H32 + (size_t)row * OD_LD + col) = v;
      }
    }
  }
};
struct EpiBf16 {
  static constexpr bool PERM = true;
  bf16_t* O; int ld;
  __device__ __forceinline__ void operator()(const f32x4 (&acc)[2][2][4][2], const Unit& u, int wr, int wc, int fr, int fq) const {
    EPI_LOOP_BEGIN
      _Pragma("unroll") for (int bj = 0; bj < 2; ++bj) { const int col = u.pn * 256 + bj * 128 + wc * 32 + fq * 8; const f32x4 v0 = acc[ai][bj][m][0], v1 = acc[ai][bj][m][1];
        *(u32x4*)(O + (size_t)row * ld + col) = (u32x4){pack2(v0[0], v0[1]), pack2(v0[2], v0[3]), pack2(v1[0], v1[1]), pack2(v1[2], v1[3])};
      }
    }
  }
};
struct EpiRes {
  static constexpr bool PERM = false;
  const float* raw; const float* pst; const float* pg; const float* pb; float* Y; float* stats;
  __device__ __forceinline__ void operator()(const f32x4 (&acc)[2][2][4][2], const Unit& u, int wr, int wc, int fr, int fq) const {
    EPI_LOOP_BEGIN
      SCHED_FENCE();
      float s = 0.f, ss = 0.f, mu = 0.f, rs = 1.f;
      if (!raw) { mu = pst[(size_t)row * 2] * (1.f / DM); const float var = pst[(size_t)row * 2 + 1] * (1.f / DM) - mu * mu; rs = rsqrtf(fmaxf(var, 0.f) + 1e-5f); }
      EPI_FRAG_LOOP
        f32x4 r;
        if (raw) r = *(const f32x4*)(raw + (size_t)row * DM + col);
        else { const f32x4 yo = *(const f32x4*)(Y + (size_t)row * DM + col), gg = *(const f32x4*)(pg + col), bb = *(const f32x4*)(pb + col); r = (yo - mu) * rs * gg + bb; }
        const f32x4 y = r * ALPHA + v;
        *(f32x4*)(Y + (size_t)row * DM + col) = y;
        s += y[0] + y[1] + y[2] + y[3]; ss += y[0] * y[0] + y[1] * y[1] + y[2] * y[2] + y[3] * y[3];
      }
      s += __shfl_xor(s, 16); ss += __shfl_xor(ss, 16); s += __shfl_xor(s, 32); ss += __shfl_xor(ss, 32);
      if (fq == 0) { atomicAdd(stats + (size_t)row * 2, s); atomicAdd(stats + (size_t)row * 2 + 1, ss); }
    }
  }
};
struct EpiGlu {
  static constexpr bool PERM = false;
  const bf16_t* YS; const float* bias; bf16_t* CAT;
  __device__ __forceinline__ void operator()(const f32x4 (&acc)[2][2][4][2], const Unit& u, int wr, int wc, int fr, int fq) const {
    EPI_LOOP_BEGIN
      EPI_FRAG_LOOP
        const u32x2 yy = *(const u32x2*)(YS + (size_t)row * S5_CH + col);
        const f32x4 b = *(const f32x4*)(bias + col);
        float y0 = __uint_as_float(yy[0] << 16), y1 = __uint_as_float(yy[0] & 0xffff0000u), y2 = __uint_as_float(yy[1] << 16), y3 = __uint_as_float(yy[1] & 0xffff0000u);
        y0 *= sigmoidf_(v[0] + b[0]); y1 *= sigmoidf_(v[1] + b[1]); y2 *= sigmoidf_(v[2] + b[2]); y3 *= sigmoidf_(v[3] + b[3]);
        *(u32x2*)(CAT + (size_t)row * ODD_OUT + GDN_H * 128 + col) = (u32x2){pack2(y0, y1), pack2(y2, y3)};
      }
    }
  }
};

template <class Epi> __device__ __forceinline__ void run_gemm(char* smem, const bf16_t* A, const bf16_t* Bt, int N, int K, const Epi& E, int bid, int nb) {
  pg8::Gemm g{A, Bt, SEQ, N, K}; pg8::StaticOrder S; S.init(SEQ, N, nb, bid);
  pg8::gemm_phase<Epi>(smem, g, S, E);
}

__device__ __forceinline__ void transpose_convert(const float* src, bf16_t* dst, int K, int N, int Np, char* smem, int bid, int nb, int glr = -1) {
  float* T = (float*)smem;
  const int tk = K / 64, tn = Np / 64, ntile = tk * tn, tid = tid_();
  const int r0 = tid >> 4, c4 = (tid & 15) * 4;
  f32x4 v[2];
  if (bid < ntile) { const int k0 = (bid % tk) * 64, n = (bid / tk) * 64 + c4;
#pragma unroll
    for (int i = 0; i < 2; ++i) v[i] = (n < N) ? *(const f32x4*)(src + (size_t)(k0 + r0 + 32 * i) * N + n) : f4zero(); }
  for (int t = bid; t < ntile; t += nb) {
    const int k0 = (t % tk) * 64, n0 = (t / tk) * 64;
#pragma unroll
    for (int i = 0; i < 2; ++i) {
#pragma unroll
      for (int e = 0; e < 4; ++e) T[(c4 + e) * 65 + r0 + 32 * i] = v[i][e]; }
    __syncthreads();
    if (t + nb < ntile) { const int k1 = ((t + nb) % tk) * 64, n = ((t + nb) / tk) * 64 + c4;
#pragma unroll
      for (int i = 0; i < 2; ++i) v[i] = (n < N) ? *(const f32x4*)(src + (size_t)(k1 + r0 + 32 * i) * N + n) : f4zero(); }
    { const int n = tid >> 3, ks = (tid & 7) * 8; const float* tp = T + n * 65 + ks;
      u32x4 o; o[0] = pack2(tp[0], tp[1]); o[1] = pack2(tp[2], tp[3]); o[2] = pack2(tp[4], tp[5]); o[3] = pack2(tp[6], tp[7]);
      int dn = n0 + n; if (glr >= 0) dn = (dn < glr) ? dn : (dn < glr + 16) ? (N - 16 + (dn - glr)) : (dn < N) ? dn - 16 : dn;
      *(u32x4*)(dst + (size_t)dn * K + k0 + ks) = o; }
    __syncthreads();
  }
}
__device__ __forceinline__ void conv_mat(const Params& p, int kind, int idx, char* smem, int bid, int nb) {
  const float* src; size_t doff; int K, N, Np, glr = -1;
  switch (kind) {
    case 0: src = p.even_w_in + (size_t)idx * DM * EVEN_IN; doff = OFF_WINE + idx * SZ_WINE; K = DM; N = EVEN_IN; Np = EVEN_NP; glr = EV_GLR; break;
    case 1: src = p.even_w_out + (size_t)idx * EVEN_OUT * DM; doff = OFF_WOUTE + idx * SZ_WOUTE; K = EVEN_OUT; N = DM; Np = DM; break;
    case 2: src = p.odd_w_in + (size_t)idx * DM * ODD_IN; doff = OFF_WINO + idx * SZ_WINO; K = DM; N = ODD_IN; Np = ODD_NP; break;
    case 3: src = p.s5_glu_w + (size_t)idx * S5_CH * S5_CH; doff = OFF_WGLU + idx * SZ_WGLU; K = S5_CH; N = S5_CH; Np = S5_CH; break;
    case 4: src = p.odd_w_out + (size_t)idx * ODD_OUT * DM; doff = OFF_WOUTO + idx * SZ_WOUTO; K = ODD_OUT; N = DM; Np = DM; break;
    case 5: src = p.ffn_w_up + (size_t)idx * DM * 2 * DFF; doff = OFF_WUP + idx * SZ_WUP; K = DM; N = 2 * DFF; Np = 2 * DFF; break;
    default: src = p.ffn_w_down + (size_t)idx * DFF * DM; doff = OFF_WDN + idx * SZ_WDN; K = DFF; N = DM; Np = DM; break;
  }
  transpose_convert(src, (bf16_t*)(p.ws + doff), K, N, Np, smem, bid, nb, glr);
}
__device__ __forceinline__ void conv_group(const Params& p, int g, char* smem, int bid, int nb) {
#pragma unroll 1
  for (int k = 0; k < 10; ++k) {
    int kind, idx; bool on;
    if (g < 0) { kind = (k < 2) ? k : (k < 4) ? k + 3 : k - 2; idx = 0; on = (k < 4) || (k < 7 && DEPTH > 1); }
    else {
      if (k < 2) { kind = 5 + k; idx = g; on = true; }
      else if (k < 4) { kind = k - 2; idx = (g + 1) >> 1; on = g + 1 < DEPTH; }
      else if (k < 6) { kind = 5 + (k - 4); idx = g + 1; on = g + 1 < DEPTH; }
      else if (k < 9) { kind = 2 + (k - 6); idx = (g + 2) >> 1; on = g + 2 < DEPTH; }
      else { kind = 0; idx = 0; on = false; }
    }
    if (on) conv_mat(p, kind, idx, smem, bid, nb);
  }
}
__device__ __forceinline__ void step_prep(const Params& p, char* smem, int bid, int nb) {
  char* ws = p.ws;
  conv_group(p, -1, smem, bid, nb);
  const size_t gt = (size_t)bid * 512 + tid_(), gn = (size_t)nb * 512;
  { bf16_t* XB = (bf16_t*)(ws + OFF_XB);
    for (size_t e = gt; e < (size_t)SEQ * DM / 4; e += gn) { const f32x4 v = *(const f32x4*)(p.x + e * 4); *(u32x2*)(XB + e * 4) = (u32x2){pack2(v[0], v[1]), pack2(v[2], v[3])}; } }
  { float* st = (float*)(ws + OFF_STATS); for (size_t e = gt; e < (size_t)DEPTH * 2 * SEQ * 2; e += gn) st[e] = 0.f; }
  for (size_t e = gt; e < (size_t)N_ODD * S5_G * S5_P; e += gn) {
    const int j = (int)(e / (S5_G * S5_P)), gp = (int)(e % (S5_G * S5_P)), g = gp / S5_P;
    float* C = (float*)(ws + OFF_S5C + j * SZ_S5C1);
    const float are = p.s5_a_re[(size_t)j * S5_G * S5_P + gp], aim = p.s5_a_im[(size_t)j * S5_G * S5_P + gp];
    const float step = expf(p.s5_log_step[j * S5_G + g]);
    const float mag = expf(are * step), abr = mag * cosf(aim * step), abi = mag * sinf(aim * step);
    const float den = are * are + aim * aim;
    const float zr = ((abr - 1.f) * are + abi * aim) / den, zi = (abi * are - (abr - 1.f) * aim) / den;
    C[gp] = abr; C[S5_G * S5_P + gp] = abi;
    float pr = abr, pi = abi;
    for (int k = 0; k < 6; ++k) { const float nr = pr * pr - pi * pi, ni = 2.f * pr * pi; pr = nr; pi = ni; }
    C[2 * S5_G * S5_P + gp] = pr; C[3 * S5_G * S5_P + gp] = pi;
    float* BBR = C + 4 * S5_G * S5_P + (size_t)gp * 16; float* BBI = C + 20 * S5_G * S5_P + (size_t)gp * 16;
    for (int c = 0; c < 16; ++c) { const float br = p.s5_b_re[((size_t)j * S5_G * S5_P + gp) * 16 + c], bi = p.s5_b_im[((size_t)j * S5_G * S5_P + gp) * 16 + c];
      BBR[c] = zr * br - zi * bi; BBI[c] = zr * bi + zi * br; }
  }
}

__device__ __forceinline__ void step_ln(const float* Y, const float* stats, const float* g, const float* b, float* X32, bf16_t* XB, int bid, int nb) {
  const int w = tid_() >> 6, lane = tid_() & 63;
  constexpr int NV = DM / 256;
  for (int row = bid * 8 + w; row < SEQ; row += nb * 8) {
    f32x4 y[NV];
#pragma unroll
    for (int i = 0; i < NV; ++i) y[i] = *(const f32x4*)(Y + (size_t)row * DM + lane * 4 + i * 256);
    const float mu = stats[(size_t)row * 2] * (1.f / DM); const float var = stats[(size_t)row * 2 + 1] * (1.f / DM) - mu * mu; const float rs = rsqrtf(fmaxf(var, 0.f) + 1e-5f);
#pragma unroll
    for (int i = 0; i < NV; ++i) { const int c = lane * 4 + i * 256;
      const f32x4 gg = *(const f32x4*)(g + c), bb = *(const f32x4*)(b + c);
      const f32x4 o = (y[i] - mu) * rs * gg + bb;
      if (X32) *(f32x4*)(X32 + (size_t)row * DM + c) = o;
      *(u32x2*)(XB + (size_t)row * DM + c) = (u32x2){pack2(o[0], o[1]), pack2(o[2], o[3])}; }
  }
}

__device__ __forceinline__ void step_ffn_conv(const bf16_t* H16, const float* cw, bf16_t* G16, int bid, int nb) {
  constexpr int CG = DFF / 8, RB = 16;
  const size_t total = (size_t)(SEQ / RB) * CG;
  for (size_t it = (size_t)bid * 512 + tid_(); it < total; it += (size_t)nb * 512) {
    const int cg8 = (int)(it % CG) * 8, t0 = (int)(it / CG) * RB;
    float wg[3][8], wv[3][8];
#pragma unroll
    for (int i = 0; i < 3; ++i) {
#pragma unroll
      for (int k = 0; k < 8; k += 4) { const f32x4 a = *(const f32x4*)(cw + (size_t)i * 2 * DFF + cg8 + k), b = *(const f32x4*)(cw + (size_t)i * 2 * DFF + DFF + cg8 + k);
        wg[i][k] = a[0]; wg[i][k + 1] = a[1]; wg[i][k + 2] = a[2]; wg[i][k + 3] = a[3]; wv[i][k] = b[0]; wv[i][k + 1] = b[1]; wv[i][k + 2] = b[2]; wv[i][k + 3] = b[3]; }
    }
    float g0[8], g1[8], v0[8], v1[8];
#pragma unroll
    for (int k = 0; k < 8; ++k) { g0[k] = g1[k] = v0[k] = v1[k] = 0.f; }
    if (t0 >= 2) {
      const u32x4 a = *(const u32x4*)(H16 + (size_t)(t0 - 2) * 2 * DFF + cg8), b = *(const u32x4*)(H16 + (size_t)(t0 - 2) * 2 * DFF + DFF + cg8);
      const u32x4 c = *(const u32x4*)(H16 + (size_t)(t0 - 1) * 2 * DFF + cg8), d = *(const u32x4*)(H16 + (size_t)(t0 - 1) * 2 * DFF + DFF + cg8);
#pragma unroll
      for (int k = 0; k < 4; ++k) { g0[2 * k] = __uint_as_float(a[k] << 16); g0[2 * k + 1] = __uint_as_float(a[k] & 0xffff0000u); v0[2 * k] = __uint_as_float(b[k] << 16); v0[2 * k + 1] = __uint_as_float(b[k] & 0xffff0000u);
        g1[2 * k] = __uint_as_float(c[k] << 16); g1[2 * k + 1] = __uint_as_float(c[k] & 0xffff0000u); v1[2 * k] = __uint_as_float(d[k] << 16); v1[2 * k + 1] = __uint_as_float(d[k] & 0xffff0000u); }
    }
#pragma unroll 1
    for (int tb = t0; tb < t0 + RB; tb += 8) {
      u32x4 ra[8], rb[8];
#pragma unroll
      for (int r = 0; r < 8; ++r) { ra[r] = *(const u32x4*)(H16 + (size_t)(tb + r) * 2 * DFF + cg8); rb[r] = *(const u32x4*)(H16 + (size_t)(tb + r) * 2 * DFF + DFF + cg8); }
#pragma unroll
      for (int r = 0; r < 8; ++r) {
        const u32x4 a = ra[r], b = rb[r]; const int t = tb + r;
        float g2[8], v2[8], o[8];
#pragma unroll
        for (int k = 0; k < 4; ++k) { g2[2 * k] = __uint_as_float(a[k] << 16); g2[2 * k + 1] = __uint_as_float(a[k] & 0xffff0000u); v2[2 * k] = __uint_as_float(b[k] << 16); v2[2 * k + 1] = __uint_as_float(b[k] & 0xffff0000u); }
#pragma unroll
        for (int k = 0; k < 8; ++k) { const float gg = wg[0][k] * g0[k] + wg[1][k] * g1[k] + wg[2][k] * g2[k]; const float vv = wv[0][k] * v0[k] + wv[1][k] * v1[k] + wv[2][k] * v2[k];
          o[k] = siluf_(gg) * vv; g0[k] = g1[k]; g1[k] = g2[k]; v0[k] = v1[k]; v1[k] = v2[k]; }
        u32x4 ov; ov[0] = pack2(o[0], o[1]); ov[1] = pack2(o[2], o[3]); ov[2] = pack2(o[4], o[5]); ov[3] = pack2(o[6], o[7]);
        *(u32x4*)(G16 + (size_t)t * DFF + cg8) = ov;
      }
    }
  }
}

__device__ __forceinline__ void gla_logcum(const Params& p, int j, int h, int n, float* CUM, const float* H32, float* TMP) {
  const int tid = tid_();
  const float* w2 = p.gla_w_gate2 + (size_t)j * 16 * (GLA_H * 64); const float* bg = p.gla_b_gate + (size_t)j * GLA_H * 64;
  float* GL = TMP; float* W2 = TMP + 1024; float* BG = W2 + 1024;
  for (int e = tid; e < 1024; e += 512) { GL[e] = H32[(size_t)(n * 64 + (e >> 4)) * EV_LD + EV_GLR + (e & 15)]; W2[e] = w2[(e >> 6) * (GLA_H * 64) + h * 64 + (e & 63)]; }
  if (tid < 64) BG[tid] = bg[h * 64 + tid];
  __syncthreads();
  for (int e = tid; e < 4096; e += 512) {
    const int t = e >> 6, d = e & 63; float x = BG[d];
#pragma unroll
    for (int r = 0; r < 16; ++r) x += GL[t * 16 + r] * W2[r * 64 + d];
    CUM[e] = (fminf(x, 0.f) - log1pf(__expf(-fabsf(x)))) * (1.f / 16.f);
  }
  __syncthreads();
  if (tid < 64) { float c = 0.f;
#pragma unroll 16
    for (int t = 0; t < 64; ++t) { c += CUM[t * 64 + tid]; CUM[t * 64 + tid] = c; } }
  __syncthreads();
}
__device__ __forceinline__ void gla_kv_item(const Params& p, int j, int h, int n, char* smem) {
  const float* H32 = (const float*)(p.ws + OFF_H32); float* KVS = (float*)(p.ws + OFF_KVS); float* DEC = (float*)(p.ws + OFF_DEC);
  float* CUM = (float*)smem; float* KD = CUM + 4096; float* VS = KD + 4096;
  const int tid = tid_();
  f32x4 vpre[4];
#pragma unroll
  for (int i = 0; i < 4; ++i) { const int e = tid + 512 * i, t = e >> 5, c4 = (e & 31) * 4; vpre[i] = *(const f32x4*)(H32 + (size_t)(n * 64 + t) * EV_LD + EV_GV + h * 128 + c4); }
  gla_logcum(p, j, h, n, CUM, H32, VS);
  for (int e = tid; e < 4096; e += 512) { const int t = e >> 6, d = e & 63; KD[e] = H32[(size_t)(n * 64 + t) * EV_LD + EV_GK + h * 64 + d] * __expf(CUM[63 * 64 + d] - CUM[e]); }
#pragma unroll
  for (int i = 0; i < 4; ++i) { const int e = tid + 512 * i, t = e >> 5, c4 = (e & 31) * 4; *(f32x4*)(VS + t * 128 + c4) = vpre[i]; }
  __syncthreads();
  const int dg = tid >> 5, vg = tid & 31;
  f32x4 acc[4] = {f4zero(), f4zero(), f4zero(), f4zero()};
#pragma unroll 4
  for (int t = 0; t < 64; ++t) { const f32x4 k4 = *(const f32x4*)(KD + t * 64 + dg * 4), v4 = *(const f32x4*)(VS + t * 128 + vg * 4);
#pragma unroll
    for (int i = 0; i < 4; ++i) acc[i] += k4[i] * v4; }
#pragma unroll
  for (int i = 0; i < 4; ++i) *(f32x4*)(KVS + ((size_t)(h * NCH + n) * 64 + dg * 4 + i) * 128 + vg * 4) = acc[i];
  if (tid < 64) DEC[(size_t)(h * NCH + n) * 64 + tid] = __expf(CUM[63 * 64 + tid]);
  __syncthreads();
}
__device__ __forceinline__ void gla_scan(const Params& p, int bid, int nb) {
  const float* __restrict__ KVS = (const float*)(p.ws + OFF_KVS); const float* __restrict__ DEC = (const float*)(p.ws + OFF_DEC); float* __restrict__ SPV = (float*)(p.ws + OFF_SPV);
  const int tid = tid_();
  if (tid < 256) for (int e = bid * 256 + tid; e < GLA_H * 64 * 128; e += nb * 256) {
    const int h = e / (64 * 128), d = (e >> 7) & 63, v = e & 127; float s = 0.f;
#pragma unroll 1
    for (int n0 = 0; n0 < NCH; n0 += 16) { float kv[16], dc[16];
#pragma unroll
      for (int k = 0; k < 16; ++k) { kv[k] = KVS[((size_t)(h * NCH + n0 + k) * 64 + d) * 128 + v]; dc[k] = DEC[(size_t)(h * NCH + n0 + k) * 64 + d]; }
#pragma unroll
      for (int k = 0; k < 16; ++k) { SPV[((size_t)(h * NCH + n0 + k) * 64 + d) * 128 + v] = s; s = s * dc[k] + kv[k]; } }
  }
}
__device__ __forceinline__ void gla_out_item(const Params& p, int j, int h, int n, char* smem) {
  constexpr int QP = 68;
  const float* H32 = (const float*)(p.ws + OFF_H32); const float* SP = (const float*)(p.ws + OFF_SPV) + (size_t)(h * NCH + n) * 64 * 128; bf16_t* CAT = (bf16_t*)(p.ws + OFF_CAT);
  float* CUM = (float*)smem; float* QE = CUM + 4096; float* KE = QE + 64 * QP; float* QEt = KE + 64 * QP; float* ATt = QEt + 64 * QP; float* VS = ATt + 64 * QP;
  float* SPs = QE;
  const int tid = tid_();
  f32x4 vpre[4];
#pragma unroll
  for (int i = 0; i < 4; ++i) { const int e = tid + 512 * i, t = e >> 5, c4 = (e & 31) * 4; vpre[i] = *(const f32x4*)(H32 + (size_t)(n * 64 + t) * EV_LD + EV_GV + h * 128 + c4); }
  gla_logcum(p, j, h, n, CUM, H32, VS);
  for (int e = tid; e < 4096; e += 512) { const int t = e >> 6, d = e & 63; const float* hr = H32 + (size_t)(n * 64 + t) * EV_LD; const float c = CUM[e];
    const float qe = hr[EV_GQ + h * 64 + d] * 0.125f * __expf(c); QE[t * QP + d] = qe; QEt[d * QP + t] = qe; KE[t * QP + d] = hr[EV_GK + h * 64 + d] * __expf(-c); }
#pragma unroll
  for (int i = 0; i < 4; ++i) { const int e = tid + 512 * i, t = e >> 5, c4 = (e & 31) * 4; *(f32x4*)(VS + t * 128 + c4) = vpre[i]; }
  __syncthreads();
  const int cg_ = tid >> 5, lg = tid & 31;
  { float a[4][2] = {{0.f, 0.f}, {0.f, 0.f}, {0.f, 0.f}, {0.f, 0.f}};
#pragma unroll 2
    for (int d4 = 0; d4 < 16; ++d4) { f32x4 k0 = *(const f32x4*)(KE + lg * QP + d4 * 4), k1 = *(const f32x4*)(KE + (lg + 32) * QP + d4 * 4);
#pragma unroll
      for (int i = 0; i < 4; ++i) { const f32x4 q = *(const f32x4*)(QE + (cg_ * 4 + i) * QP + d4 * 4); a[i][0] += q[0] * k0[0] + q[1] * k0[1] + q[2] * k0[2] + q[3] * k0[3]; a[i][1] += q[0] * k1[0] + q[1] * k1[1] + q[2] * k1[2] + q[3] * k1[3]; } }
#pragma unroll
    for (int i = 0; i < 4; ++i) { const int c = cg_ * 4 + i; ATt[lg * QP + c] = (c >= lg) ? a[i][0] : 0.f; ATt[(lg + 32) * QP + c] = (c >= lg + 32) ? a[i][1] : 0.f; } }
  __syncthreads();
  for (int e = tid; e < 64 * 32; e += 512) *(f32x4*)(SPs + e * 4) = *(const f32x4*)(SP + e * 4);
  __syncthreads();
  f32x4 acc[4] = {f4zero(), f4zero(), f4zero(), f4zero()};
#pragma unroll 4
  for (int s = 0; s < 64; ++s) { const f32x4 a4 = *(const f32x4*)(ATt + s * QP + cg_ * 4), v4 = *(const f32x4*)(VS + s * 128 + lg * 4);
#pragma unroll
    for (int i = 0; i < 4; ++i) acc[i] += a4[i] * v4; }
#pragma unroll 4
  for (int d = 0; d < 64; ++d) { const f32x4 q4 = *(const f32x4*)(QEt + d * QP + cg_ * 4), s4 = *(const f32x4*)(SPs + d * 128 + lg * 4);
#pragma unroll
    for (int i = 0; i < 4; ++i) acc[i] += q4[i] * s4; }
  const f32x4 ng = *(const f32x4*)(p.gla_norm_g + (size_t)j * 128 + lg * 4);
#pragma unroll
  for (int i = 0; i < 4; ++i) {
    float ss = acc[i][0] * acc[i][0] + acc[i][1] * acc[i][1] + acc[i][2] * acc[i][2] + acc[i][3] * acc[i][3];
    ss += __shfl_xor(ss, 1); ss += __shfl_xor(ss, 2); ss += __shfl_xor(ss, 4); ss += __shfl_xor(ss, 8); ss += __shfl_xor(ss, 16);
    const float r = rsqrtf(ss * (1.f / 128.f) + 1e-6f); const int t = n * 64 + cg_ * 4 + i;
    const f32x4 gr = *(const f32x4*)(H32 + (size_t)t * EV_LD + EV_GR + h * 128 + lg * 4);
    const f32x4 o = acc[i] * r * ng;
    *(u32x2*)(CAT + (size_t)t * EVEN_OUT + h * 128 + lg * 4) = (u32x2){pack2(o[0] * siluf_(gr[0]), o[1] * siluf_(gr[1])), pack2(o[2] * siluf_(gr[2]), o[3] * siluf_(gr[3]))};
  }
  __syncthreads();
}

__device__ __forceinline__ void moba_kmean_item(const Params& p, int h, int blk, char* smem) {
  const bf16_t* MK = (const bf16_t*)(p.ws + OFF_MK); float* KM = (float*)(p.ws + OFF_KMEAN); float* PART = (float*)smem;
  const int tid = tid_(), d = tid & 127, part = tid >> 7; float s = 0.f;
#pragma unroll 16
  for (int k = 0; k < 64; ++k) s += bf2f(MK[(size_t)(blk * 256 + part * 64 + k) * MQ_LD + h * 128 + d]);
  PART[tid] = s; __syncthreads();
  if (tid < 128) KM[(size_t)(h * NBLK + blk) * 128 + tid] = (PART[tid] + PART[128 + tid] + PART[256 + tid] + PART[384 + tid]) * (1.f / 256.f);
  __syncthreads();
}
struct Top3 { float v0, v1, v2; int i0, i1, i2; };
__device__ __forceinline__ bool top_better(float v, int i, float w, int j) { return v > w || (v == w && i < j); }
__device__ __forceinline__ Top3 top_ins(Top3 t, float v, int i) {
  const bool b0 = top_better(v, i, t.v0, t.i0), b1 = top_better(v, i, t.v1, t.i1), b2 = top_better(v, i, t.v2, t.i2);
  Top3 r;
  r.v2 = b1 ? t.v1 : (b2 ? v : t.v2); r.i2 = b1 ? t.i1 : (b2 ? i : t.i2);
  r.v1 = b0 ? t.v0 : (b1 ? v : t.v1); r.i1 = b0 ? t.i0 : (b1 ? i : t.i1);
  r.v0 = b0 ? v : t.v0; r.i0 = b0 ? i : t.i0;
  return r;
}
template <bool GATH> __device__ __forceinline__ void moba_tile(const Params& p, int h, int arg0, int arg1, int arg2, char* smem) {
  constexpr int PB = 272;
  constexpr float NEG = -1e30f;
  const bf16_t* MQ = (const bf16_t*)(p.ws + OFF_MQ); const bf16_t* MK = (const bf16_t*)(p.ws + OFF_MK); const bf16_t* MVT = (const bf16_t*)(p.ws + OFF_MVT);
  const float* KM = (const float*)(p.ws + OFF_KMEAN); unsigned* MCNT = (unsigned*)(p.ws + OFF_MCNT); unsigned* MLIST = (unsigned*)(p.ws + OFF_MLIST);
  bf16_t* PO = (bf16_t*)(p.ws + OFF_PO); f32x2* PML = (f32x2*)(p.ws + OFF_PML);
  char* Qs = smem; char* Ks = Qs + 64 * PB; char* VTs = Ks + 128 * PB; int* ROWT = (int*)(VTs + 128 * PB); int* ROWS = ROWT + 64;
  float* MRG = (float*)Ks;
  const int tid = tid_(), w = tid >> 6, lane = tid & 63, fr = lane & 15, fq = lane >> 4, wq = w & 3, wh = w >> 2;
  const int t0 = GATH ? 0 : arg0 * 64, own = t0 >> 8;
  const float slope = exp2f(-8.f * (float)(h + 1) / (float)MOBA_H), scale = 0.08838834764831845f;
  const int kbase = GATH ? arg0 * 256 : own * 256;
  unsigned ent = 0u; const bool rv = GATH ? (arg1 + tid < arg2) : true;
  if (GATH && tid < 64) ent = MLIST[(size_t)(h * NBLK + arg0) * SEQ + (rv ? arg1 + tid : arg1)];
  u32x4 kreg[4], vreg[4];
  { const int key0 = kbase;
#pragma unroll
    for (int i = 0; i < 4; ++i) { const int e = tid + 512 * i, r = e >> 4, c = e & 15;
      kreg[i] = *(const u32x4*)(MK + (size_t)(key0 + r) * MQ_LD + h * 128 + c * 8); vreg[i] = *(const u32x4*)(MVT + (size_t)(h * 128 + r) * SEQ + key0 + c * 8); } }
  if (tid < 64) {
    if (GATH) { ROWT[tid] = (int)(ent >> 2); ROWS[tid] = rv ? (int)(ent & 3u) : -1; }
    else { ROWT[tid] = t0 + tid; ROWS[tid] = 3; } }
  lds_barrier();
  for (int e = tid; e < 64 * 16; e += 512) { const int r = e >> 4, c = e & 15; *(u32x4*)(Qs + r * PB + c * 16) = *(const u32x4*)(MQ + (size_t)ROWT[r] * MQ_LD + h * 128 + c * 8); }
  lds_barrier();
  if (!GATH) {
    float* KMs = (float*)Ks;
    for (int e = tid; e < own * 32; e += 512) *(f32x4*)(KMs + e * 4) = *(const f32x4*)(KM + (size_t)h * NBLK * 128 + e * 4);
    __syncthreads();
    const int q = tid >> 3, part = tid & 7; Top3 tp; tp.v0 = tp.v1 = tp.v2 = -INFINITY; tp.i0 = tp.i1 = tp.i2 = 1 << 20;
    for (int nb_ = part; nb_ < own; nb_ += 8) { const float* km = KMs + nb_ * 128; float s = 0.f;
#pragma unroll 2
      for (int c = 0; c < 16; ++c) { const u32x4 qq = *(const u32x4*)(Qs + q * PB + c * 16); const f32x4 ka = *(const f32x4*)(km + c * 8), kb = *(const f32x4*)(km + c * 8 + 4);
        s += __uint_as_float(qq[0] << 16) * ka[0] + __uint_as_float(qq[0] & 0xffff0000u) * ka[1] + __uint_as_float(qq[1] << 16) * ka[2] + __uint_as_float(qq[1] & 0xffff0000u) * ka[3]
           + __uint_as_float(qq[2] << 16) * kb[0] + __uint_as_float(qq[2] & 0xffff0000u) * kb[1] + __uint_as_float(qq[3] << 16) * kb[2] + __uint_as_float(qq[3] & 0xffff0000u) * kb[3]; }
      tp = top_ins(tp, s, nb_); }
#pragma unroll
    for (int m = 1; m < 8; m <<= 1) { const float a0 = __shfl_xor(tp.v0, m), a1 = __shfl_xor(tp.v1, m), a2 = __shfl_xor(tp.v2, m); const int b0 = __shfl_xor(tp.i0, m), b1 = __shfl_xor(tp.i1, m), b2 = __shfl_xor(tp.i2, m);
      tp = top_ins(tp, a0, b0); tp = top_ins(tp, a1, b1); tp = top_ins(tp, a2, b2); }
    unsigned* CL = (unsigned*)(ROWS + 64); unsigned* BASE = CL + 32;
    if (tid < 32) CL[tid] = 0u;
    __syncthreads();
    unsigned l0 = 0, l1 = 0, l2 = 0;
    if (part == 0) { if (tp.i0 < 32) l0 = atomicAdd(CL + tp.i0, 1u); if (tp.i1 < 32) l1 = atomicAdd(CL + tp.i1, 1u); if (tp.i2 < 32) l2 = atomicAdd(CL + tp.i2, 1u); }
    __syncthreads();
    if (tid < own && CL[tid] > 0u) BASE[tid] = atomicAdd(MCNT + h * NBLK + tid, CL[tid]);
    __syncthreads();
    if (part == 0) { const unsigned tt = (unsigned)(t0 + q);
      if (tp.i0 < 32) MLIST[(size_t)(h * NBLK + tp.i0) * SEQ + BASE[tp.i0] + l0] = (tt << 2) | 0u;
      if (tp.i1 < 32) MLIST[(size_t)(h * NBLK + tp.i1) * SEQ + BASE[tp.i1] + l1] = (tt << 2) | 1u;
      if (tp.i2 < 32) MLIST[(size_t)(h * NBLK + tp.i2) * SEQ + BASE[tp.i2] + l2] = (tt << 2) | 2u; }
  }
  bf16x8 qf[4];
#pragma unroll
  for (int kk = 0; kk < 4; ++kk) qf[kk] = *(const bf16x8*)(Qs + (wq * 16 + fr) * PB + kk * 64 + fq * 16);
  f32x4 oacc[8];
#pragma unroll
  for (int i = 0; i < 8; ++i) oacc[i] = f4zero();
  float mrow = NEG, lrow = 0.f;
  const int tq = ROWT[wq * 16 + fr], slot = ROWS[wq * 16 + fr];
  const int ntile = GATH ? 2 : ((own * 256 + 128 <= t0 + 63) ? 2 : 1);
#pragma unroll 1
  for (int ti = 0; ti < ntile; ++ti) {
    {
      const int key0 = kbase + ti * 128;
      lds_barrier();
#pragma unroll
      for (int i = 0; i < 4; ++i) { const int e = tid + 512 * i, r = e >> 4, c = e & 15; *(u32x4*)(Ks + r * PB + c * 16) = kreg[i]; *(u32x4*)(VTs + r * PB + c * 16) = vreg[i]; }
      if (ti + 1 < ntile) { const int key1 = key0 + 128;
#pragma unroll
        for (int i = 0; i < 4; ++i) { const int e = tid + 512 * i, r = e >> 4, c = e & 15;
          kreg[i] = *(const u32x4*)(MK + (size_t)(key1 + r) * MQ_LD + h * 128 + c * 8); vreg[i] = *(const u32x4*)(MVT + (size_t)(h * 128 + r) * SEQ + key1 + c * 8); } }
      lds_barrier();
      const int kb = wh * 64;
      f32x4 sacc[4];
#pragma unroll
      for (int nt = 0; nt < 4; ++nt) { sacc[nt] = f4zero();
#pragma unroll
        for (int kk = 0; kk < 4; ++kk) { const bf16x8 kf = *(const bf16x8*)(Ks + (kb + nt * 16 + fr) * PB + kk * 64 + fq * 16); sacc[nt] = __builtin_amdgcn_mfma_f32_16x16x32_bf16(kf, qf[kk], sacc[nt], 0, 0, 0); } }
      float mx = NEG;
#pragma unroll
      for (int nt = 0; nt < 4; ++nt)
#pragma unroll
        for (int jj = 0; jj < 4; ++jj) { const int tk = key0 + kb + nt * 16 + fq * 4 + jj; float s = sacc[nt][jj] * scale - slope * (float)(tq - tk);
          const bool ok = GATH ? true : (tk <= tq); s = ok ? s : NEG; sacc[nt][jj] = s; mx = fmaxf(mx, s); }
      mx = fmaxf(mx, __shfl_xor(mx, 16)); mx = fmaxf(mx, __shfl_xor(mx, 32));
      const float mnew = fmaxf(mrow, mx), alpha = __expf(mrow - mnew); mrow = mnew;
      float ps = 0.f;
#pragma unroll
      for (int nt = 0; nt < 4; ++nt)
#pragma unroll
        for (int jj = 0; jj < 4; ++jj) { const float pv = __expf(sacc[nt][jj] - mnew); sacc[nt][jj] = pv; ps += pv; }
      lrow = lrow * alpha + ps;
#pragma unroll
      for (int i = 0; i < 8; ++i) oacc[i] *= alpha;
#pragma unroll
      for (int k2 = 0; k2 < 2; ++k2) {
        u32x4 pk; pk[0] = pack2(sacc[2 * k2][0], sacc[2 * k2][1]); pk[1] = pack2(sacc[2 * k2][2], sacc[2 * k2][3]); pk[2] = pack2(sacc[2 * k2 + 1][0], sacc[2 * k2 + 1][1]); pk[3] = pack2(sacc[2 * k2 + 1][2], sacc[2 * k2 + 1][3]);
        bf16x8 pb; __builtin_memcpy(&pb, &pk, 16);
#pragma unroll
        for (int dt = 0; dt < 8; ++dt) {
          const char* vr = VTs + (dt * 16 + fr) * PB + (kb + 32 * k2 + fq * 4) * 2;
          const u32x2 lo = *(const u32x2*)vr, hi = *(const u32x2*)(vr + 32);
          u32x4 vv; vv[0] = lo[0]; vv[1] = lo[1]; vv[2] = hi[0]; vv[3] = hi[1]; bf16x8 vf; __builtin_memcpy(&vf, &vv, 16);
          oacc[dt] = __builtin_amdgcn_mfma_f32_16x16x32_bf16(vf, pb, oacc[dt], 0, 0, 0);
        }
      }
    }
  }
  lrow += __shfl_xor(lrow, 16); lrow += __shfl_xor(lrow, 32);
  __syncthreads();
  if (wh == 1) { float* mg = MRG + (size_t)wq * 34 * 64;
#pragma unroll
    for (int dt = 0; dt < 8; ++dt)
#pragma unroll
      for (int jj = 0; jj < 4; ++jj) mg[(dt * 4 + jj) * 64 + lane] = oacc[dt][jj];
    mg[32 * 64 + lane] = mrow; mg[33 * 64 + lane] = lrow; }
  __syncthreads();
  if (wh == 0 && slot >= 0) { const float* mg = MRG + (size_t)wq * 34 * 64; const float m2 = mg[32 * 64 + lane], l2 = mg[33 * 64 + lane];
    const float ms = fmaxf(mrow, m2), f1 = __expf(mrow - ms), f2 = __expf(m2 - ms); const float lt = lrow * f1 + l2 * f2, inv = 1.f / lt;
    const size_t pi = ((size_t)h * SEQ + tq) * 4 + slot;
#pragma unroll
    for (int dt = 0; dt < 8; ++dt) { f32x4 o;
#pragma unroll
      for (int jj = 0; jj < 4; ++jj) o[jj] = (oacc[dt][jj] * f1 + mg[(dt * 4 + jj) * 64 + lane] * f2) * inv;
      *(u32x2*)(PO + pi * 128 + dt * 16 + fq * 4) = (u32x2){pack2(o[0], o[1]), pack2(o[2], o[3])}; }
    if (fq == 0) PML[pi] = (f32x2){ms, lt}; }
  __syncthreads();
}
__device__ __forceinline__ void moba_gathered(const Params& p, char* smem, int bid, int nb) {
  const unsigned* MCNT = (const unsigned*)(p.ws + OFF_MCNT);
  int* PC = (int*)(smem + 120 * 1024); int* PF = PC + 256;
  const int tid = tid_();
  if (tid < 256) PC[tid] = (tid < MOBA_H * NBLK) ? (int)((MCNT[tid] + 63u) >> 6) : 0;
  __syncthreads();
  if (tid < 256) { int sum = 0; for (int k = 0; k < tid; ++k) sum += PC[k]; PF[tid] = sum; }
  __syncthreads();
  const int total = PF[255] + PC[255];
  const int vb = ((nb & 7) == 0) ? (bid & 7) * (nb >> 3) + (bid >> 3) : bid;
  for (int g = vb; g < total; g += nb) {
    int lo = 0, hi = 256;
    while (hi - lo > 1) { const int mid = (lo + hi) >> 1; if (PF[mid] <= g) lo = mid; else hi = mid; }
    moba_tile<true>(p, lo / NBLK, lo % NBLK, (g - PF[lo]) * 64, (int)MCNT[lo], smem);
  }
}
__device__ __forceinline__ void moba_combine(const Params& p, int bid, int nb) {
  const bf16_t* PO = (const bf16_t*)(p.ws + OFF_PO); const f32x2* PML = (const f32x2*)(p.ws + OFF_PML); bf16_t* CAT = (bf16_t*)(p.ws + OFF_CAT);
  const int grp = tid_() >> 5, l = tid_() & 31;
  for (int it = bid * 16 + grp; it < SEQ * MOBA_H; it += nb * 16) {
    const int t = it / MOBA_H, h = it % MOBA_H, own = t >> 8, nv = own < 3 ? own : 3; const size_t pi = ((size_t)h * SEQ + t) * 4;
    f32x2 ml[4]; f32x4 po[4];
    auto ldp = [&](size_t q) { const u32x2 r = *(const u32x2*)(PO + q * 128 + l * 4); return (f32x4){__uint_as_float(r[0] << 16), __uint_as_float(r[0] & 0xffff0000u), __uint_as_float(r[1] << 16), __uint_as_float(r[1] & 0xffff0000u)}; };
    ml[3] = PML[pi + 3]; po[3] = ldp(pi + 3);
#pragma unroll
    for (int k = 0; k < 3; ++k) { if (k < nv) { ml[k] = PML[pi + k]; po[k] = ldp(pi + k); } else { ml[k] = (f32x2){-1e30f, 0.f}; po[k] = f4zero(); } }
    float mm = fmaxf(fmaxf(ml[0][0], ml[1][0]), fmaxf(ml[2][0], ml[3][0]));
    float wsum = 0.f; f32x4 acc = f4zero();
#pragma unroll
    for (int k = 0; k < 4; ++k) { const float wk = ml[k][1] * __expf(ml[k][0] - mm); wsum += wk; acc += po[k] * wk; }
    const float inv = 1.f / wsum;
    *(u32x2*)(CAT + (size_t)t * EVEN_OUT + GLA_H * 128 + h * 128 + l * 4) = (u32x2){pack2(acc[0] * inv, acc[1] * inv), pack2(acc[2] * inv, acc[3] * inv)};
  }
}

__device__ __forceinline__ void gdn_local_item(const Params& p, int j, int h, int n, char* smem) {
  constexpr int SP_ = 260, KP = 132;
  const float* H32 = (const float*)(p.ws + OFF_H32);
  float* SOL = (float*)smem; float* KS = SOL + 64 * SP_; float* LM = KS + 64 * KP; float* BETA = LM + 2 * 64 * 36;   float* GG = BETA + 64; float* GC = GG + 64;
  const size_t base = (size_t)(h * NCH + n);
  float* Ug = (float*)(p.ws + OFF_GU) + base * 8192; bf16_t* Wg = (bf16_t*)(p.ws + OFF_GW) + base * 8192; bf16_t* QDg = (bf16_t*)(p.ws + OFF_GQD) + base * 8192; bf16_t* KDg = (bf16_t*)(p.ws + OFF_GKD) + base * 8192;
  bf16_t* ATg = (bf16_t*)(p.ws + OFF_ATT) + base * 4096; float* EGL = (float*)(p.ws + OFF_EGL);
  const int tid = tid_(), t0 = n * 64;
  { const int cs = tid & 31, rg = tid >> 5, c4 = cs * 4; const float* cwb = p.gdn_conv_w + (size_t)j * 4 * (3 * GDN_H * 128);
#pragma unroll
    for (int part = 0; part < 3; ++part) { const int col = part * GDN_H * 128 + h * 128 + c4; f32x4 wv[4], xv[7];
#pragma unroll
      for (int jj = 0; jj < 4; ++jj) wv[jj] = *(const f32x4*)(cwb + (size_t)jj * (3 * GDN_H * 128) + col);
#pragma unroll
      for (int r = 0; r < 7; ++r) { const int t = t0 + rg * 4 - 3 + r; xv[r] = (t >= 0) ? *(const f32x4*)(H32 + (size_t)t * OD_LD + OD_QKV + col) : f4zero(); }
#pragma unroll
      for (int i = 0; i < 4; ++i) { f32x4 o = wv[0] * xv[i] + wv[1] * xv[i + 1] + wv[2] * xv[i + 2] + wv[3] * xv[i + 3];
        o[0] = siluf_(o[0]); o[1] = siluf_(o[1]); o[2] = siluf_(o[2]); o[3] = siluf_(o[3]);
        float* dst = (part == 0) ? (SOL + (rg * 4 + i) * SP_ + 128 + c4) : (part == 1) ? (KS + (rg * 4 + i) * KP + c4) : (SOL + (rg * 4 + i) * SP_ + c4);
        *(f32x4*)dst = o; } } }
  if (tid < 64) { const int t = t0 + tid; BETA[tid] = sigmoidf_(H32[(size_t)t * OD_LD + OD_BETA + h]);
    GG[tid] = -expf(p.gdn_a_log[j * GDN_H + h]) * softplusf_(H32[(size_t)t * OD_LD + OD_DEC + h] + p.gdn_dt_bias[j * GDN_H + h]); }
  __syncthreads();
  const int row = tid >> 3, seg = tid & 7;
  { float* qp = SOL + row * SP_ + 128 + seg * 16; float* kp = KS + row * KP + seg * 16; float sq = 0.f, sk = 0.f;
#pragma unroll
    for (int c = 0; c < 16; ++c) { sq += qp[c] * qp[c]; sk += kp[c] * kp[c]; }
    sq += __shfl_xor(sq, 1); sk += __shfl_xor(sk, 1); sq += __shfl_xor(sq, 2); sk += __shfl_xor(sk, 2); sq += __shfl_xor(sq, 4); sk += __shfl_xor(sk, 4);
    const float rq = rsqrtf(sq + 1e-6f) * 0.08838834764831845f, rk = rsqrtf(sk + 1e-6f);
#pragma unroll
    for (int c = 0; c < 16; ++c) { qp[c] *= rq; kp[c] *= rk; }
    char* Kb = (char*)LM; char* Qb = smem + 122880;
#pragma unroll
    for (int c = 0; c < 16; c += 8) { *(u32x4*)(Kb + row * 272 + (seg * 16 + c) * 2) = (u32x4){pack2(kp[c], kp[c + 1]), pack2(kp[c + 2], kp[c + 3]), pack2(kp[c + 4], kp[c + 5]), pack2(kp[c + 6], kp[c + 7])};
      *(u32x4*)(Qb + row * 272 + (seg * 16 + c) * 2) = (u32x4){pack2(qp[c], qp[c + 1]), pack2(qp[c + 2], qp[c + 3]), pack2(qp[c + 4], qp[c + 5]), pack2(qp[c + 6], qp[c + 7])}; } }
  if (tid == 0) { float c = 0.f;
#pragma unroll 16
    for (int t = 0; t < 64; ++t) { c += GG[t]; GC[t] = c; } }
  __syncthreads();
  {
    const char* Kb = (const char*)LM; const char* Qb = smem + 122880;
    const int w = tid >> 6, lane = tid & 63, fr = lane & 15, fq = lane >> 4, it = w >> 1, jt0 = 2 * (w & 1);
    f32x4 aL[2] = {f4zero(), f4zero()}, aA[2] = {f4zero(), f4zero()};
#pragma unroll
    for (int kk = 0; kk < 4; ++kk) {
      const bf16x8 ki = *(const bf16x8*)(Kb + (it * 16 + fr) * 272 + kk * 64 + fq * 16), qi = *(const bf16x8*)(Qb + (it * 16 + fr) * 272 + kk * 64 + fq * 16);
#pragma unroll
      for (int jj = 0; jj < 2; ++jj) { const bf16x8 kj = *(const bf16x8*)(Kb + ((jt0 + jj) * 16 + fr) * 272 + kk * 64 + fq * 16);
        aL[jj] = __builtin_amdgcn_mfma_f32_16x16x32_bf16(ki, kj, aL[jj], 0, 0, 0); aA[jj] = __builtin_amdgcn_mfma_f32_16x16x32_bf16(qi, kj, aA[jj], 0, 0, 0); } }
    __syncthreads();
#pragma unroll
    for (int jj = 0; jj < 2; ++jj)
#pragma unroll
      for (int r = 0; r < 4; ++r) { const int ii = it * 16 + fq * 4 + r, jx = (jt0 + jj) * 16 + fr; const float dec = (ii >= jx) ? __expf(GC[ii] - GC[jx]) : 0.f;
        LM[(jx & 1) * (64 * 36) + ii * 36 + (jx >> 1)] = (ii > jx) ? BETA[ii] * aL[jj][r] * dec : 0.f; ATg[ii * 64 + jx] = f2bf(aA[jj][r] * dec); } }
  { const float eg = __expf(GC[row]), ek = __expf(GC[63] - GC[row]); const float* qp = SOL + row * SP_ + 128 + seg * 16; const float* kp = KS + row * KP + seg * 16;
#pragma unroll
    for (int c = 0; c < 16; c += 4) { const f32x4 q = *(const f32x4*)(qp + c), k = *(const f32x4*)(kp + c); { const f32x4 qq = q * eg; *(u32x2*)(QDg + row * 128 + seg * 16 + c) = (u32x2){pack2(qq[0], qq[1]), pack2(qq[2], qq[3])}; }
#pragma unroll
      for (int e = 0; e < 4; ++e) KDg[(seg * 16 + c + e) * 64 + row] = f2bf(k[e] * ek); } }
  __syncthreads();
  { const float bt = BETA[row], be = bt * __expf(GC[row]); float* vp = SOL + row * SP_ + seg * 16; float* wp = SOL + row * SP_ + 128 + seg * 16; const float* kp = KS + row * KP + seg * 16;
#pragma unroll
    for (int c = 0; c < 16; ++c) { vp[c] *= bt; wp[c] = kp[c] * be; } }
  __syncthreads();
  { const int col = tid >> 1, half = tid & 1; const float* lmh = LM + half * (64 * 36);
    float x[32];
#pragma unroll
    for (int k = 0; k < 32; ++k) x[k] = 0.f;
#pragma unroll
    for (int i = 0; i < 64; ++i) {
      const float rhs = SOL[i * SP_ + col]; float part = 0.f;
#pragma unroll
      for (int k4 = 0; k4 < (i + 1) / 2; k4 += 4) { const f32x4 l4 = *(const f32x4*)(lmh + i * 36 + k4);
#pragma unroll
        for (int e = 0; e < 4; ++e) if (k4 + e < (i + 1) / 2) part += l4[e] * x[k4 + e]; }
      const float nv = rhs - (part + dpp_mov<0xB1>(part));
      x[i >> 1] = ((i & 1) == half) ? nv : x[i >> 1];
      if (i > 0) SOL[i * SP_ + col] = nv;
    } }
  __syncthreads();
#pragma unroll
  for (int c = 0; c < 16; c += 4) { const f32x4 uu = *(const f32x4*)(SOL + row * SP_ + seg * 16 + c);
#pragma unroll
    for (int e = 0; e < 4; ++e) Ug[(seg * 16 + c + e) * 64 + row] = uu[e];
    { const f32x4 ww = *(const f32x4*)(SOL + row * SP_ + 128 + seg * 16 + c); *(u32x2*)(Wg + row * 128 + seg * 16 + c) = (u32x2){pack2(ww[0], ww[1]), pack2(ww[2], ww[3])}; } }
  if (tid == 0) EGL[base] = __expf(GC[63]);
  __syncthreads();
}
struct GdnMRegs { bf16x8 a12[4], a4[2]; f32x4 x[2]; float egl; };
__device__ __forceinline__ void gdn_mload(GdnMRegs& r, const char* ws, int h, int n, int w, int fr, int fq, int j0) {
  const size_t base = (size_t)(h * NCH + n);
  const float* UTn = (const float*)(ws + OFF_GU) + base * 8192; const bf16_t* Wn = (const bf16_t*)(ws + OFF_GW) + base * 8192; const bf16_t* QDn = (const bf16_t*)(ws + OFF_GQD) + base * 8192;
  const bf16_t* KDTn = (const bf16_t*)(ws + OFF_GKD) + base * 8192; const bf16_t* ATn = (const bf16_t*)(ws + OFF_ATT) + base * 4096;
  const bf16_t* a12p = ((w < 4) ? Wn : QDn) + (16 * (w & 3) + fr) * 128 + fq * 8;
#pragma unroll
  for (int kk = 0; kk < 4; ++kk) r.a12[kk] = *(const bf16x8*)(a12p + kk * 32);
  const bf16_t* a4p = KDTn + (16 * w + fr) * 64 + fq * 8;
#pragma unroll
  for (int kk = 0; kk < 2; ++kk) r.a4[kk] = *(const bf16x8*)(a4p + kk * 32);
  const char* xp = (w < 4) ? (const char*)(UTn + (j0 + fr) * 64 + 16 * w + fq * 4) : (const char*)(ATn + (16 * (w - 4) + fr) * 64 + fq * 8); const int xs = (w < 4) ? 16 * 64 * 4 : 64;
#pragma unroll
  for (int i = 0; i < 2; ++i) r.x[i] = *(const f32x4*)(xp + i * xs);
  r.egl = ((const float*)(ws + OFF_EGL))[base];
}
constexpr int GS_SP = 272, GS_VP = 144;
__device__ __forceinline__ void gdn_mstep(const GdnMRegs& cur, f32x4 (&sacc)[2], char* ST, char* VT, float* O32, int n, int h, int j0, int w, int fr, int fq) {
  f32x4 acc[2] = {f4zero(), f4zero()};
#pragma unroll
  for (int kk = 0; kk < 4; ++kk) { const bf16x8 af = cur.a12[kk];
#pragma unroll
    for (int jt = 0; jt < 2; ++jt) { const bf16x8 bfr = *(const bf16x8*)(ST + (jt * 16 + fr) * GS_SP + (kk * 32 + fq * 8) * 2); acc[jt] = __builtin_amdgcn_mfma_f32_16x16x32_bf16(af, bfr, acc[jt], 0, 0, 0); } }
  if (w < 4) {
#pragma unroll
    for (int jt = 0; jt < 2; ++jt) { const f32x4 vn = cur.x[jt] - acc[jt]; *(u32x2*)(VT + (jt * 16 + fr) * GS_VP + (16 * w + fq * 4) * 2) = (u32x2){pack2(vn[0], vn[1]), pack2(vn[2], vn[3])}; } }
  lds_barrier();
  bf16x8 vf[2][2];
#pragma unroll
  for (int kk = 0; kk < 2; ++kk)
#pragma unroll
    for (int jt = 0; jt < 2; ++jt) vf[kk][jt] = *(const bf16x8*)(VT + (jt * 16 + fr) * GS_VP + (kk * 32 + fq * 8) * 2);
  if (w >= 4) {
#pragma unroll
    for (int kk = 0; kk < 2; ++kk) { bf16x8 af; __builtin_memcpy(&af, &cur.x[kk], 16);
#pragma unroll
      for (int jt = 0; jt < 2; ++jt) acc[jt] = __builtin_amdgcn_mfma_f32_16x16x32_bf16(af, vf[kk][jt], acc[jt], 0, 0, 0); }
#pragma unroll
    for (int jt = 0; jt < 2; ++jt)
#pragma unroll
      for (int r = 0; r < 4; ++r) O32[(size_t)(n * 64 + 16 * (w - 4) + fq * 4 + r) * (GDN_H * 128) + h * 128 + j0 + jt * 16 + fr] = acc[jt][r];
  }
#pragma unroll
  for (int jt = 0; jt < 2; ++jt) sacc[jt] *= cur.egl;
#pragma unroll
  for (int kk = 0; kk < 2; ++kk) { const bf16x8 af = cur.a4[kk];
#pragma unroll
    for (int jt = 0; jt < 2; ++jt) sacc[jt] = __builtin_amdgcn_mfma_f32_16x16x32_bf16(af, vf[kk][jt], sacc[jt], 0, 0, 0); }
#pragma unroll
  for (int jt = 0; jt < 2; ++jt) *(u32x2*)(ST + (jt * 16 + fr) * GS_SP + (16 * w + fq * 4) * 2) = (u32x2){pack2(sacc[jt][0], sacc[jt][1]), pack2(sacc[jt][2], sacc[jt][3])};
  lds_barrier();
}
__device__ __forceinline__ void gdn_scan_item(const Params& p, int h, int sl, char* smem) {
  char* ST = smem; char* VT = ST + 32 * GS_SP;
  float* O32 = (float*)(p.ws + OFF_O32);
  const int tid = tid_(), w = tid >> 6, lane = tid & 63, fr = lane & 15, fq = lane >> 4, j0 = sl * 32;
  { float z = 0.f; LAUNDER_V(z); for (int e = tid; e < 32 * GS_SP / 4; e += 512) ((float*)ST)[e] = z; }
  f32x4 sacc[2] = {f4zero(), f4zero()};
  GdnMRegs a0, a1, b0, b1;
  gdn_mload(a0, p.ws, h, 0, w, fr, fq, j0); gdn_mload(a1, p.ws, h, 1, w, fr, fq, j0);
  lds_barrier();
#pragma unroll 1
  for (int n = 0; n < NCH; n += 4) {
    DRAIN_VM();
    gdn_mload(b0, p.ws, h, n + 2, w, fr, fq, j0); gdn_mload(b1, p.ws, h, n + 3, w, fr, fq, j0);
    gdn_mstep(a0, sacc, ST, VT, O32, n, h, j0, w, fr, fq);
    gdn_mstep(a1, sacc, ST, VT, O32, n + 1, h, j0, w, fr, fq);
    DRAIN_VM();
    { const int m0 = (n + 4 < NCH) ? n + 4 : n, m1 = (n + 5 < NCH) ? n + 5 : n + 1;
      gdn_mload(a0, p.ws, h, m0, w, fr, fq, j0); gdn_mload(a1, p.ws, h, m1, w, fr, fq, j0); }
    gdn_mstep(b0, sacc, ST, VT, O32, n + 2, h, j0, w, fr, fq);
    gdn_mstep(b1, sacc, ST, VT, O32, n + 3, h, j0, w, fr, fq);
  }
}
__device__ __forceinline__ void gdn_final(const Params& p, int j, int bid, int nb) {
  const float* H32 = (const float*)(p.ws + OFF_H32); const float* O32 = (const float*)(p.ws + OFF_O32); bf16_t* CAT = (bf16_t*)(p.ws + OFF_CAT);
  const int grp = tid_() >> 5, l = tid_() & 31;
  const f32x4 ng = *(const f32x4*)(p.gdn_norm_g + (size_t)j * 128 + l * 4);
  for (int it = bid * 16 + grp; it < SEQ * GDN_H; it += nb * 16) {
    const int t = it / GDN_H, h = it % GDN_H;
    const f32x4 o = *(const f32x4*)(O32 + (size_t)t * (GDN_H * 128) + h * 128 + l * 4), z = *(const f32x4*)(H32 + (size_t)t * OD_LD + OD_Z + h * 128 + l * 4);
    float ss = o[0] * o[0] + o[1] * o[1] + o[2] * o[2] + o[3] * o[3];
    ss += __shfl_xor(ss, 1); ss += __shfl_xor(ss, 2); ss += __shfl_xor(ss, 4); ss += __shfl_xor(ss, 8); ss += __shfl_xor(ss, 16);
    const float r = rsqrtf(ss * (1.f / 128.f) + 1e-6f); const f32x4 v = o * r * ng;
    *(u32x2*)(CAT + (size_t)t * ODD_OUT + h * 128 + l * 4) = (u32x2){pack2(v[0] * siluf_(z[0]), v[1] * siluf_(z[1])), pack2(v[2] * siluf_(z[2]), v[3] * siluf_(z[3]))};
  }
}

template <bool OUT> __device__ __forceinline__ void s5_item(const Params& p, int j, int g, int oct, char* smem) {
  constexpr int XP = 68;
  const float* H32 = (const float*)(p.ws + OFF_H32); const float* C = (const float*)(p.ws + OFF_S5C + j * SZ_S5C1); f32x2* XEND = (f32x2*)(p.ws + OFF_XEND); bf16_t* YS = (bf16_t*)(p.ws + OFF_YS);
  float* XR = (float*)smem; float* XI = XR + 8 * 16 * XP; float* US = XI + 8 * 16 * XP;
  const int tid = tid_(), w = tid >> 6, lane = tid & 63, n = oct * 8 + w, gp = g * S5_P + lane, fr = lane & 15, fq = lane >> 4;
  { const float* up = H32 + (size_t)(n * 64 + lane) * OD_LD + OD_U + g * 16; float* ud = US + (w * 64 + lane) * 16;
#pragma unroll
    for (int c = 0; c < 16; c += 4) *(f32x4*)(ud + c) = *(const f32x4*)(up + c); }
  bf16x8 cf[4];
  if (OUT) {
#pragma unroll
    for (int kk = 0; kk < 4; ++kk) { const float* cp = ((kk < 2) ? p.s5_c_re : p.s5_c_im) + (((size_t)j * S5_G + g) * 16 + fr) * 64 + (kk & 1) * 32 + fq * 8;
      const f32x4 c0 = *(const f32x4*)cp, c1 = *(const f32x4*)(cp + 4); const float sg = (kk < 2) ? 1.f : -1.f;
      u32x4 pk; pk[0] = pack2(sg * c0[0], sg * c0[1]); pk[1] = pack2(sg * c0[2], sg * c0[3]); pk[2] = pack2(sg * c1[0], sg * c1[1]); pk[3] = pack2(sg * c1[2], sg * c1[3]); __builtin_memcpy(&cf[kk], &pk, 16); } }
  const float ar = C[gp], ai = C[S5_G * S5_P + gp];
  float bbr[16], bbi[16];
#pragma unroll
  for (int c = 0; c < 16; c += 4) { const f32x4 a = *(const f32x4*)(C + 4 * S5_G * S5_P + (size_t)gp * 16 + c), b = *(const f32x4*)(C + 20 * S5_G * S5_P + (size_t)gp * 16 + c);
    bbr[c] = a[0]; bbr[c + 1] = a[1]; bbr[c + 2] = a[2]; bbr[c + 3] = a[3]; bbi[c] = b[0]; bbi[c + 1] = b[1]; bbi[c + 2] = b[2]; bbi[c + 3] = b[3]; }
  float xr = 0.f, xi = 0.f;
  if (OUT) { const float a64r = C[2 * S5_G * S5_P + gp], a64i = C[3 * S5_G * S5_P + gp];
#pragma unroll 1
    for (int m0 = 0; m0 < n; m0 += 16) { f32x2 xe[16];
#pragma unroll
      for (int k = 0; k < 16; ++k) xe[k] = XEND[(size_t)(((m0 + k < n) ? m0 + k : 0) * S5_G + g) * S5_P + lane];
#pragma unroll
      for (int k = 0; k < 16; ++k) if (m0 + k < n) { const float nr = a64r * xr - a64i * xi + xe[k][0], ni = a64r * xi + a64i * xr + xe[k][1]; xr = nr; xi = ni; } } }
  __syncthreads();
#pragma unroll 1
  for (int slab = 0; slab < 4; ++slab) {
#pragma unroll 2
    for (int tt = 0; tt < 16; ++tt) {
      const float* up = US + (w * 64 + slab * 16 + tt) * 16; float br = 0.f, bi = 0.f;
#pragma unroll
      for (int c = 0; c < 16; c += 4) { const f32x4 u4 = *(const f32x4*)(up + c);
#pragma unroll
        for (int e = 0; e < 4; ++e) { br += bbr[c + e] * u4[e]; bi += bbi[c + e] * u4[e]; } }
      const float nr = ar * xr - ai * xi + br, ni = ar * xi + ai * xr + bi; xr = nr; xi = ni;
      if (OUT) { XR[(w * 16 + tt) * XP + lane] = xr; XI[(w * 16 + tt) * XP + lane] = xi; }
    }
    if (OUT) {
      __syncthreads();
      f32x4 y = f4zero();
#pragma unroll
      for (int kk = 0; kk < 4; ++kk) { const float* xp = ((kk < 2) ? XR : XI) + (w * 16 + fr) * XP + (kk & 1) * 32 + fq * 8;
        const f32x4 x0 = *(const f32x4*)xp, x1 = *(const f32x4*)(xp + 4);
        u32x4 pk; pk[0] = pack2(x0[0], x0[1]); pk[1] = pack2(x0[2], x0[3]); pk[2] = pack2(x1[0], x1[1]); pk[3] = pack2(x1[2], x1[3]); bf16x8 xf; __builtin_memcpy(&xf, &pk, 16);
        y = __builtin_amdgcn_mfma_f32_16x16x32_bf16(cf[kk], xf, y, 0, 0, 0); }
      const int t = n * 64 + slab * 16 + fr;
      const f32x4 u4 = *(const f32x4*)(US + (w * 64 + slab * 16 + fr) * 16 + fq * 4), d4 = *(const f32x4*)(p.s5_d + ((size_t)j * S5_G + g) * 16 + fq * 4);
      y += d4 * u4;
      *(u32x2*)(YS + (size_t)t * S5_CH + g * 16 + fq * 4) = (u32x2){pack2(geluf_(y[0]), geluf_(y[1])), pack2(geluf_(y[2]), geluf_(y[3]))};
      __syncthreads();
    }
  }
  if (!OUT) XEND[(size_t)(n * S5_G + g) * S5_P + lane] = (f32x2){xr, xi};
}

__device__ __forceinline__ void s5_carry(const Params& p, int j, int bid, int nb) {
  const float* C = (const float*)(p.ws + OFF_S5C + j * SZ_S5C1); const f32x2* __restrict__ XEND = (const f32x2*)(p.ws + OFF_XEND); f32x2* __restrict__ CARRY = (f32x2*)(p.ws + OFF_CARRY);
  for (int e = bid * 512 + tid_(); e < S5_G * S5_P; e += nb * 512) {
    const float a64r = C[2 * S5_G * S5_P + e], a64i = C[3 * S5_G * S5_P + e]; float xr = 0.f, xi = 0.f;
#pragma unroll 1
    for (int n0 = 0; n0 < NCH; n0 += 16) { f32x2 xe[16];
#pragma unroll
      for (int k = 0; k < 16; ++k) xe[k] = XEND[(size_t)(n0 + k) * S5_G * S5_P + e];
#pragma unroll
      for (int k = 0; k < 16; ++k) { CARRY[(size_t)(n0 + k) * S5_G * S5_P + e] = (f32x2){xr, xi}; const float nr = a64r * xr - a64i * xi + xe[k][0], ni = a64r * xi + a64i * xr + xe[k][1]; xr = nr; xi = ni; } }
  }
}

__device__ __forceinline__ void glr_pass(const bf16_t* XB, const bf16_t* Wg, float* H32, int bid, int nb) {
  const int w = tid_() >> 6, lane = tid_() & 63, fr = lane & 15, fq = lane >> 4;
  for (int tile = bid * 8 + w; tile < SEQ / 16; tile += nb * 8) {
    const bf16_t* ap = XB + (size_t)(tile * 16 + fr) * DM + fq * 8; const bf16_t* bp = Wg + (size_t)fr * DM + fq * 8;
    f32x4 acc = f4zero();
#pragma unroll 8
    for (int kk = 0; kk < DM / 32; ++kk) { const bf16x8 a = *(const bf16x8*)(ap + kk * 32), b = *(const bf16x8*)(bp + kk * 32); acc = __builtin_amdgcn_mfma_f32_16x16x32_bf16(a, b, acc, 0, 0, 0); }
#pragma unroll
    for (int jj = 0; jj < 4; ++jj) H32[(size_t)(tile * 16 + fq * 4 + jj) * EV_LD + EV_GLR + fr] = acc[jj];
  }
}

#ifndef EMU
__device__ __forceinline__ void subgrid_barrier(unsigned* cnt, unsigned count, unsigned* tmo) {
  asm volatile("s_waitcnt vmcnt(0)" ::: "memory");
  __syncthreads();
  if (threadIdx.x == 0) {
    __builtin_amdgcn_fence(__ATOMIC_RELEASE, "agent");
    asm volatile("s_waitcnt vmcnt(0)" ::: "memory");
    __hip_atomic_fetch_add(cnt, 1u, __ATOMIC_RELAXED, __HIP_MEMORY_SCOPE_AGENT);
    unsigned sp = 0;
    while (__hip_atomic_load(cnt, __ATOMIC_RELAXED, __HIP_MEMORY_SCOPE_AGENT) < count) { __builtin_amdgcn_s_sleep(1);
      if ((++sp & 255u) == 0u) { if (__hip_atomic_load(tmo, __ATOMIC_RELAXED, __HIP_MEMORY_SCOPE_AGENT)) break; if (sp > (1u << 18)) { atomicAdd(tmo, 1u); break; } } }
    __builtin_amdgcn_fence(__ATOMIC_ACQUIRE, "agent");
    asm volatile("s_waitcnt vmcnt(0)" ::: "memory");
  }
  __syncthreads();
}
#else
__device__ __forceinline__ void subgrid_barrier(unsigned*, unsigned, unsigned*) {}
#endif

#ifdef EMU
#define SUBGRID_GLU()
#else
#define SUBGRID_GLU() do { subgrid_barrier((unsigned*)(ws + OFF_BAR) + 3600 + 64 * L, (unsigned)(nb - NSCAN), (unsigned*)(ws + OFF_BAR) + 128); \
    EpiGlu E{(const bf16_t*)(ws + OFF_YS), p.s5_glu_b + (size_t)j * S5_CH, CAT}; run_gemm(smem, (const bf16_t*)(ws + OFF_YS), (const bf16_t*)(ws + OFF_WGLU + j * SZ_WGLU), S5_CH, S5_CH, E, bid - NSCAN, nb - NSCAN); } while (0)
#endif
__device__ __forceinline__ bool run_step(const Params& p, int step, char* smem, int bid, int nb) {
  LAUNDER_S(bid); LAUNDER_S(nb);
  char* ws = p.ws;
  if (step == 0) { step_prep(p, smem, bid, nb); return true; }
  const int L = (step - 1) / STEPS_PER_LAYER, s = (step - 1) % STEPS_PER_LAYER, j = L >> 1; const bool even = (L & 1) == 0;
  bf16_t* XB = (bf16_t*)(ws + OFF_XB); float* X32 = (float*)(ws + OFF_X32); float* Y32 = (float*)(ws + OFF_Y32); float* H32 = (float*)(ws + OFF_H32); bf16_t* CAT = (bf16_t*)(ws + OFF_CAT);
  float* stats_mix = (float*)(ws + OFF_STATS) + (size_t)(L * 2) * SEQ * 2; float* stats_ffn = stats_mix + (size_t)SEQ * 2;
  switch (s) {
    case 0:
      if (even) { EpiEvenIn E{H32, (bf16_t*)(ws + OFF_MQ), (bf16_t*)(ws + OFF_MK), (bf16_t*)(ws + OFF_MVT)}; run_gemm(smem, XB, (const bf16_t*)(ws + OFF_WINE + j * SZ_WINE), EVEN_NMAIN, DM, E, bid, nb);
        glr_pass(XB, (const bf16_t*)(ws + OFF_WINE + j * SZ_WINE) + (size_t)EVEN_NMAIN * DM, H32, bid, nb); }
      else { EpiOddIn E{H32}; run_gemm(smem, XB, (const bf16_t*)(ws + OFF_WINO + j * SZ_WINO), ODD_NP, DM, E, bid, nb); }
      return true;
    case 1:
      if (even) {
        for (int it = bid; it < GLA_H * NCH; it += nb) gla_kv_item(p, j, it % GLA_H, it / GLA_H, smem);
        for (int it = bid; it < MOBA_H * NBLK; it += nb) moba_kmean_item(p, it % MOBA_H, it / MOBA_H, smem);
        if (bid == 0 && tid_() < MOBA_H * NBLK) ((unsigned*)(ws + OFF_MCNT))[tid_()] = 0u;
      } else {
        for (int it = bid; it < GDN_H * NCH; it += nb) gdn_local_item(p, j, it % GDN_H, it / GDN_H, smem);
        for (int it = bid; it < S5_G * (NCH / 8); it += nb) { s5_item<false>(p, j, it % S5_G, it / S5_G, smem); __syncthreads(); }
      }
      return true;
    case 2:
      if (even) {
        gla_scan(p, bid, nb);
        for (int it = nb - 1 - bid; it < MOBA_H * NCH; it += nb) moba_tile<false>(p, it % MOBA_H, NCH - 1 - it / MOBA_H, 0, 0, smem);
      } else {
        constexpr int NSCAN = GDN_H * 4;
        if (nb > 2 * NSCAN) {
          if (bid < NSCAN) gdn_scan_item(p, bid % GDN_H, bid / GDN_H, smem);
          else { for (int it = bid - NSCAN; it < S5_G * (NCH / 8); it += nb - NSCAN) { s5_item<true>(p, j, it % S5_G, it / S5_G, smem); __syncthreads(); }
            SUBGRID_GLU();
            conv_group(p, L, smem, bid - NSCAN, nb - NSCAN); }
        } else {
          for (int it = bid; it < NSCAN; it += nb) gdn_scan_item(p, it % GDN_H, it / GDN_H, smem);
          for (int it = bid; it < S5_G * (NCH / 8); it += nb) { s5_item<true>(p, j, it % S5_G, it / S5_G, smem); __syncthreads(); }
          conv_group(p, L, smem, bid, nb);
        }
      }
      return true;
    case 3:
      if (even) { for (int it = bid; it < GLA_H * NCH; it += nb) gla_out_item(p, j, it % GLA_H, it / GLA_H, smem); moba_gathered(p, smem, bid, nb); }
      else {
        gdn_final(p, j, bid, nb);
      }
      return true;
    case 4:
      if (even) { moba_combine(p, bid, nb); return true; }
      if (GLU_IN_WINDOW && nb > 2 * GDN_H * 4) return false;
      { EpiGlu E{(const bf16_t*)(ws + OFF_YS), p.s5_glu_b + (size_t)j * S5_CH, CAT}; run_gemm(smem, (const bf16_t*)(ws + OFF_YS), (const bf16_t*)(ws + OFF_WGLU + j * SZ_WGLU), S5_CH, S5_CH, E, bid, nb); }
      return true;
    case 5: {
      const float* pst = stats_mix - (size_t)SEQ * 2;
      EpiRes E{L == 0 ? p.x : nullptr, pst, p.ln_ffn_g + (size_t)(L > 0 ? L - 1 : 0) * DM, p.ln_ffn_b + (size_t)(L > 0 ? L - 1 : 0) * DM, Y32, stats_mix};
      if (even) run_gemm(smem, CAT, (const bf16_t*)(ws + OFF_WOUTE + j * SZ_WOUTE), DM, EVEN_OUT, E, bid, nb);
      else run_gemm(smem, CAT, (const bf16_t*)(ws + OFF_WOUTO + j * SZ_WOUTO), DM, ODD_OUT, E, bid, nb);
      return true; }
    case 6: step_ln(Y32, stats_mix, p.ln_mix_g + (size_t)L * DM, p.ln_mix_b + (size_t)L * DM, nullptr, XB, bid, nb); return true;
    case 7: { EpiBf16 E{(bf16_t*)(ws + OFF_H16), 2 * DFF}; run_gemm(smem, XB, (const bf16_t*)(ws + OFF_WUP + L * SZ_WUP), 2 * DFF, DM, E, bid, nb); return true; }
    case 8: step_ffn_conv((const bf16_t*)(ws + OFF_H16), p.ffn_conv_w + (size_t)L * 3 * 2 * DFF, (bf16_t*)(ws + OFF_G16), bid, nb); return true;
    case 9: { EpiRes E{nullptr, stats_mix, p.ln_mix_g + (size_t)L * DM, p.ln_mix_b + (size_t)L * DM, Y32, stats_ffn}; run_gemm(smem, (const bf16_t*)(ws + OFF_G16), (const bf16_t*)(ws + OFF_WDN + L * SZ_WDN), DM, DFF, E, bid, nb); return true; }
    case 10: step_ln(Y32, stats_ffn, p.ln_ffn_g + (size_t)L * DM, p.ln_ffn_b + (size_t)L * DM, (L == DEPTH - 1) ? p.out : nullptr, XB, bid, nb); return true;
  }
  return false;
}

#ifndef EMU
#define XB_TMO      128
#define XB_XCNT(j)  (256  + 64 * (j))
#define XB_XSUB(j)  (1280 + 64 * (j))
#define XB_XGEN(j)  (2304 + 64 * (j))
#define XB_TOP      3328
#define XB_TOPGEN   3392
#define XCD_BAR_WORDS 3456
#define XB_SPIN_CAP (1u << 18)
#define LAS __attribute__((address_space(3)))
__device__ __forceinline__ unsigned xb_ld(unsigned* p)              { return __hip_atomic_load(p, __ATOMIC_RELAXED, __HIP_MEMORY_SCOPE_AGENT); }
__device__ __forceinline__ unsigned xb_add(unsigned* p, unsigned v) { return __hip_atomic_fetch_add(p, v, __ATOMIC_RELAXED, __HIP_MEMORY_SCOPE_AGENT); }
__device__ __forceinline__ unsigned xb_xcc_id() { return (unsigned)__builtin_amdgcn_s_getreg((3 << 11) | 20) & 0xFu; }
#define XB_SPIN(cond, bar) do { unsigned _sp = 0; while (cond) { __builtin_amdgcn_s_sleep(1); \
    if ((++_sp & 255u) == 0u) { if (xb_ld(&(bar)[XB_TMO])) break; if (_sp > XB_SPIN_CAP) { atomicAdd(&(bar)[XB_TMO], 1u); break; } } } } while (0)
__device__ __forceinline__ void xcd_barrier_complete(unsigned* bar, unsigned x, unsigned& nloc, unsigned& nx) {
  const unsigned G = gridDim.x;
  unsigned sum, cnt, mine, sp = 0u;
  for (;;) {
    sum = 0u; cnt = 0u; mine = 0u;
#pragma unroll
    for (unsigned j = 0; j < 16; ++j) { const unsigned c = xb_ld(&bar[XB_XCNT(j)]); sum += c; cnt += (c > 0u) ? 1u : 0u; mine = (j == x) ? c : mine; }
    if (sum == G) break;
    __builtin_amdgcn_s_sleep(1);
    if ((++sp & 255u) == 0u) { if (xb_ld(&bar[XB_TMO])) break; if (sp > XB_SPIN_CAP) { atomicAdd(&bar[XB_TMO], 1u); break; } }
  }
  nloc = mine > 0u ? mine : 1u; nx = cnt > 0u ? cnt : 1u;
}
__device__ __forceinline__ void xcd_barrier(unsigned* bar, volatile LAS unsigned* st) {
  asm volatile("s_waitcnt vmcnt(0)" ::: "memory");
  __syncthreads();
  if (threadIdx.x == 0) {
    const unsigned x = xb_xcc_id();
    __builtin_amdgcn_s_waitcnt(0);
    unsigned nloc = st[0], nx = st[1];
    if (nloc == 0u) { xcd_barrier_complete(bar, x, nloc, nx); st[0] = nloc; st[1] = nx; }
    const unsigned old = xb_add(&bar[XB_XSUB(x)], 1u);
    const unsigned gen = old / nloc;
    if (old + 1u == (gen + 1u) * nloc) {
      __builtin_amdgcn_fence(__ATOMIC_RELEASE, "agent");
      asm volatile("s_waitcnt vmcnt(0)" ::: "memory");
      const unsigned og = xb_add(&bar[XB_TOP], 1u);
      const unsigned tg = og / nx;
      if (og + 1u == (tg + 1u) * nx) xb_add(&bar[XB_TOPGEN], 1u);
      else XB_SPIN(xb_ld(&bar[XB_TOPGEN]) == tg, bar);
      __builtin_amdgcn_fence(__ATOMIC_ACQUIRE, "agent");
      xb_add(&bar[XB_XGEN(x)], 1u);
      asm volatile("s_waitcnt vmcnt(0)" ::: "memory");
    } else {
      XB_SPIN(xb_ld(&bar[XB_XGEN(x)]) == gen, bar);
      __builtin_amdgcn_fence(__ATOMIC_ACQUIRE, "agent");
      asm volatile("s_waitcnt vmcnt(0)" ::: "memory");
    }
  }
  __syncthreads();
}

typedef __attribute__((address_space(4))) const Params* KParamsPtr;
__global__ void __launch_bounds__(512, 2) hybrid_megakernel(Params p_unused) {
  extern __shared__ __attribute__((aligned(16))) char smem[];
  __shared__ uint4 xb_words;
  cg::grid_group grid = cg::this_grid();
  const int bid = blockIdx.x, nb = gridDim.x;
  KParamsPtr q0 = (KParamsPtr)__builtin_amdgcn_kernarg_segment_ptr();
  const int sb = q0->step_begin, se = q0->step_end;
  if (threadIdx.x == 0) { xb_words = make_uint4(0u, 0u, 0u, 0u); (void)xb_add(&((unsigned*)(q0->ws + OFF_BAR))[XB_XCNT(xb_xcc_id())], 1u); }
  __syncthreads();
#ifdef PROBE_MASK
  __shared__ unsigned long long tacc_s[2];
  if (threadIdx.x == 0) tacc_s[0] = 0;
#endif
  for (int s = sb; s < se; ++s) {
    KParamsPtr q = q0; asm volatile("" : "+s"(q));
    Params lp; __builtin_memcpy(&lp, q, sizeof(Params));
#ifdef PROBE_MASK
    const unsigned long long t0 = wall_clock64();
#endif
    const bool did = run_step(lp, s, smem, bid, nb);
#ifdef PROBE_MASK
    const bool more = true;
#else
    const bool more = s + 1 < se;
#endif
    if (did && more) {
      if (s == sb) grid.sync();
      else xcd_barrier((unsigned*)(q0->ws + OFF_BAR), (volatile LAS unsigned*)&xb_words);
    }
#ifdef PROBE_MASK
    { const unsigned long long t1 = wall_clock64(); const int bit = (s == 0) ? 22 : (((s - 1) / STEPS_PER_LAYER) & 1) * 11 + (s - 1) % STEPS_PER_LAYER;
      if (((PROBE_MASK >> bit) & 1u) && threadIdx.x == 0) tacc_s[0] += t1 - t0; }
#endif
  }
#ifdef PROBE_MASK
  __syncthreads();
  if (bid == 0) { const unsigned n = (unsigned)(tacc_s[0] / 20); float* out = q0->out;
    for (unsigned i = threadIdx.x; i < n; i += 512) out[((size_t)i * 271) % ((size_t)SEQ * DM)] += 0.1f; }
#endif
}

extern "C" void kernel_launch(void* const* d_in, const int* in_sizes, int n_in, void* d_out, int out_size, void* d_ws, size_t ws_size, hipStream_t stream) {
  static int grid_blocks = 0;
  if (!grid_blocks) {
    int dev = 0, cus = 0, per_cu = 0;
    hipGetDevice(&dev);
    hipDeviceGetAttribute(&cus, hipDeviceAttributeMultiprocessorCount, dev);
    hipFuncSetAttribute((const void*)hybrid_megakernel, hipFuncAttributeMaxDynamicSharedMemorySize, LDS_BYTES);
    hipOccupancyMaxActiveBlocksPerMultiprocessor(&per_cu, hybrid_megakernel, 512, LDS_BYTES);
    if (per_cu < 1) per_cu = 1;
    if (per_cu > 1) per_cu = 1;
    grid_blocks = cus * per_cu;
  }
  if (ws_size < WS_NEEDED) { fprintf(stderr, "workspace too small: %zu < %zu\n", ws_size, (size_t)WS_NEEDED); return; }
  Params p{};
  const float** pp = (const float**)&p;
  for (int i = 0; i < 29; ++i) pp[i] = (const float*)d_in[i];
  p.out = (float*)d_out; p.ws = (char*)d_ws; p.step_begin = 0; p.step_end = N_STEPS;
  hipMemsetAsync((char*)d_ws + OFF_BAR, 0, SZ_BAR, stream);
  void* args[] = {&p};
  hipError_t e = hipLaunchCooperativeKernel((const void*)hybrid_megakernel, dim3(grid_blocks), dim3(512), args, LDS_BYTES, stream);
  if (e != hipSuccess) fprintf(stderr, "cooperative launch failed: %s (grid %d)\n", hipGetErrorString(e), grid_blocks);
}
#endif
```

```cpp
#ifdef EMU
#include "emu.h"
#else
#include <hip/hip_runtime.h>
#include <hip/hip_cooperative_groups.h>
#include <cstdio>
namespace cg = cooperative_groups;
#endif

typedef unsigned short bf16_t;
typedef short bf16x8 __attribute__((ext_vector_type(8)));
typedef float f32x4 __attribute__((ext_vector_type(4)));
typedef float f32x2 __attribute__((ext_vector_type(2)));
typedef unsigned u32x4 __attribute__((ext_vector_type(4)));
typedef unsigned u32x2 __attribute__((ext_vector_type(2)));

#ifdef EMU_SMALL
constexpr int SEQ = EMU_SEQ, DM = 256, DEPTH = 2, GLA_H = 2, MOBA_H = 2, GDN_H = 2, S5_CH = 256, DFF = 512;
constexpr float ALPHA = 1.4142135623730951f;
#else
constexpr int SEQ = 8192, DM = 2048, DEPTH = 4, GLA_H = 8, MOBA_H = 8, GDN_H = 8, S5_CH = 1024, DFF = 5632;
constexpr float ALPHA = 1.681792830507429f;
#endif
constexpr int N_EVEN = (DEPTH + 1) / 2, N_ODD = DEPTH / 2;
constexpr int NCH = SEQ / 64, NBLK = SEQ / 256;
constexpr int S5_G = S5_CH / 16, S5_P = 64;
constexpr int EV_GQ = 0, EV_GK = GLA_H * 64, EV_GV = 2 * GLA_H * 64, EV_GLR = EV_GV + GLA_H * 128, EV_GR = EV_GLR + 16,
              EV_MQ = EV_GR + GLA_H * 128, EV_MK = EV_MQ + MOBA_H * 128, EV_MV = EV_MK + MOBA_H * 128, EVEN_IN = EV_MV + MOBA_H * 128;
constexpr int EV_LD = EV_MQ;
constexpr int OD_QKV = 0, OD_Z = 3 * GDN_H * 128, OD_BETA = OD_Z + GDN_H * 128, OD_DEC = OD_BETA + GDN_H, OD_U = OD_DEC + GDN_H, ODD_IN = OD_U + S5_CH;
constexpr int OD_LD = ODD_IN;
constexpr int EVEN_OUT = GLA_H * 128 + MOBA_H * 128, ODD_OUT = GDN_H * 128 + S5_CH;
constexpr int EVEN_NMAIN = EVEN_IN - 16;
static_assert(EVEN_NMAIN % 256 == 0, "even projection main part must tile by 256");
constexpr int EVEN_NP = EVEN_NMAIN + 256, ODD_NP = ((ODD_IN + 255) / 256) * 256;
constexpr int MQ_LD = MOBA_H * 128;
constexpr int STEPS_PER_LAYER = 11, N_STEPS = 1 + DEPTH * STEPS_PER_LAYER;
constexpr int LDS_BYTES = 143360;
#ifdef EMU
constexpr bool GLU_IN_WINDOW = false;
#else
constexpr bool GLU_IN_WINDOW = true;
#endif

constexpr size_t al256(size_t x) { return (x + 255) & ~(size_t)255; }
constexpr size_t cmax(size_t a, size_t b) { return a > b ? a : b; }
constexpr size_t SZ_WINE = al256((size_t)EVEN_NP * DM * 2), SZ_WOUTE = al256((size_t)DM * EVEN_OUT * 2), SZ_WINO = al256((size_t)ODD_NP * DM * 2),
                 SZ_WGLU = al256((size_t)S5_CH * S5_CH * 2), SZ_WOUTO = al256((size_t)DM * ODD_OUT * 2), SZ_WUP = al256((size_t)2 * DFF * DM * 2), SZ_WDN = al256((size_t)DM * DFF * 2);
constexpr size_t OFF_WINE = 0, OFF_WOUTE = OFF_WINE + N_EVEN * SZ_WINE, OFF_WINO = OFF_WOUTE + N_EVEN * SZ_WOUTE, OFF_WGLU = OFF_WINO + N_ODD * SZ_WINO,
                 OFF_WOUTO = OFF_WGLU + N_ODD * SZ_WGLU, OFF_WUP = OFF_WOUTO + N_ODD * SZ_WOUTO, OFF_WDN = OFF_WUP + DEPTH * SZ_WUP, OFF_ACT = OFF_WDN + DEPTH * SZ_WDN;
constexpr size_t SZ_XB = al256((size_t)SEQ * DM * 2), SZ_X32 = al256((size_t)SEQ * DM * 4), SZ_H32 = al256((size_t)SEQ * cmax(EV_LD, OD_LD) * 4),
                 SZ_CAT = al256((size_t)SEQ * cmax(EVEN_OUT, ODD_OUT) * 2), SZ_STATS = al256((size_t)DEPTH * 2 * SEQ * 2 * 4),
                 SZ_S5C1 = al256((size_t)36 * S5_G * S5_P * 4), SZ_KMEAN = al256((size_t)MOBA_H * NBLK * 128 * 4);
constexpr size_t OFF_BAR = OFF_ACT, SZ_BAR = 16384;
constexpr size_t OFF_XB = OFF_BAR + SZ_BAR, OFF_X32 = OFF_XB + SZ_XB, OFF_Y32 = OFF_X32 + SZ_X32, OFF_H32 = OFF_Y32 + SZ_X32, OFF_CAT = OFF_H32 + SZ_H32, OFF_STATS = OFF_CAT + SZ_CAT,
                 OFF_S5C = OFF_STATS + SZ_STATS, OFF_KMEAN = OFF_S5C + N_ODD * SZ_S5C1, OFF_SCR = OFF_KMEAN + SZ_KMEAN;
constexpr size_t SZ_H16 = al256((size_t)SEQ * 2 * DFF * 2), SZ_G16 = al256((size_t)SEQ * DFF * 2);
constexpr size_t OFF_H16 = OFF_SCR, OFF_G16 = OFF_H16 + SZ_H16, END_FFN = OFF_G16 + SZ_G16;
constexpr size_t SZ_MQ = al256((size_t)SEQ * MQ_LD * 2), SZ_KVS = al256((size_t)GLA_H * NCH * 64 * 128 * 4), SZ_DEC = al256((size_t)GLA_H * NCH * 64 * 4);
constexpr size_t OFF_MQ = OFF_SCR, OFF_MK = OFF_MQ + SZ_MQ, OFF_MVT = OFF_MK + SZ_MQ, OFF_KVS = OFF_MVT + SZ_MQ, OFF_DEC = OFF_KVS + SZ_KVS, OFF_SPV = OFF_DEC + SZ_DEC, OFF_MCNT = OFF_SPV + SZ_KVS, OFF_MLIST = OFF_MCNT + 4096, OFF_PO = OFF_MLIST + al256((size_t)MOBA_H * NBLK * SEQ * 4),
                 OFF_PML = OFF_PO + al256((size_t)MOBA_H * SEQ * 4 * 128 * 4), END_EVEN = OFF_PML + al256((size_t)MOBA_H * SEQ * 4 * 2 * 4);
constexpr size_t SZ_GD = al256((size_t)GDN_H * NCH * 64 * 128 * 4), SZ_ATT = al256((size_t)GDN_H * NCH * 64 * 64 * 4), SZ_EGL = al256((size_t)GDN_H * NCH * 4),
                 SZ_O32 = al256((size_t)SEQ * GDN_H * 128 * 4), SZ_XEND = al256((size_t)NCH * S5_G * S5_P * 2 * 4), SZ_YS = al256((size_t)SEQ * S5_CH * 2);
constexpr size_t OFF_GU_ = 0;
constexpr size_t OFF_GU = OFF_SCR, OFF_GW = OFF_GU + SZ_GD, OFF_GQD = OFF_GW + SZ_GD, OFF_GKD = OFF_GQD + SZ_GD, OFF_ATT = OFF_GKD + SZ_GD, OFF_EGL = OFF_ATT + SZ_ATT,
                 OFF_O32 = OFF_EGL + SZ_EGL, OFF_XEND = OFF_O32 + SZ_O32, OFF_YS = OFF_XEND + SZ_XEND, OFF_CARRY = OFF_YS + SZ_YS, END_ODD = OFF_CARRY + SZ_XEND;
constexpr size_t WS_NEEDED = cmax(END_FFN, cmax(END_EVEN, END_ODD));

struct Params {
  const float *x, *even_w_in, *gla_w_gate2, *gla_b_gate, *gla_norm_g, *even_w_out, *odd_w_in, *gdn_conv_w, *gdn_a_log, *gdn_dt_bias, *gdn_norm_g,
      *s5_a_re, *s5_a_im, *s5_b_re, *s5_b_im, *s5_c_re, *s5_c_im, *s5_d, *s5_log_step, *s5_glu_w, *s5_glu_b, *odd_w_out, *ln_mix_g, *ln_mix_b,
      *ffn_w_up, *ffn_conv_w, *ffn_w_down, *ln_ffn_g, *ln_ffn_b;
  float* out; char* ws; int step_begin, step_end;
};

#ifdef EMU
__device__ __forceinline__ int tid_() { return threadIdx.x; }
#define LAUNDER_S(x)
#define SCHED_FENCE()
#define LAUNDER_V(x)
#define DRAIN_VM()
__device__ __forceinline__ void lds_barrier() { __syncthreads(); }
#else
__device__ __forceinline__ void lds_barrier() { asm volatile("s_waitcnt lgkmcnt(0)\n\ts_barrier" ::: "memory"); }
__device__ __forceinline__ int tid_() { int t = threadIdx.x; asm volatile("" : "+v"(t)); return t; }
#define LAUNDER_S(x) asm volatile("" : "+s"(x))
#define DRAIN_VM() __builtin_amdgcn_s_waitcnt(0x0F70)
#define SCHED_FENCE() __builtin_amdgcn_sched_barrier(0)
#define LAUNDER_V(x) asm volatile("" : "+v"(x))
#endif

__device__ __forceinline__ bf16_t f2bf(float f) { unsigned u = __float_as_uint(f); u += 0x7FFFu + ((u >> 16) & 1u); return (bf16_t)(u >> 16); }
__device__ __forceinline__ float bf2f(bf16_t b) { return __uint_as_float(((unsigned)b) << 16); }
#ifdef EMU
__device__ __forceinline__ unsigned pack2(float lo, float hi) { return (unsigned)f2bf(lo) | ((unsigned)f2bf(hi) << 16); }
#else
typedef __bf16 bf16v2_t __attribute__((ext_vector_type(2)));
__device__ __forceinline__ unsigned pack2(float lo, float hi) { const bf16v2_t v = __builtin_convertvector((f32x2){lo, hi}, bf16v2_t); return __builtin_bit_cast(unsigned, v); }
#endif
__device__ __forceinline__ float sigmoidf_(float x) { return 1.f / (1.f + __expf(-x)); }
__device__ __forceinline__ float siluf_(float x) { return x / (1.f + __expf(-x)); }
__device__ __forceinline__ float softplusf_(float x) { return fmaxf(x, 0.f) + log1pf(__expf(-fabsf(x))); }
__device__ __forceinline__ float geluf_(float x) { float u = 0.7978845608028654f * (x + 0.044715f * x * x * x); float e = __expf(2.f * u); float th = 1.f - 2.f / (e + 1.f); return 0.5f * x * (1.f + th); }
__device__ __forceinline__ f32x4 shfl_xor4(f32x4 v, int m) {
#ifdef EMU
  return __shfl_xor(v, m);
#else
  f32x4 r; r[0] = __shfl_xor(v[0], m); r[1] = __shfl_xor(v[1], m); r[2] = __shfl_xor(v[2], m); r[3] = __shfl_xor(v[3], m); return r;
#endif
}
__device__ __forceinline__ f32x4 f4zero() { return (f32x4){0.f, 0.f, 0.f, 0.f}; }
template <int CTRL> __device__ __forceinline__ float dpp_mov(float v) {
#ifdef EMU
  const int l = tid_() & 63; const int src = (CTRL == 0xB1) ? (l ^ 1) : (CTRL == 0x4E) ? (l ^ 2) : ((l & ~7) | (7 - (l & 7)));
  return __shfl(v, src);
#else
  return __builtin_bit_cast(float, __builtin_amdgcn_update_dpp(0, __builtin_bit_cast(int, v), CTRL, 0xF, 0xF, true));
#endif
}
__device__ __forceinline__ f32x4 red4_f4(f32x4 v) {
#pragma unroll
  for (int e = 0; e < 4; ++e) { v[e] += dpp_mov<0xB1>(v[e]); v[e] += dpp_mov<0x4E>(v[e]); }
  return v;
}
__device__ __forceinline__ f32x4 red8_f4(f32x4 v) {
#pragma unroll
  for (int e = 0; e < 4; ++e) { v[e] += dpp_mov<0xB1>(v[e]); v[e] += dpp_mov<0x4E>(v[e]); v[e] += dpp_mov<0x141>(v[e]); }
  return v;
}

namespace pg8 {
constexpr int BM = 256, BK = 64, HALF = 128, HTB = HALF * BK * 2, STAGE_BYTES = 8 * HTB, NXCD = 8, WGM = 8;
__host__ __device__ __forceinline__ int lds_byte(int r, int c) { const int st = (r >> 4) * 2 + (c >> 5), rr = r & 15, cc = c & 31, ob = rr * 64 + cc * 2; return st * 1024 + (ob ^ (((ob >> 9) & 1) << 5)); }
__host__ __device__ __forceinline__ void stage_rc(int b, int& R, int& C) { const int st = b / 1024, sb = b % 1024, swz = sb ^ (((sb >> 9) & 1) << 5); R = (st >> 1) * 16 + swz / 64; C = (st & 1) * 32 + (swz % 64) / 2; }
__host__ __device__ __forceinline__ int perm32(int rho) { const int n = rho >> 4, i = rho & 15; return 8 * (i >> 2) + 4 * n + (i & 3); }
struct Unit { int pm, pn; };
struct Gemm { const bf16_t* A; const bf16_t* Bt; int M, N, K; };
struct StaticOrder {
  int nM, nN, nwg, G, c;
  __host__ __device__ void init(int M, int N, int G_, int c_) { nM = M / BM; nN = N / BM; nwg = nM * nN; G = G_; c = c_; }
  __host__ __device__ bool next(int i, Unit& u) const {
    const long L = (long)i * G + c; if (L >= nwg) return false;
    int wgid = (int)L; { const int q = nwg / NXCD, r = nwg % NXCD, xcd = wgid % NXCD, off = wgid / NXCD; wgid = (xcd < r ? xcd * (q + 1) : r * (q + 1) + (xcd - r) * q) + off; }
    const int nig = WGM * nN, gid = wgid / nig, fm = gid * WGM, gsz = (nM - fm) < WGM ? (nM - fm) : WGM;
    u.pm = fm + ((wgid % nig) % gsz); u.pn = (wgid % nig) / gsz; return true;
  }
};
#ifndef EMU
#define PG8_LAS __attribute__((address_space(3)))
template <class Epi>
__device__ __forceinline__ void gemm_phase(char* smem, const Gemm g, const StaticOrder& S, const Epi& E) {
  PG8_LAS unsigned char* lds = (PG8_LAS unsigned char*)smem;
  const int tid = tid_(), wid = __builtin_amdgcn_readfirstlane(tid >> 6), lane = tid & 63, wr = wid >> 2, wc = wid & 3, fr = lane & 15, fq = lane >> 4;
  const int K = g.K, nt = K / BK;
  unsigned voffA[2], voffB[2];
#pragma unroll
  for (int i = 0; i < 2; ++i) { int R, C; stage_rc(tid * 16 + i * 8192, R, C); const int Rb = Epi::PERM ? ((R & ~31) + perm32(R & 31)) : R; voffA[i] = (unsigned)(R * K + C) * 2u; voffB[i] = (unsigned)(Rb * K + C) * 2u; }
  const size_t kstep = (size_t)(BK * 2);
  const size_t hstep = (size_t)HALF * K * 2;
  const size_t tstep = 2 * hstep;
  const unsigned ldsw = (unsigned)wid * 1024u;
  const int aoff = lds_byte(wr * 64 + fr, fq * 8), boff = lds_byte(wc * 32 + fr, fq * 8);
#define PG8_SA(b, h) (((b) * 2 + (h)) * HTB)
#define PG8_SB(b, h) ((4 + (b) * 2 + (h)) * HTB)
#define PG8_STAGE(bufoff, gbase, voff) do { _Pragma("unroll") for (int _i = 0; _i < 2; ++_i) \
    __builtin_amdgcn_global_load_lds((const unsigned*)((const char*)(gbase) + (voff)[_i]), (PG8_LAS unsigned*)(lds + (bufoff) + ldsw + _i * 8192), 16, 0, 0); } while (0)
#define PG8_LDA(dst, b, h) do { _Pragma("unroll") for (int m = 0; m < 4; ++m) _Pragma("unroll") for (int k = 0; k < 2; ++k) dst[m][k] = *(const PG8_LAS bf16x8*)(lds + PG8_SA(b, h) + aoff + m * 2048 + k * 1024); } while (0)
#define PG8_LDB(dst, b, h) do { _Pragma("unroll") for (int n = 0; n < 2; ++n) _Pragma("unroll") for (int k = 0; k < 2; ++k) dst[n][k] = *(const PG8_LAS bf16x8*)(lds + PG8_SB(b, h) + boff + n * 2048 + k * 1024); } while (0)
#define PG8_MMA(ai, bj, At, Bt) do { __builtin_amdgcn_s_setprio(1); _Pragma("unroll") for (int m = 0; m < 4; ++m) _Pragma("unroll") for (int n = 0; n < 2; ++n) _Pragma("unroll") for (int k = 0; k < 2; ++k) \
    acc[ai][bj][m][n] = __builtin_amdgcn_mfma_f32_16x16x32_bf16(Bt[n][k], At[m][k], acc[ai][bj][m][n], 0, 0, 0); __builtin_amdgcn_s_setprio(0); } while (0)
#define PG8_WAIT_V(n) asm volatile("s_waitcnt vmcnt(" #n ")" ::: "memory")
#define PG8_WAIT_L(n) asm volatile("s_waitcnt lgkmcnt(" #n ")" ::: "memory")
#define PG8_BAR __builtin_amdgcn_s_barrier()
#define PG8_SCHED __builtin_amdgcn_sched_barrier(0)
  Unit cur, nxt; int ui = 0;
  if (!S.next(0, cur)) return;
  f32x4 acc[2][2][4][2];
#pragma unroll
  for (int a = 0; a < 2; ++a)
#pragma unroll
    for (int b = 0; b < 2; ++b)
#pragma unroll
      for (int m = 0; m < 4; ++m)
#pragma unroll
        for (int n = 0; n < 2; ++n) acc[a][b][m][n] = (f32x4){0.f, 0.f, 0.f, 0.f};
  bf16x8 At[4][2], B0[2][2], B1[2][2];
  const char* cA = (const char*)g.A + (size_t)cur.pm * tstep; const char* cB = (const char*)g.Bt + (size_t)cur.pn * tstep;
  PG8_STAGE(PG8_SB(0, 0), cB, voffB); PG8_STAGE(PG8_SA(0, 0), cA, voffA); PG8_STAGE(PG8_SB(0, 1), cB + hstep, voffB); PG8_STAGE(PG8_SA(0, 1), cA + hstep, voffA);
  if (wr == 1) PG8_BAR;
  PG8_WAIT_V(4); PG8_BAR;
  PG8_STAGE(PG8_SB(1, 0), cB + kstep, voffB); PG8_STAGE(PG8_SA(1, 0), cA + kstep, voffA); PG8_STAGE(PG8_SB(1, 1), cB + hstep + kstep, voffB);
  PG8_WAIT_V(6); PG8_BAR;
  for (;;) {
    const bool has_next = S.next(ui + 1, nxt);
    const char* nA = has_next ? (const char*)g.A + (size_t)nxt.pm * tstep : cA; const char* nB = has_next ? (const char*)g.Bt + (size_t)nxt.pn * tstep : cB;
    for (int t = 0; t < nt; t += 2) {
      const bool last = (t == nt - 2);
      const char* a1 = cA + (size_t)(t + 1) * kstep;
      const char* a2 = last ? nA : cA + (size_t)(t + 2) * kstep; const char* b2 = last ? nB : cB + (size_t)(t + 2) * kstep;
      const char* a3 = a2 + kstep; const char* b3 = b2 + kstep;
      PG8_LDB(B0, 0, 0); PG8_SCHED; PG8_LDA(At, 0, 0); PG8_STAGE(PG8_SA(1, 1), a1 + hstep, voffA);
      PG8_WAIT_L(8); PG8_BAR; PG8_WAIT_L(0); PG8_MMA(0, 0, At, B0); PG8_BAR; PG8_SCHED;
      PG8_LDB(B1, 0, 1); PG8_STAGE(PG8_SB(0, 0), b2, voffB);
      PG8_BAR; PG8_WAIT_L(0); PG8_MMA(0, 1, At, B1); PG8_BAR;
      PG8_LDA(At, 0, 1); PG8_STAGE(PG8_SA(0, 0), a2, voffA);
      PG8_BAR; PG8_WAIT_L(0); PG8_MMA(1, 0, At, B0); PG8_BAR; PG8_SCHED;
      PG8_STAGE(PG8_SB(0, 1), b2 + hstep, voffB);
      PG8_WAIT_V(6); PG8_BAR; PG8_MMA(1, 1, At, B1); PG8_BAR;
      PG8_LDB(B0, 1, 0); PG8_SCHED; PG8_LDA(At, 1, 0); PG8_STAGE(PG8_SA(0, 1), a2 + hstep, voffA);
      PG8_WAIT_L(8); PG8_BAR; PG8_WAIT_L(0); PG8_MMA(0, 0, At, B0); PG8_BAR; PG8_SCHED;
      PG8_LDB(B1, 1, 1); PG8_STAGE(PG8_SB(1, 0), b3, voffB);
      PG8_BAR; PG8_WAIT_L(0); PG8_MMA(0, 1, At, B1); PG8_BAR;
      PG8_LDA(At, 1, 1); PG8_STAGE(PG8_SA(1, 0), a3, voffA);
      PG8_BAR; PG8_WAIT_L(0); PG8_MMA(1, 0, At, B0); PG8_BAR; PG8_SCHED;
      PG8_STAGE(PG8_SB(1, 1), b3 + hstep, voffB);
      PG8_WAIT_V(6); PG8_BAR; PG8_MMA(1, 1, At, B1); PG8_BAR;
    }
    E(acc, cur, wr, wc, fr, fq);
    if (!has_next) break;
#pragma unroll
    for (int a = 0; a < 2; ++a)
#pragma unroll
      for (int b = 0; b < 2; ++b)
#pragma unroll
        for (int m = 0; m < 4; ++m)
#pragma unroll
          for (int n = 0; n < 2; ++n) acc[a][b][m][n] = (f32x4){0.f, 0.f, 0.f, 0.f};
    cur = nxt; cA = nA; cB = nB; ++ui;
  }
  PG8_WAIT_V(0);
  if (wr == 0) PG8_BAR;
  PG8_BAR;
#undef PG8_SA
#undef PG8_SB
#undef PG8_STAGE
#undef PG8_LDA
#undef PG8_LDB
#undef PG8_MMA
#undef PG8_WAIT_V
#undef PG8_WAIT_L
#undef PG8_BAR
#undef PG8_SCHED
}
#else
template <class Epi>
void gemm_phase(char* smem, const Gemm g, const StaticOrder& S, const Epi& E) {
  const int tid = tid_(), wid = tid >> 6, lane = tid & 63, wr = wid >> 2, wc = wid & 3, fr = lane & 15, fq = lane >> 4;
  Unit u;
  for (int i = 0; S.next(i, u); ++i) {
    f32x4 acc[2][2][4][2];
    for (int ai = 0; ai < 2; ++ai) for (int bj = 0; bj < 2; ++bj) for (int m = 0; m < 4; ++m) for (int n = 0; n < 2; ++n) for (int j = 0; j < 4; ++j) {
      int row = u.pm * 256 + ai * 128 + wr * 64 + m * 16 + fr, col = u.pn * 256 + bj * 128 + wc * 32 + (Epi::PERM ? (fq * 8 + n * 4) : (n * 16 + fq * 4)) + j;
      const bf16_t* a = g.A + (size_t)row * g.K; const bf16_t* b = g.Bt + (size_t)col * g.K; float s = 0.f;
      for (int k = 0; k < g.K; ++k) s += bf2f(a[k]) * bf2f(b[k]);
      acc[ai][bj][m][n][j] = s;
    }
    E(acc, u, wr, wc, fr, fq);
  }
}
#endif
}
using pg8::Unit;

#define EPI_LOOP_BEGIN _Pragma("unroll") for (int ai = 0; ai < 2; ++ai) _Pragma("unroll") for (int m = 0; m < 4; ++m) { const int row = u.pm * 256 + ai * 128 + wr * 64 + m * 16 + fr;
#define EPI_FRAG_LOOP _Pragma("unroll") for (int bj = 0; bj < 2; ++bj) _Pragma("unroll") for (int n = 0; n < 2; ++n) { const int col = EPI_COLMAP(u.pn * 256 + bj * 128 + wc * 32 + n * 16 + fq * 4); const f32x4 v = acc[ai][bj][m][n];
#define EPI_COLMAP(c) (c)
#undef EPI_COLMAP
#define EPI_COLMAP(c) ((c) + (((c) >= EV_GLR) ? 16 : 0))
struct EpiEvenIn {
  static constexpr bool PERM = false;
  float* H32; bf16_t *MQ, *MK, *MVT;
  __device__ __forceinline__ void operator()(const f32x4 (&acc)[2][2][4][2], const Unit& u, int wr, int wc, int fr, int fq) const {
    EPI_LOOP_BEGIN
      EPI_FRAG_LOOP
        const int gcol = col; (void)gcol;
        if (col < EV_MQ) *(f32x4*)(H32 + (size_t)row * EV_LD + col) = v;
        else if (col < EV_MK) *(u32x2*)(MQ + (size_t)row * MQ_LD + (col - EV_MQ)) = (u32x2){pack2(v[0], v[1]), pack2(v[2], v[3])};
        else if (col < EV_MV) *(u32x2*)(MK + (size_t)row * MQ_LD + (col - EV_MK)) = (u32x2){pack2(v[0], v[1]), pack2(v[2], v[3])};
        else if (col < EVEN_IN) { bf16_t* d = MVT + (size_t)(col - EV_MV) * SEQ + row; d[0] = f2bf(v[0]); d[SEQ] = f2bf(v[1]); d[2 * (size_t)SEQ] = f2bf(v[2]); d[3 * (size_t)SEQ] = f2bf(v[3]); }
      }
    }
  }
};
#undef EPI_COLMAP
#define EPI_COLMAP(c) (c)
struct EpiOddIn {
  static constexpr bool PERM = false;
  float* H32;
  __device__ __forceinline__ void operator()(const f32x4 (&acc)[2][2][4][2], const Unit& u, int wr, int wc, int fr, int fq) const {
    EPI_LOOP_BEGIN
      EPI_FRAG_LOOP
        if (col < ODD_IN) *(f32x4*)(H32 + (size_t)row * OD_LD + col) = v;
      }
    }
  }
};
struct EpiBf16 {
  static constexpr bool PERM = true;
  bf16_t* O; int ld;
  __device__ __forceinline__ void operator()(const f32x4 (&acc)[2][2][4][2], const Unit& u, int wr, int wc, int fr, int fq) const {
    EPI_LOOP_BEGIN
      _Pragma("unroll") for (int bj = 0; bj < 2; ++bj) { const int col = u.pn * 256 + bj * 128 + wc * 32 + fq * 8; const f32x4 v0 = acc[ai][bj][m][0], v1 = acc[ai][bj][m][1];
        *(u32x4*)(O + (size_t)row * ld + col) = (u32x4){pack2(v0[0], v0[1]), pack2(v0[2], v0[3]), pack2(v1[0], v1[1]), pack2(v1[2], v1[3])};
      }
    }
  }
};
struct EpiRes {
  static constexpr bool PERM = false;
  const float* raw; const float* pst; const float* pg; const float* pb; float* Y; float* stats;
  __device__ __forceinline__ void operator()(const f32x4 (&acc)[2][2][4][2], const Unit& u, int wr, int wc, int fr, int fq) const {
    EPI_LOOP_BEGIN
      SCHED_FENCE();
      float s = 0.f, ss = 0.f, mu = 0.f, rs = 1.f;
      if (!raw) { mu = pst[(size_t)row * 2] * (1.f / DM); const float var = pst[(size_t)row * 2 + 1] * (1.f / DM) - mu * mu; rs = rsqrtf(fmaxf(var, 0.f) + 1e-5f); }
      EPI_FRAG_LOOP
        f32x4 r;
        if (raw) r = *(const f32x4*)(raw + (size_t)row * DM + col);
        else { const f32x4 yo = *(const f32x4*)(Y + (size_t)row * DM + col), gg = *(const f32x4*)(pg + col), bb = *(const f32x4*)(pb + col); r = (yo - mu) * rs * gg + bb; }
        const f32x4 y = r * ALPHA + v;
        *(f32x4*)(Y + (size_t)row * DM + col) = y;
        s += y[0] + y[1] + y[2] + y[3]; ss += y[0] * y[0] + y[1] * y[1] + y[2] * y[2] + y[3] * y[3];
      }
      s += __shfl_xor(s, 16); ss += __shfl_xor(ss, 16); s += __shfl_xor(s, 32); ss += __shfl_xor(ss, 32);
      if (fq == 0) { atomicAdd(stats + (size_t)row * 2, s); atomicAdd(stats + (size_t)row * 2 + 1, ss); }
    }
  }
};
struct EpiGlu {
  static constexpr bool PERM = false;
  const bf16_t* YS; const float* bias; bf16_t* CAT;
  __device__ __forceinline__ void operator()(const f32x4 (&acc)[2][2][4][2], const Unit& u, int wr, int wc, int fr, int fq) const {
    EPI_LOOP_BEGIN
      EPI_FRAG_LOOP
        const u32x2 yy = *(const u32x2*)(YS + (size_t)row * S5_CH + col);
        const f32x4 b = *(const f32x4*)(bias + col);
        float y0 = __uint_as_float(yy[0] << 16), y1 = __uint_as_float(yy[0] & 0xffff0000u), y2 = __uint_as_float(yy[1] << 16), y3 = __uint_as_float(yy[1] & 0xffff0000u);
        y0 *= sigmoidf_(v[0] + b[0]); y1 *= sigmoidf_(v[1] + b[1]); y2 *= sigmoidf_(v[2] + b[2]); y3 *= sigmoidf_(v[3] + b[3]);
        *(u32x2*)(CAT + (size_t)row * ODD_OUT + GDN_H * 128 + col) = (u32x2){pack2(y0, y1), pack2(y2, y3)};
      }
    }
  }
};

template <class Epi> __device__ __forceinline__ void run_gemm(char* smem, const bf16_t* A, const bf16_t* Bt, int N, int K, const Epi& E, int bid, int nb) {
  pg8::Gemm g{A, Bt, SEQ, N, K}; pg8::StaticOrder S; S.init(SEQ, N, nb, bid);
  pg8::gemm_phase<Epi>(smem, g, S, E);
}

__device__ __forceinline__ void transpose_convert(const float* src, bf16_t* dst, int K, int N, int Np, char* smem, int bid, int nb, int glr = -1) {
  float* T = (float*)smem;
  const int tk = K / 64, tn = Np / 64, ntile = tk * tn, tid = tid_();
  const int r0 = tid >> 4, c4 = (tid & 15) * 4;
  f32x4 v[2];
  if (bid < ntile) { const int k0 = (bid % tk) * 64, n = (bid / tk) * 64 + c4;
#pragma unroll
    for (int i = 0; i < 2; ++i) v[i] = (n < N) ? *(const f32x4*)(src + (size_t)(k0 + r0 + 32 * i) * N + n) : f4zero(); }
  for (int t = bid; t < ntile; t += nb) {
    const int k0 = (t % tk) * 64, n0 = (t / tk) * 64;
#pragma unroll
    for (int i = 0; i < 2; ++i) {
#pragma unroll
      for (int e = 0; e < 4; ++e) T[(c4 + e) * 65 + r0 + 32 * i] = v[i][e]; }
    __syncthreads();
    if (t + nb < ntile) { const int k1 = ((t + nb) % tk) * 64, n = ((t + nb) / tk) * 64 + c4;
#pragma unroll
      for (int i = 0; i < 2; ++i) v[i] = (n < N) ? *(const f32x4*)(src + (size_t)(k1 + r0 + 32 * i) * N + n) : f4zero(); }
    { const int n = tid >> 3, ks = (tid & 7) * 8; const float* tp = T + n * 65 + ks;
      u32x4 o; o[0] = pack2(tp[0], tp[1]); o[1] = pack2(tp[2], tp[3]); o[2] = pack2(tp[4], tp[5]); o[3] = pack2(tp[6], tp[7]);
      int dn = n0 + n; if (glr >= 0) dn = (dn < glr) ? dn : (dn < glr + 16) ? (N - 16 + (dn - glr)) : (dn < N) ? dn - 16 : dn;
      *(u32x4*)(dst + (size_t)dn * K + k0 + ks) = o; }
    __syncthreads();
  }
}
__device__ __forceinline__ void conv_mat(const Params& p, int kind, int idx, char* smem, int bid, int nb) {
  const float* src; size_t doff; int K, N, Np, glr = -1;
  switch (kind) {
    case 0: src = p.even_w_in + (size_t)idx * DM * EVEN_IN; doff = OFF_WINE + idx * SZ_WINE; K = DM; N = EVEN_IN; Np = EVEN_NP; glr = EV_GLR; break;
    case 1: src = p.even_w_out + (size_t)idx * EVEN_OUT * DM; doff = OFF_WOUTE + idx * SZ_WOUTE; K = EVEN_OUT; N = DM; Np = DM; break;
    case 2: src = p.odd_w_in + (size_t)idx * DM * ODD_IN; doff = OFF_WINO + idx * SZ_WINO; K = DM; N = ODD_IN; Np = ODD_NP; break;
    case 3: src = p.s5_glu_w + (size_t)idx * S5_CH * S5_CH; doff = OFF_WGLU + idx * SZ_WGLU; K = S5_CH; N = S5_CH; Np = S5_CH; break;
    case 4: src = p.odd_w_out + (size_t)idx * ODD_OUT * DM; doff = OFF_WOUTO + idx * SZ_WOUTO; K = ODD_OUT; N = DM; Np = DM; break;
    case 5: src = p.ffn_w_up + (size_t)idx * DM * 2 * DFF; doff = OFF_WUP + idx * SZ_WUP; K = DM; N = 2 * DFF; Np = 2 * DFF; break;
    default: src = p.ffn_w_down + (size_t)idx * DFF * DM; doff = OFF_WDN + idx * SZ_WDN; K = DFF; N = DM; Np = DM; break;
  }
  transpose_convert(src, (bf16_t*)(p.ws + doff), K, N, Np, smem, bid, nb, glr);
}
__device__ __forceinline__ void conv_group(const Params& p, int g, char* smem, int bid, int nb) {
#pragma unroll 1
  for (int k = 0; k < 10; ++k) {
    int kind, idx; bool on;
    if (g < 0) { kind = (k < 2) ? k : (k < 4) ? k + 3 : k - 2; idx = 0; on = (k < 4) || (k < 7 && DEPTH > 1); }
    else {
      if (k < 2) { kind = 5 + k; idx = g; on = true; }
      else if (k < 4) { kind = k - 2; idx = (g + 1) >> 1; on = g + 1 < DEPTH; }
      else if (k < 6) { kind = 5 + (k - 4); idx = g + 1; on = g + 1 < DEPTH; }
      else if (k < 9) { kind = 2 + (k - 6); idx = (g + 2) >> 1; on = g + 2 < DEPTH; }
      else { kind = 0; idx = 0; on = false; }
    }
    if (on) conv_mat(p, kind, idx, smem, bid, nb);
  }
}
__device__ __forceinline__ void step_prep(const Params& p, char* smem, int bid, int nb) {
  char* ws = p.ws;
  conv_group(p, -1, smem, bid, nb);
  const size_t gt = (size_t)bid * 512 + tid_(), gn = (size_t)nb * 512;
  { bf16_t* XB = (bf16_t*)(ws + OFF_XB);
    for (size_t e = gt; e < (size_t)SEQ * DM / 4; e += gn) { const f32x4 v = *(const f32x4*)(p.x + e * 4); *(u32x2*)(XB + e * 4) = (u32x2){pack2(v[0], v[1]), pack2(v[2], v[3])}; } }
  { float* st = (float*)(ws + OFF_STATS); for (size_t e = gt; e < (size_t)DEPTH * 2 * SEQ * 2; e += gn) st[e] = 0.f; }
  for (size_t e = gt; e < (size_t)N_ODD * S5_G * S5_P; e += gn) {
    const int j = (int)(e / (S5_G * S5_P)), gp = (int)(e % (S5_G * S5_P)), g = gp / S5_P;
    float* C = (float*)(ws + OFF_S5C + j * SZ_S5C1);
    const float are = p.s5_a_re[(size_t)j * S5_G * S5_P + gp], aim = p.s5_a_im[(size_t)j * S5_G * S5_P + gp];
    const float step = expf(p.s5_log_step[j * S5_G + g]);
    const float mag = expf(are * step), abr = mag * cosf(aim * step), abi = mag * sinf(aim * step);
    const float den = are * are + aim * aim;
    const float zr = ((abr - 1.f) * are + abi * aim) / den, zi = (abi * are - (abr - 1.f) * aim) / den;
    C[gp] = abr; C[S5_G * S5_P + gp] = abi;
    float pr = abr, pi = abi;
    for (int k = 0; k < 6; ++k) { const float nr = pr * pr - pi * pi, ni = 2.f * pr * pi; pr = nr; pi = ni; }
    C[2 * S5_G * S5_P + gp] = pr; C[3 * S5_G * S5_P + gp] = pi;
    float* BBR = C + 4 * S5_G * S5_P + (size_t)gp * 16; float* BBI = C + 20 * S5_G * S5_P + (size_t)gp * 16;
    for (int c = 0; c < 16; ++c) { const float br = p.s5_b_re[((size_t)j * S5_G * S5_P + gp) * 16 + c], bi = p.s5_b_im[((size_t)j * S5_G * S5_P + gp) * 16 + c];
      BBR[c] = zr * br - zi * bi; BBI[c] = zr * bi + zi * br; }
  }
}

__device__ __forceinline__ void step_ln(const float* Y, const float* stats, const float* g, const float* b, float* X32, bf16_t* XB, int bid, int nb) {
  const int w = tid_() >> 6, lane = tid_() & 63;
  constexpr int NV = DM / 256;
  for (int row = bid * 8 + w; row < SEQ; row += nb * 8) {
    f32x4 y[NV];
#pragma unroll
    for (int i = 0; i < NV; ++i) y[i] = *(const f32x4*)(Y + (size_t)row * DM + lane * 4 + i * 256);
    const float mu = stats[(size_t)row * 2] * (1.f / DM); const float var = stats[(size_t)row * 2 + 1] * (1.f / DM) - mu * mu; const float rs = rsqrtf(fmaxf(var, 0.f) + 1e-5f);
#pragma unroll
    for (int i = 0; i < NV; ++i) { const int c = lane * 4 + i * 256;
      const f32x4 gg = *(const f32x4*)(g + c), bb = *(const f32x4*)(b + c);
      const f32x4 o = (y[i] - mu) * rs * gg + bb;
      if (X32) *(f32x4*)(X32 + (size_t)row * DM + c) = o;
      *(u32x2*)(XB + (size_t)row * DM + c) = (u32x2){pack2(o[0], o[1]), pack2(o[2], o[3])}; }
  }
}

__device__ __forceinline__ void step_ffn_conv(const bf16_t* H16, const float* cw, bf16_t* G16, int bid, int nb) {
  constexpr int CG = DFF / 8, RB = 16;
  const size_t total = (size_t)(SEQ / RB) * CG;
  for (size_t it = (size_t)bid * 512 + tid_(); it < total; it += (size_t)nb * 512) {
    const int cg8 = (int)(it % CG) * 8, t0 = (int)(it / CG) * RB;
    float wg[3][8], wv[3][8];
#pragma unroll
    for (int i = 0; i < 3; ++i) {
#pragma unroll
      for (int k = 0; k < 8; k += 4) { const f32x4 a = *(const f32x4*)(cw + (size_t)i * 2 * DFF + cg8 + k), b = *(const f32x4*)(cw + (size_t)i * 2 * DFF + DFF + cg8 + k);
        wg[i][k] = a[0]; wg[i][k + 1] = a[1]; wg[i][k + 2] = a[2]; wg[i][k + 3] = a[3]; wv[i][k] = b[0]; wv[i][k + 1] = b[1]; wv[i][k + 2] = b[2]; wv[i][k + 3] = b[3]; }
    }
    float g0[8], g1[8], v0[8], v1[8];
#pragma unroll
    for (int k = 0; k < 8; ++k) { g0[k] = g1[k] = v0[k] = v1[k] = 0.f; }
    if (t0 >= 2) {
      const u32x4 a = *(const u32x4*)(H16 + (size_t)(t0 - 2) * 2 * DFF + cg8), b = *(const u32x4*)(H16 + (size_t)(t0 - 2) * 2 * DFF + DFF + cg8);
      const u32x4 c = *(const u32x4*)(H16 + (size_t)(t0 - 1) * 2 * DFF + cg8), d = *(const u32x4*)(H16 + (size_t)(t0 - 1) * 2 * DFF + DFF + cg8);
#pragma unroll
      for (int k = 0; k < 4; ++k) { g0[2 * k] = __uint_as_float(a[k] << 16); g0[2 * k + 1] = __uint_as_float(a[k] & 0xffff0000u); v0[2 * k] = __uint_as_float(b[k] << 16); v0[2 * k + 1] = __uint_as_float(b[k] & 0xffff0000u);
        g1[2 * k] = __uint_as_float(c[k] << 16); g1[2 * k + 1] = __uint_as_float(c[k] & 0xffff0000u); v1[2 * k] = __uint_as_float(d[k] << 16); v1[2 * k + 1] = __uint_as_float(d[k] & 0xffff0000u); }
    }
#pragma unroll 1
    for (int tb = t0; tb < t0 + RB; tb += 8) {
      u32x4 ra[8], rb[8];
#pragma unroll
      for (int r = 0; r < 8; ++r) { ra[r] = *(const u32x4*)(H16 + (size_t)(tb + r) * 2 * DFF + cg8); rb[r] = *(const u32x4*)(H16 + (size_t)(tb + r) * 2 * DFF + DFF + cg8); }
#pragma unroll
      for (int r = 0; r < 8; ++r) {
        const u32x4 a = ra[r], b = rb[r]; const int t = tb + r;
        float g2[8], v2[8], o[8];
#pragma unroll
        for (int k = 0; k < 4; ++k) { g2[2 * k] = __uint_as_float(a[k] << 16); g2[2 * k + 1] = __uint_as_float(a[k] & 0xffff0000u); v2[2 * k] = __uint_as_float(b[k] << 16); v2[2 * k + 1] = __uint_as_float(b[k] & 0xffff0000u); }
#pragma unroll
        for (int k = 0; k < 8; ++k) { const float gg = wg[0][k] * g0[k] + wg[1][k] * g1[k] + wg[2][k] * g2[k]; const float vv = wv[0][k] * v0[k] + wv[1][k] * v1[k] + wv[2][k] * v2[k];
          o[k] = siluf_(gg) * vv; g0[k] = g1[k]; g1[k] = g2[k]; v0[k] = v1[k]; v1[k] = v2[k]; }
        u32x4 ov; ov[0] = pack2(o[0], o[1]); ov[1] = pack2(o[2], o[3]); ov[2] = pack2(o[4], o[5]); ov[3] = pack2(o[6], o[7]);
        *(u32x4*)(G16 + (size_t)t * DFF + cg8) = ov;
      }
    }
  }
}

__device__ __forceinline__ void gla_logcum(const Params& p, int j, int h, int n, float* CUM, const float* H32, float* TMP) {
  const int tid = tid_();
  const float* w2 = p.gla_w_gate2 + (size_t)j * 16 * (GLA_H * 64); const float* bg = p.gla_b_gate + (size_t)j * GLA_H * 64;
  float* GL = TMP; float* W2 = TMP + 1024; float* BG = W2 + 1024;
  for (int e = tid; e < 1024; e += 512) { GL[e] = H32[(size_t)(n * 64 + (e >> 4)) * EV_LD + EV_GLR + (e & 15)]; W2[e] = w2[(e >> 6) * (GLA_H * 64) + h * 64 + (e & 63)]; }
  if (tid < 64) BG[tid] = bg[h * 64 + tid];
  __syncthreads();
  for (int e = tid; e < 4096; e += 512) {
    const int t = e >> 6, d = e & 63; float x = BG[d];
#pragma unroll
    for (int r = 0; r < 16; ++r) x += GL[t * 16 + r] * W2[r * 64 + d];
    CUM[e] = (fminf(x, 0.f) - log1pf(__expf(-fabsf(x)))) * (1.f / 16.f);
  }
  __syncthreads();
  if (tid < 64) { float c = 0.f;
#pragma unroll 16
    for (int t = 0; t < 64; ++t) { c += CUM[t * 64 + tid]; CUM[t * 64 + tid] = c; } }
  __syncthreads();
}
__device__ __forceinline__ void gla_kv_item(const Params& p, int j, int h, int n, char* smem) {
  const float* H32 = (const float*)(p.ws + OFF_H32); float* KVS = (float*)(p.ws + OFF_KVS); float* DEC = (float*)(p.ws + OFF_DEC);
  float* CUM = (float*)smem; float* KD = CUM + 4096; float* VS = KD + 4096;
  const int tid = tid_();
  f32x4 vpre[4];
#pragma unroll
  for (int i = 0; i < 4; ++i) { const int e = tid + 512 * i, t = e >> 5, c4 = (e & 31) * 4; vpre[i] = *(const f32x4*)(H32 + (size_t)(n * 64 + t) * EV_LD + EV_GV + h * 128 + c4); }
  gla_logcum(p, j, h, n, CUM, H32, VS);
  for (int e = tid; e < 4096; e += 512) { const int t = e >> 6, d = e & 63; KD[e] = H32[(size_t)(n * 64 + t) * EV_LD + EV_GK + h * 64 + d] * __expf(CUM[63 * 64 + d] - CUM[e]); }
#pragma unroll
  for (int i = 0; i < 4; ++i) { const int e = tid + 512 * i, t = e >> 5, c4 = (e & 31) * 4; *(f32x4*)(VS + t * 128 + c4) = vpre[i]; }
  __syncthreads();
  const int dg = tid >> 5, vg = tid & 31;
  f32x4 acc[4] = {f4zero(), f4zero(), f4zero(), f4zero()};
#pragma unroll 4
  for (int t = 0; t < 64; ++t) { const f32x4 k4 = *(const f32x4*)(KD + t * 64 + dg * 4), v4 = *(const f32x4*)(VS + t * 128 + vg * 4);
#pragma unroll
    for (int i = 0; i < 4; ++i) acc[i] += k4[i] * v4; }
#pragma unroll
  for (int i = 0; i < 4; ++i) *(f32x4*)(KVS + ((size_t)(h * NCH + n) * 64 + dg * 4 + i) * 128 + vg * 4) = acc[i];
  if (tid < 64) DEC[(size_t)(h * NCH + n) * 64 + tid] = __expf(CUM[63 * 64 + tid]);
  __syncthreads();
}
__device__ __forceinline__ void gla_scan(const Params& p, int bid, int nb) {
  const float* __restrict__ KVS = (const float*)(p.ws + OFF_KVS); const float* __restrict__ DEC = (const float*)(p.ws + OFF_DEC); float* __restrict__ SPV = (float*)(p.ws + OFF_SPV);
  const int tid = tid_();
  if (tid < 256) for (int e = bid * 256 + tid; e < GLA_H * 64 * 128; e += nb * 256) {
    const int h = e / (64 * 128), d = (e >> 7) & 63, v = e & 127; float s = 0.f;
#pragma unroll 1
    for (int n0 = 0; n0 < NCH; n0 += 16) { float kv[16], dc[16];
#pragma unroll
      for (int k = 0; k < 16; ++k) { kv[k] = KVS[((size_t)(h * NCH + n0 + k) * 64 + d) * 128 + v]; dc[k] = DEC[(size_t)(h * NCH + n0 + k) * 64 + d]; }
#pragma unroll
      for (int k = 0; k < 16; ++k) { SPV[((size_t)(h * NCH + n0 + k) * 64 + d) * 128 + v] = s; s = s * dc[k] + kv[k]; } }
  }
}
__device__ __forceinline__ void gla_out_item(const Params& p, int j, int h, int n, char* smem) {
  constexpr int QP = 68;
  const float* H32 = (const float*)(p.ws + OFF_H32); const float* SP = (const float*)(p.ws + OFF_SPV) + (size_t)(h * NCH + n) * 64 * 128; bf16_t* CAT = (bf16_t*)(p.ws + OFF_CAT);
  float* CUM = (float*)smem; float* QE = CUM + 4096; float* KE = QE + 64 * QP; float* QEt = KE + 64 * QP; float* ATt = QEt + 64 * QP; float* VS = ATt + 64 * QP;
  float* SPs = QE;
  const int tid = tid_();
  f32x4 vpre[4];
#pragma unroll
  for (int i = 0; i < 4; ++i) { const int e = tid + 512 * i, t = e >> 5, c4 = (e & 31) * 4; vpre[i] = *(const f32x4*)(H32 + (size_t)(n * 64 + t) * EV_LD + EV_GV + h * 128 + c4); }
  gla_logcum(p, j, h, n, CUM, H32, VS);
  for (int e = tid; e < 4096; e += 512) { const int t = e >> 6, d = e & 63; const float* hr = H32 + (size_t)(n * 64 + t) * EV_LD; const float c = CUM[e];
    const float qe = hr[EV_GQ + h * 64 + d] * 0.125f * __expf(c); QE[t * QP + d] = qe; QEt[d * QP + t] = qe; KE[t * QP + d] = hr[EV_GK + h * 64 + d] * __expf(-c); }
#pragma unroll
  for (int i = 0; i < 4; ++i) { const int e = tid + 512 * i, t = e >> 5, c4 = (e & 31) * 4; *(f32x4*)(VS + t * 128 + c4) = vpre[i]; }
  __syncthreads();
  const int cg_ = tid >> 5, lg = tid & 31;
  { float a[4][2] = {{0.f, 0.f}, {0.f, 0.f}, {0.f, 0.f}, {0.f, 0.f}};
#pragma unroll 2
    for (int d4 = 0; d4 < 16; ++d4) { f32x4 k0 = *(const f32x4*)(KE + lg * QP + d4 * 4), k1 = *(const f32x4*)(KE + (lg + 32) * QP + d4 * 4);
#pragma unroll
      for (int i = 0; i < 4; ++i) { const f32x4 q = *(const f32x4*)(QE + (cg_ * 4 + i) * QP + d4 * 4); a[i][0] += q[0] * k0[0] + q[1] * k0[1] + q[2] * k0[2] + q[3] * k0[3]; a[i][1] += q[0] * k1[0] + q[1] * k1[1] + q[2] * k1[2] + q[3] * k1[3]; } }
#pragma unroll
    for (int i = 0; i < 4; ++i) { const int c = cg_ * 4 + i; ATt[lg * QP + c] = (c >= lg) ? a[i][0] : 0.f; ATt[(lg + 32) * QP + c] = (c >= lg + 32) ? a[i][1] : 0.f; } }
  __syncthreads();
  for (int e = tid; e < 64 * 32; e += 512) *(f32x4*)(SPs + e * 4) = *(const f32x4*)(SP + e * 4);
  __syncthreads();
  f32x4 acc[4] = {f4zero(), f4zero(), f4zero(), f4zero()};
#pragma unroll 4
  for (int s = 0; s < 64; ++s) { const f32x4 a4 = *(const f32x4*)(ATt + s * QP + cg_ * 4), v4 = *(const f32x4*)(VS + s * 128 + lg * 4);
#pragma unroll
    for (int i = 0; i < 4; ++i) acc[i] += a4[i] * v4; }
#pragma unroll 4
  for (int d = 0; d < 64; ++d) { const f32x4 q4 = *(const f32x4*)(QEt + d * QP + cg_ * 4), s4 = *(const f32x4*)(SPs + d * 128 + lg * 4);
#pragma unroll
    for (int i = 0; i < 4; ++i) acc[i] += q4[i] * s4; }
  const f32x4 ng = *(const f32x4*)(p.gla_norm_g + (size_t)j * 128 + lg * 4);
#pragma unroll
  for (int i = 0; i < 4; ++i) {
    float ss = acc[i][0] * acc[i][0] + acc[i][1] * acc[i][1] + acc[i][2] * acc[i][2] + acc[i][3] * acc[i][3];
    ss += __shfl_xor(ss, 1); ss += __shfl_xor(ss, 2); ss += __shfl_xor(ss, 4); ss += __shfl_xor(ss, 8); ss += __shfl_xor(ss, 16);
    const float r = rsqrtf(ss * (1.f / 128.f) + 1e-6f); const int t = n * 64 + cg_ * 4 + i;
    const f32x4 gr = *(const f32x4*)(H32 + (size_t)t * EV_LD + EV_GR + h * 128 + lg * 4);
    const f32x4 o = acc[i] * r * ng;
    *(u32x2*)(CAT + (size_t)t * EVEN_OUT + h * 128 + lg * 4) = (u32x2){pack2(o[0] * siluf_(gr[0]), o[1] * siluf_(gr[1])), pack2(o[2] * siluf_(gr[2]), o[3] * siluf_(gr[3]))};
  }
  __syncthreads();
}

__device__ __forceinline__ void moba_kmean_item(const Params& p, int h, int blk, char* smem) {
  const bf16_t* MK = (const bf16_t*)(p.ws + OFF_MK); float* KM = (float*)(p.ws + OFF_KMEAN); float* PART = (float*)smem;
  const int tid = tid_(), d = tid & 127, part = tid >> 7; float s = 0.f;
#pragma unroll 16
  for (int k = 0; k < 64; ++k) s += bf2f(MK[(size_t)(blk * 256 + part * 64 + k) * MQ_LD + h * 128 + d]);
  PART[tid] = s; __syncthreads();
  if (tid < 128) KM[(size_t)(h * NBLK + blk) * 128 + tid] = (PART[tid] + PART[128 + tid] + PART[256 + tid] + PART[384 + tid]) * (1.f / 256.f);
  __syncthreads();
}
struct Top3 { float v0, v1, v2; int i0, i1, i2; };
__device__ __forceinline__ bool top_better(float v, int i, float w, int j) { return v > w || (v == w && i < j); }
__device__ __forceinline__ Top3 top_ins(Top3 t, float v, int i) {
  const bool b0 = top_better(v, i, t.v0, t.i0), b1 = top_better(v, i, t.v1, t.i1), b2 = top_better(v, i, t.v2, t.i2);
  Top3 r;
  r.v2 = b1 ? t.v1 : (b2 ? v : t.v2); r.i2 = b1 ? t.i1 : (b2 ? i : t.i2);
  r.v1 = b0 ? t.v0 : (b1 ? v : t.v1); r.i1 = b0 ? t.i0 : (b1 ? i : t.i1);
  r.v0 = b0 ? v : t.v0; r.i0 = b0 ? i : t.i0;
  return r;
}
template <bool GATH> __device__ __forceinline__ void moba_tile(const Params& p, int h, int arg0, int arg1, int arg2, char* smem) {
  constexpr int PB = 272;
  constexpr float NEG = -1e30f;
  const bf16_t* MQ = (const bf16_t*)(p.ws + OFF_MQ); const bf16_t* MK = (const bf16_t*)(p.ws + OFF_MK); const bf16_t* MVT = (const bf16_t*)(p.ws + OFF_MVT);
  const float* KM = (const float*)(p.ws + OFF_KMEAN); unsigned* MCNT = (unsigned*)(p.ws + OFF_MCNT); unsigned* MLIST = (unsigned*)(p.ws + OFF_MLIST);
  bf16_t* PO = (bf16_t*)(p.ws + OFF_PO); f32x2* PML = (f32x2*)(p.ws + OFF_PML);
  char* Qs = smem; char* Ks = Qs + 64 * PB; char* VTs = Ks + 128 * PB; int* ROWT = (int*)(VTs + 128 * PB); int* ROWS = ROWT + 64;
  float* MRG = (float*)Ks;
  const int tid = tid_(), w = tid >> 6, lane = tid & 63, fr = lane & 15, fq = lane >> 4, wq = w & 3, wh = w >> 2;
  const int t0 = GATH ? 0 : arg0 * 64, own = t0 >> 8;
  const float slope = exp2f(-8.f * (float)(h + 1) / (float)MOBA_H), scale = 0.08838834764831845f;
  const int kbase = GATH ? arg0 * 256 : own * 256;
  unsigned ent = 0u; const bool rv = GATH ? (arg1 + tid < arg2) : true;
  if (GATH && tid < 64) ent = MLIST[(size_t)(h * NBLK + arg0) * SEQ + (rv ? arg1 + tid : arg1)];
  u32x4 kreg[4], vreg[4];
  { const int key0 = kbase;
#pragma unroll
    for (int i = 0; i < 4; ++i) { const int e = tid + 512 * i, r = e >> 4, c = e & 15;
      kreg[i] = *(const u32x4*)(MK + (size_t)(key0 + r) * MQ_LD + h * 128 + c * 8); vreg[i] = *(const u32x4*)(MVT + (size_t)(h * 128 + r) * SEQ + key0 + c * 8); } }
  if (tid < 64) {
    if (GATH) { ROWT[tid] = (int)(ent >> 2); ROWS[tid] = rv ? (int)(ent & 3u) : -1; }
    else { ROWT[tid] = t0 + tid; ROWS[tid] = 3; } }
  lds_barrier();
  for (int e = tid; e < 64 * 16; e += 512) { const int r = e >> 4, c = e & 15; *(u32x4*)(Qs + r * PB + c * 16) = *(const u32x4*)(MQ + (size_t)ROWT[r] * MQ_LD + h * 128 + c * 8); }
  lds_barrier();
  if (!GATH) {
    float* KMs = (float*)Ks;
    for (int e = tid; e < own * 32; e += 512) *(f32x4*)(KMs + e * 4) = *(const f32x4*)(KM + (size_t)h * NBLK * 128 + e * 4);
    __syncthreads();
    const int q = tid >> 3, part = tid & 7; Top3 tp; tp.v0 = tp.v1 = tp.v2 = -INFINITY; tp.i0 = tp.i1 = tp.i2 = 1 << 20;
    for (int nb_ = part; nb_ < own; nb_ += 8) { const float* km = KMs + nb_ * 128; float s = 0.f;
#pragma unroll 2
      for (int c = 0; c < 16; ++c) { const u32x4 qq = *(const u32x4*)(Qs + q * PB + c * 16); const f32x4 ka = *(const f32x4*)(km + c * 8), kb = *(const f32x4*)(km + c * 8 + 4);
        s += __uint_as_float(qq[0] << 16) * ka[0] + __uint_as_float(qq[0] & 0xffff0000u) * ka[1] + __uint_as_float(qq[1] << 16) * ka[2] + __uint_as_float(qq[1] & 0xffff0000u) * ka[3]
           + __uint_as_float(qq[2] << 16) * kb[0] + __uint_as_float(qq[2] & 0xffff0000u) * kb[1] + __uint_as_float(qq[3] << 16) * kb[2] + __uint_as_float(qq[3] & 0xffff0000u) * kb[3]; }
      tp = top_ins(tp, s, nb_); }
#pragma unroll
    for (int m = 1; m < 8; m <<= 1) { const float a0 = __shfl_xor(tp.v0, m), a1 = __shfl_xor(tp.v1, m), a2 = __shfl_xor(tp.v2, m); const int b0 = __shfl_xor(tp.i0, m), b1 = __shfl_xor(tp.i1, m), b2 = __shfl_xor(tp.i2, m);
      tp = top_ins(tp, a0, b0); tp = top_ins(tp, a1, b1); tp = top_ins(tp, a2, b2); }
    unsigned* CL = (unsigned*)(ROWS + 64); unsigned* BASE = CL + 32;
    if (tid < 32) CL[tid] = 0u;
    __syncthreads();
    unsigned l0 = 0, l1 = 0, l2 = 0;
    if (part == 0) { if (tp.i0 < 32) l0 = atomicAdd(CL + tp.i0, 1u); if (tp.i1 < 32) l1 = atomicAdd(CL + tp.i1, 1u); if (tp.i2 < 32) l2 = atomicAdd(CL + tp.i2, 1u); }
    __syncthreads();
    if (tid < own && CL[tid] > 0u) BASE[tid] = atomicAdd(MCNT + h * NBLK + tid, CL[tid]);
    __syncthreads();
    if (part == 0) { const unsigned tt = (unsigned)(t0 + q);
      if (tp.i0 < 32) MLIST[(size_t)(h * NBLK + tp.i0) * SEQ + BASE[tp.i0] + l0] = (tt << 2) | 0u;
      if (tp.i1 < 32) MLIST[(size_t)(h * NBLK + tp.i1) * SEQ + BASE[tp.i1] + l1] = (tt << 2) | 1u;
      if (tp.i2 < 32) MLIST[(size_t)(h * NBLK + tp.i2) * SEQ + BASE[tp.i2] + l2] = (tt << 2) | 2u; }
  }
  bf16x8 qf[4];
#pragma unroll
  for (int kk = 0; kk < 4; ++kk) qf[kk] = *(const bf16x8*)(Qs + (wq * 16 + fr) * PB + kk * 64 + fq * 16);
  f32x4 oacc[8];
#pragma unroll
  for (int i = 0; i < 8; ++i) oacc[i] = f4zero();
  float mrow = NEG, lrow = 0.f;
  const int tq = ROWT[wq * 16 + fr], slot = ROWS[wq * 16 + fr];
  const int ntile = GATH ? 2 : ((own * 256 + 128 <= t0 + 63) ? 2 : 1);
#pragma unroll 1
  for (int ti = 0; ti < ntile; ++ti) {
    {
      const int key0 = kbase + ti * 128;
      lds_barrier();
#pragma unroll
      for (int i = 0; i < 4; ++i) { const int e = tid + 512 * i, r = e >> 4, c = e & 15; *(u32x4*)(Ks + r * PB + c * 16) = kreg[i]; *(u32x4*)(VTs + r * PB + c * 16) = vreg[i]; }
      if (ti + 1 < ntile) { const int key1 = key0 + 128;
#pragma unroll
        for (int i = 0; i < 4; ++i) { const int e = tid + 512 * i, r = e >> 4, c = e & 15;
          kreg[i] = *(const u32x4*)(MK + (size_t)(key1 + r) * MQ_LD + h * 128 + c * 8); vreg[i] = *(const u32x4*)(MVT + (size_t)(h * 128 + r) * SEQ + key1 + c * 8); } }
      lds_barrier();
      const int kb = wh * 64;
      f32x4 sacc[4];
#pragma unroll
      for (int nt = 0; nt < 4; ++nt) { sacc[nt] = f4zero();
#pragma unroll
        for (int kk = 0; kk < 4; ++kk) { const bf16x8 kf = *(const bf16x8*)(Ks + (kb + nt * 16 + fr) * PB + kk * 64 + fq * 16); sacc[nt] = __builtin_amdgcn_mfma_f32_16x16x32_bf16(kf, qf[kk], sacc[nt], 0, 0, 0); } }
      float mx = NEG;
#pragma unroll
      for (int nt = 0; nt < 4; ++nt)
#pragma unroll
        for (int jj = 0; jj < 4; ++jj) { const int tk = key0 + kb + nt * 16 + fq * 4 + jj; float s = sacc[nt][jj] * scale - slope * (float)(tq - tk);
          const bool ok = GATH ? true : (tk <= tq); s = ok ? s : NEG; sacc[nt][jj] = s; mx = fmaxf(mx, s); }
      mx = fmaxf(mx, __shfl_xor(mx, 16)); mx = fmaxf(mx, __shfl_xor(mx, 32));
      const float mnew = fmaxf(mrow, mx), alpha = __expf(mrow - mnew); mrow = mnew;
      float ps = 0.f;
#pragma unroll
      for (int nt = 0; nt < 4; ++nt)
#pragma unroll
        for (int jj = 0; jj < 4; ++jj) { const float pv = __expf(sacc[nt][jj] - mnew); sacc[nt][jj] = pv; ps += pv; }
      lrow = lrow * alpha + ps;
#pragma unroll
      for (int i = 0; i < 8; ++i) oacc[i] *= alpha;
#pragma unroll
      for (int k2 = 0; k2 < 2; ++k2) {
        u32x4 pk; pk[0] = pack2(sacc[2 * k2][0], sacc[2 * k2][1]); pk[1] = pack2(sacc[2 * k2][2], sacc[2 * k2][3]); pk[2] = pack2(sacc[2 * k2 + 1][0], sacc[2 * k2 + 1][1]); pk[3] = pack2(sacc[2 * k2 + 1][2], sacc[2 * k2 + 1][3]);
        bf16x8 pb; __builtin_memcpy(&pb, &pk, 16);
#pragma unroll
        for (int dt = 0; dt < 8; ++dt) {
          const char* vr = VTs + (dt * 16 + fr) * PB + (kb + 32 * k2 + fq * 4) * 2;
          const u32x2 lo = *(const u32x2*)vr, hi = *(const u32x2*)(vr + 32);
          u32x4 vv; vv[0] = lo[0]; vv[1] = lo[1]; vv[2] = hi[0]; vv[3] = hi[1]; bf16x8 vf; __builtin_memcpy(&vf, &vv, 16);
          oacc[dt] = __builtin_amdgcn_mfma_f32_16x16x32_bf16(vf, pb, oacc[dt], 0, 0, 0);
        }
      }
    }
  }
  lrow += __shfl_xor(lrow, 16); lrow += __shfl_xor(lrow, 32);
  __syncthreads();
  if (wh == 1) { float* mg = MRG + (size_t)wq * 34 * 64;
#pragma unroll
    for (int dt = 0; dt < 8; ++dt)
#pragma unroll
      for (int jj = 0; jj < 4; ++jj) mg[(dt * 4 + jj) * 64 + lane] = oacc[dt][jj];
    mg[32 * 64 + lane] = mrow; mg[33 * 64 + lane] = lrow; }
  __syncthreads();
  if (wh == 0 && slot >= 0) { const float* mg = MRG + (size_t)wq * 34 * 64; const float m2 = mg[32 * 64 + lane], l2 = mg[33 * 64 + lane];
    const float ms = fmaxf(mrow, m2), f1 = __expf(mrow - ms), f2 = __expf(m2 - ms); const float lt = lrow * f1 + l2 * f2, inv = 1.f / lt;
    const size_t pi = ((size_t)h * SEQ + tq) * 4 + slot;
#pragma unroll
    for (int dt = 0; dt < 8; ++dt) { f32x4 o;
#pragma unroll
      for (int jj = 0; jj < 4; ++jj) o[jj] = (oacc[dt][jj] * f1 + mg[(dt * 4 + jj) * 64 + lane] * f2) * inv;
      *(u32x2*)(PO + pi * 128 + dt * 16 + fq * 4) = (u32x2){pack2(o[0], o[1]), pack2(o[2], o[3])}; }
    if (fq == 0) PML[pi] = (f32x2){ms, lt}; }
  __syncthreads();
}
__device__ __forceinline__ void moba_gathered(const Params& p, char* smem, int bid, int nb) {
  const unsigned* MCNT = (const unsigned*)(p.ws + OFF_MCNT);
  int* PC = (int*)(smem + 120 * 1024); int* PF = PC + 256;
  const int tid = tid_();
  if (tid < 256) PC[tid] = (tid < MOBA_H * NBLK) ? (int)((MCNT[tid] + 63u) >> 6) : 0;
  __syncthreads();
  if (tid < 256) { int sum = 0; for (int k = 0; k < tid; ++k) sum += PC[k]; PF[tid] = sum; }
  __syncthreads();
  const int total = PF[255] + PC[255];
  const int vb = ((nb & 7) == 0) ? (bid & 7) * (nb >> 3) + (bid >> 3) : bid;
  for (int g = vb; g < total; g += nb) {
    int lo = 0, hi = 256;
    while (hi - lo > 1) { const int mid = (lo + hi) >> 1; if (PF[mid] <= g) lo = mid; else hi = mid; }
    moba_tile<true>(p, lo / NBLK, lo % NBLK, (g - PF[lo]) * 64, (int)MCNT[lo], smem);
  }
}
__device__ __forceinline__ void moba_combine(const Params& p, int bid, int nb) {
  const bf16_t* PO = (const bf16_t*)(p.ws + OFF_PO); const f32x2* PML = (const f32x2*)(p.ws + OFF_PML); bf16_t* CAT = (bf16_t*)(p.ws + OFF_CAT);
  const int grp = tid_() >> 5, l = tid_() & 31;
  for (int it = bid * 16 + grp; it < SEQ * MOBA_H; it += nb * 16) {
    const int t = it / MOBA_H, h = it % MOBA_H, own = t >> 8, nv = own < 3 ? own : 3; const size_t pi = ((size_t)h * SEQ + t) * 4;
    f32x2 ml[4]; f32x4 po[4];
    auto ldp = [&](size_t q) { const u32x2 r = *(const u32x2*)(PO + q * 128 + l * 4); return (f32x4){__uint_as_float(r[0] << 16), __uint_as_float(r[0] & 0xffff0000u), __uint_as_float(r[1] << 16), __uint_as_float(r[1] & 0xffff0000u)}; };
    ml[3] = PML[pi + 3]; po[3] = ldp(pi + 3);
#pragma unroll
    for (int k = 0; k < 3; ++k) { if (k < nv) { ml[k] = PML[pi + k]; po[k] = ldp(pi + k); } else { ml[k] = (f32x2){-1e30f, 0.f}; po[k] = f4zero(); } }
    float mm = fmaxf(fmaxf(ml[0][0], ml[1][0]), fmaxf(ml[2][0], ml[3][0]));
    float wsum = 0.f; f32x4 acc = f4zero();
#pragma unroll
    for (int k = 0; k < 4; ++k) { const float wk = ml[k][1] * __expf(ml[k][0] - mm); wsum += wk; acc += po[k] * wk; }
    const float inv = 1.f / wsum;
    *(u32x2*)(CAT + (size_t)t * EVEN_OUT + GLA_H * 128 + h * 128 + l * 4) = (u32x2){pack2(acc[0] * inv, acc[1] * inv), pack2(acc[2] * inv, acc[3] * inv)};
  }
}

__device__ __forceinline__ void gdn_local_item(const Params& p, int j, int h, int n, char* smem) {
  constexpr int SP_ = 260, KP = 132;
  const float* H32 = (const float*)(p.ws + OFF_H32);
  float* SOL = (float*)smem; float* KS = SOL + 64 * SP_; float* LM = KS + 64 * KP; float* BETA = LM + 2 * 64 * 36;   float* GG = BETA + 64; float* GC = GG + 64;
  const size_t base = (size_t)(h * NCH + n);
  float* Ug = (float*)(p.ws + OFF_GU) + base * 8192; bf16_t* Wg = (bf16_t*)(p.ws + OFF_GW) + base * 8192; bf16_t* QDg = (bf16_t*)(p.ws + OFF_GQD) + base * 8192; bf16_t* KDg = (bf16_t*)(p.ws + OFF_GKD) + base * 8192;
  bf16_t* ATg = (bf16_t*)(p.ws + OFF_ATT) + base * 4096; float* EGL = (float*)(p.ws + OFF_EGL);
  const int tid = tid_(), t0 = n * 64;
  { const int cs = tid & 31, rg = tid >> 5, c4 = cs * 4; const float* cwb = p.gdn_conv_w + (size_t)j * 4 * (3 * GDN_H * 128);
#pragma unroll
    for (int part = 0; part < 3; ++part) { const int col = part * GDN_H * 128 + h * 128 + c4; f32x4 wv[4], xv[7];
#pragma unroll
      for (int jj = 0; jj < 4; ++jj) wv[jj] = *(const f32x4*)(cwb + (size_t)jj * (3 * GDN_H * 128) + col);
#pragma unroll
      for (int r = 0; r < 7; ++r) { const int t = t0 + rg * 4 - 3 + r; xv[r] = (t >= 0) ? *(const f32x4*)(H32 + (size_t)t * OD_LD + OD_QKV + col) : f4zero(); }
#pragma unroll
      for (int i = 0; i < 4; ++i) { f32x4 o = wv[0] * xv[i] + wv[1] * xv[i + 1] + wv[2] * xv[i + 2] + wv[3] * xv[i + 3];
        o[0] = siluf_(o[0]); o[1] = siluf_(o[1]); o[2] = siluf_(o[2]); o[3] = siluf_(o[3]);
        float* dst = (part == 0) ? (SOL + (rg * 4 + i) * SP_ + 128 + c4) : (part == 1) ? (KS + (rg * 4 + i) * KP + c4) : (SOL + (rg * 4 + i) * SP_ + c4);
        *(f32x4*)dst = o; } } }
  if (tid < 64) { const int t = t0 + tid; BETA[tid] = sigmoidf_(H32[(size_t)t * OD_LD + OD_BETA + h]);
    GG[tid] = -expf(p.gdn_a_log[j * GDN_H + h]) * softplusf_(H32[(size_t)t * OD_LD + OD_DEC + h] + p.gdn_dt_bias[j * GDN_H + h]); }
  __syncthreads();
  const int row = tid >> 3, seg = tid & 7;
  { float* qp = SOL + row * SP_ + 128 + seg * 16; float* kp = KS + row * KP + seg * 16; float sq = 0.f, sk = 0.f;
#pragma unroll
    for (int c = 0; c < 16; ++c) { sq += qp[c] * qp[c]; sk += kp[c] * kp[c]; }
    sq += __shfl_xor(sq, 1); sk += __shfl_xor(sk, 1); sq += __shfl_xor(sq, 2); sk += __shfl_xor(sk, 2); sq += __shfl_xor(sq, 4); sk += __shfl_xor(sk, 4);
    const float rq = rsqrtf(sq + 1e-6f) * 0.08838834764831845f, rk = rsqrtf(sk + 1e-6f);
#pragma unroll
    for (int c = 0; c < 16; ++c) { qp[c] *= rq; kp[c] *= rk; }
    char* Kb = (char*)LM; char* Qb = smem + 122880;
#pragma unroll
    for (int c = 0; c < 16; c += 8) { *(u32x4*)(Kb + row * 272 + (seg * 16 + c) * 2) = (u32x4){pack2(kp[c], kp[c + 1]), pack2(kp[c + 2], kp[c + 3]), pack2(kp[c + 4], kp[c + 5]), pack2(kp[c + 6], kp[c + 7])};
      *(u32x4*)(Qb + row * 272 + (seg * 16 + c) * 2) = (u32x4){pack2(qp[c], qp[c + 1]), pack2(qp[c + 2], qp[c + 3]), pack2(qp[c + 4], qp[c + 5]), pack2(qp[c + 6], qp[c + 7])}; } }
  if (tid == 0) { float c = 0.f;
#pragma unroll 16
    for (int t = 0; t < 64; ++t) { c += GG[t]; GC[t] = c; } }
  __syncthreads();
  {
    const char* Kb = (const char*)LM; const char* Qb = smem + 122880;
    const int w = tid >> 6, lane = tid & 63, fr = lane & 15, fq = lane >> 4, it = w >> 1, jt0 = 2 * (w & 1);
    f32x4 aL[2] = {f4zero(), f4zero()}, aA[2] = {f4zero(), f4zero()};
#pragma unroll
    for (int kk = 0; kk < 4; ++kk) {
      const bf16x8 ki = *(const bf16x8*)(Kb + (it * 16 + fr) * 272 + kk * 64 + fq * 16), qi = *(const bf16x8*)(Qb + (it * 16 + fr) * 272 + kk * 64 + fq * 16);
#pragma unroll
      for (int jj = 0; jj < 2; ++jj) { const bf16x8 kj = *(const bf16x8*)(Kb + ((jt0 + jj) * 16 + fr) * 272 + kk * 64 + fq * 16);
        aL[jj] = __builtin_amdgcn_mfma_f32_16x16x32_bf16(ki, kj, aL[jj], 0, 0, 0); aA[jj] = __builtin_amdgcn_mfma_f32_16x16x32_bf16(qi, kj, aA[jj], 0, 0, 0); } }
    __syncthreads();
#pragma unroll
    for (int jj = 0; jj < 2; ++jj)
#pragma unroll
      for (int r = 0; r < 4; ++r) { const int ii = it * 16 + fq * 4 + r, jx = (jt0 + jj) * 16 + fr; const float dec = (ii >= jx) ? __expf(GC[ii] - GC[jx]) : 0.f;
        LM[(jx & 1) * (64 * 36) + ii * 36 + (jx >> 1)] = (ii > jx) ? BETA[ii] * aL[jj][r] * dec : 0.f; ATg[ii * 64 + jx] = f2bf(aA[jj][r] * dec); } }
  { const float eg = __expf(GC[row]), ek = __expf(GC[63] - GC[row]); const float* qp = SOL + row * SP_ + 128 + seg * 16; const float* kp = KS + row * KP + seg * 16;
#pragma unroll
    for (int c = 0; c < 16; c += 4) { const f32x4 q = *(const f32x4*)(qp + c), k = *(const f32x4*)(kp + c); { const f32x4 qq = q * eg; *(u32x2*)(QDg + row * 128 + seg * 16 + c) = (u32x2){pack2(qq[0], qq[1]), pack2(qq[2], qq[3])}; }
#pragma unroll
      for (int e = 0; e < 4; ++e) KDg[(seg * 16 + c + e) * 64 + row] = f2bf(k[e] * ek); } }
  __syncthreads();
  { const float bt = BETA[row], be = bt * __expf(GC[row]); float* vp = SOL + row * SP_ + seg * 16; float* wp = SOL + row * SP_ + 128 + seg * 16; const float* kp = KS + row * KP + seg * 16;
#pragma unroll
    for (int c = 0; c < 16; ++c) { vp[c] *= bt; wp[c] = kp[c] * be; } }
  __syncthreads();
  { const int col = tid >> 1, half = tid & 1; const float* lmh = LM + half * (64 * 36);
    float x[32];
#pragma unroll
    for (int k = 0; k < 32; ++k) x[k] = 0.f;
#pragma unroll
    for (int i = 0; i < 64; ++i) {
      const float rhs = SOL[i * SP_ + col]; float part = 0.f;
#pragma unroll
      for (int k4 = 0; k4 < (i + 1) / 2; k4 += 4) { const f32x4 l4 = *(const f32x4*)(lmh + i * 36 + k4);
#pragma unroll
        for (int e = 0; e < 4; ++e) if (k4 + e < (i + 1) / 2) part += l4[e] * x[k4 + e]; }
      const float nv = rhs - (part + dpp_mov<0xB1>(part));
      x[i >> 1] = ((i & 1) == half) ? nv : x[i >> 1];
      if (i > 0) SOL[i * SP_ + col] = nv;
    } }
  __syncthreads();
#pragma unroll
  for (int c = 0; c < 16; c += 4) { const f32x4 uu = *(const f32x4*)(SOL + row * SP_ + seg * 16 + c);
#pragma unroll
    for (int e = 0; e < 4; ++e) Ug[(seg * 16 + c + e) * 64 + row] = uu[e];
    { const f32x4 ww = *(const f32x4*)(SOL + row * SP_ + 128 + seg * 16 + c); *(u32x2*)(Wg + row * 128 + seg * 16 + c) = (u32x2){pack2(ww[0], ww[1]), pack2(ww[2], ww[3])}; } }
  if (tid == 0) EGL[base] = __expf(GC[63]);
  __syncthreads();
}
struct GdnMRegs { bf16x8 a12[4], a4[2]; f32x4 x[2]; float egl; };
__device__ __forceinline__ void gdn_mload(GdnMRegs& r, const char* ws, int h, int n, int w, int fr, int fq, int j0) {
  const size_t base = (size_t)(h * NCH + n);
  const float* UTn = (const float*)(ws + OFF_GU) + base * 8192; const bf16_t* Wn = (const bf16_t*)(ws + OFF_GW) + base * 8192; const bf16_t* QDn = (const bf16_t*)(ws + OFF_GQD) + base * 8192;
  const bf16_t* KDTn = (const bf16_t*)(ws + OFF_GKD) + base * 8192; const bf16_t* ATn = (const bf16_t*)(ws + OFF_ATT) + base * 4096;
  const bf16_t* a12p = ((w < 4) ? Wn : QDn) + (16 * (w & 3) + fr) * 128 + fq * 8;
#pragma unroll
  for (int kk = 0; kk < 4; ++kk) r.a12[kk] = *(const bf16x8*)(a12p + kk * 32);
  const bf16_t* a4p = KDTn + (16 * w + fr) * 64 + fq * 8;
#pragma unroll
  for (int kk = 0; kk < 2; ++kk) r.a4[kk] = *(const bf16x8*)(a4p + kk * 32);
  const char* xp = (w < 4) ? (const char*)(UTn + (j0 + fr) * 64 + 16 * w + fq * 4) : (const char*)(ATn + (16 * (w - 4) + fr) * 64 + fq * 8); const int xs = (w < 4) ? 16 * 64 * 4 : 64;
#pragma unroll
  for (int i = 0; i < 2; ++i) r.x[i] = *(const f32x4*)(xp + i * xs);
  r.egl = ((const float*)(ws + OFF_EGL))[base];
}
constexpr int GS_SP = 272, GS_VP = 144;
__device__ __forceinline__ void gdn_mstep(const GdnMRegs& cur, f32x4 (&sacc)[2], char* ST, char* VT, float* O32, int n, int h, int j0, int w, int fr, int fq) {
  f32x4 acc[2] = {f4zero(), f4zero()};
#pragma unroll
  for (int kk = 0; kk < 4; ++kk) { const bf16x8 af = cur.a12[kk];
#pragma unroll
    for (int jt = 0; jt < 2; ++jt) { const bf16x8 bfr = *(const bf16x8*)(ST + (jt * 16 + fr) * GS_SP + (kk * 32 + fq * 8) * 2); acc[jt] = __builtin_amdgcn_mfma_f32_16x16x32_bf16(af, bfr, acc[jt], 0, 0, 0); } }
  if (w < 4) {
#pragma unroll
    for (int jt = 0; jt < 2; ++jt) { const f32x4 vn = cur.x[jt] - acc[jt]; *(u32x2*)(VT + (jt * 16 + fr) * GS_VP + (16 * w + fq * 4) * 2) = (u32x2){pack2(vn[0], vn[1]), pack2(vn[2], vn[3])}; } }
  lds_barrier();
  bf16x8 vf[2][2];
#pragma unroll
  for (int kk = 0; kk < 2; ++kk)
#pragma unroll
    for (int jt = 0; jt < 2; ++jt) vf[kk][jt] = *(const bf16x8*)(VT + (jt * 16 + fr) * GS_VP + (kk * 32 + fq * 8) * 2);
  if (w >= 4) {
#pragma unroll
    for (int kk = 0; kk < 2; ++kk) { bf16x8 af; __builtin_memcpy(&af, &cur.x[kk], 16);
#pragma unroll
      for (int jt = 0; jt < 2; ++jt) acc[jt] = __builtin_amdgcn_mfma_f32_16x16x32_bf16(af, vf[kk][jt], acc[jt], 0, 0, 0); }
#pragma unroll
    for (int jt = 0; jt < 2; ++jt)
#pragma unroll
      for (int r = 0; r < 4; ++r) O32[(size_t)(n * 64 + 16 * (w - 4) + fq * 4 + r) * (GDN_H * 128) + h * 128 + j0 + jt * 16 + fr] = acc[jt][r];
  }
#pragma unroll
  for (int jt = 0; jt < 2; ++jt) sacc[jt] *= cur.egl;
#pragma unroll
  for (int kk = 0; kk < 2; ++kk) { const bf16x8 af = cur.a4[kk];
#pragma unroll
    for (int jt = 0; jt < 2; ++jt) sacc[jt] = __builtin_amdgcn_mfma_f32_16x16x32_bf16(af, vf[kk][jt], sacc[jt], 0, 0, 0); }
#pragma unroll
  for (int jt = 0; jt < 2; ++jt) *(u32x2*)(ST + (jt * 16 + fr) * GS_SP + (16 * w + fq * 4) * 2) = (u32x2){pack2(sacc[jt][0], sacc[jt][1]), pack2(sacc[jt][2], sacc[jt][3])};
  lds_barrier();
}
__device__ __forceinline__ void gdn_scan_item(const Params& p, int h, int sl, char* smem) {
  char* ST = smem; char* VT = ST + 32 * GS_SP;
  float* O32 = (float*)(p.ws + OFF_O32);
  const int tid = tid_(), w = tid >> 6, lane = tid & 63, fr = lane & 15, fq = lane >> 4, j0 = sl * 32;
  { float z = 0.f; LAUNDER_V(z); for (int e = tid; e < 32 * GS_SP / 4; e += 512) ((float*)ST)[e] = z; }
  f32x4 sacc[2] = {f4zero(), f4zero()};
  GdnMRegs a0, a1, b0, b1;
  gdn_mload(a0, p.ws, h, 0, w, fr, fq, j0); gdn_mload(a1, p.ws, h, 1, w, fr, fq, j0);
  lds_barrier();
#pragma unroll 1
  for (int n = 0; n < NCH; n += 4) {
    DRAIN_VM();
    gdn_mload(b0, p.ws, h, n + 2, w, fr, fq, j0); gdn_mload(b1, p.ws, h, n + 3, w, fr, fq, j0);
    gdn_mstep(a0, sacc, ST, VT, O32, n, h, j0, w, fr, fq);
    gdn_mstep(a1, sacc, ST, VT, O32, n + 1, h, j0, w, fr, fq);
    DRAIN_VM();
    { const int m0 = (n + 4 < NCH) ? n + 4 : n, m1 = (n + 5 < NCH) ? n + 5 : n + 1;
      gdn_mload(a0, p.ws, h, m0, w, fr, fq, j0); gdn_mload(a1, p.ws, h, m1, w, fr, fq, j0); }
    gdn_mstep(b0, sacc, ST, VT, O32, n + 2, h, j0, w, fr, fq);
    gdn_mstep(b1, sacc, ST, VT, O32, n + 3, h, j0, w, fr, fq);
  }
}
__device__ __forceinline__ void gdn_final(const Params& p, int j, int bid, int nb) {
  const float* H32 = (const float*)(p.ws + OFF_H32); const float* O32 = (const float*)(p.ws + OFF_O32); bf16_t* CAT = (bf16_t*)(p.ws + OFF_CAT);
  const int grp = tid_() >> 5, l = tid_() & 31;
  const f32x4 ng = *(const f32x4*)(p.gdn_norm_g + (size_t)j * 128 + l * 4);
  for (int it = bid * 16 + grp; it < SEQ * GDN_H; it += nb * 16) {
    const int t = it / GDN_H, h = it % GDN_H;
    const f32x4 o = *(const f32x4*)(O32 + (size_t)t * (GDN_H * 128) + h * 128 + l * 4), z = *(const f32x4*)(H32 + (size_t)t * OD_LD + OD_Z + h * 128 + l * 4);
    float ss = o[0] * o[0] + o[1] * o[1] + o[2] * o[2] + o[3] * o[3];
    ss += __shfl_xor(ss, 1); ss += __shfl_xor(ss, 2); ss += __shfl_xor(ss, 4); ss += __shfl_xor(ss, 8); ss += __shfl_xor(ss, 16);
    const float r = rsqrtf(ss * (1.f / 128.f) + 1e-6f); const f32x4 v = o * r * ng;
    *(u32x2*)(CAT + (size_t)t * ODD_OUT + h * 128 + l * 4) = (u32x2){pack2(v[0] * siluf_(z[0]), v[1] * siluf_(z[1])), pack2(v[2] * siluf_(z[2]), v[3] * siluf_(z[3]))};
  }
}

template <bool OUT> __device__ __forceinline__ void s5_item(const Params& p, int j, int g, int oct, char* smem) {
  constexpr int XP = 68;
  const float* H32 = (const float*)(p.ws + OFF_H32); const float* C = (const float*)(p.ws + OFF_S5C + j * SZ_S5C1); f32x2* XEND = (f32x2*)(p.ws + OFF_XEND); bf16_t* YS = (bf16_t*)(p.ws + OFF_YS);
  float* XR = (float*)smem; float* XI = XR + 8 * 16 * XP; float* US = XI + 8 * 16 * XP;
  const int tid = tid_(), w = tid >> 6, lane = tid & 63, n = oct * 8 + w, gp = g * S5_P + lane, fr = lane & 15, fq = lane >> 4;
  { const float* up = H32 + (size_t)(n * 64 + lane) * OD_LD + OD_U + g * 16; float* ud = US + (w * 64 + lane) * 16;
#pragma unroll
    for (int c = 0; c < 16; c += 4) *(f32x4*)(ud + c) = *(const f32x4*)(up + c); }
  bf16x8 cf[4];
  if (OUT) {
#pragma unroll
    for (int kk = 0; kk < 4; ++kk) { const float* cp = ((kk < 2) ? p.s5_c_re : p.s5_c_im) + (((size_t)j * S5_G + g) * 16 + fr) * 64 + (kk & 1) * 32 + fq * 8;
      const f32x4 c0 = *(const f32x4*)cp, c1 = *(const f32x4*)(cp + 4); const float sg = (kk < 2) ? 1.f : -1.f;
      u32x4 pk; pk[0] = pack2(sg * c0[0], sg * c0[1]); pk[1] = pack2(sg * c0[2], sg * c0[3]); pk[2] = pack2(sg * c1[0], sg * c1[1]); pk[3] = pack2(sg * c1[2], sg * c1[3]); __builtin_memcpy(&cf[kk], &pk, 16); } }
  const float ar = C[gp], ai = C[S5_G * S5_P + gp];
  float bbr[16], bbi[16];
#pragma unroll
  for (int c = 0; c < 16; c += 4) { const f32x4 a = *(const f32x4*)(C + 4 * S5_G * S5_P + (size_t)gp * 16 + c), b = *(const f32x4*)(C + 20 * S5_G * S5_P + (size_t)gp * 16 + c);
    bbr[c] = a[0]; bbr[c + 1] = a[1]; bbr[c + 2] = a[2]; bbr[c + 3] = a[3]; bbi[c] = b[0]; bbi[c + 1] = b[1]; bbi[c + 2] = b[2]; bbi[c + 3] = b[3]; }
  float xr = 0.f, xi = 0.f;
  if (OUT) { const float a64r = C[2 * S5_G * S5_P + gp], a64i = C[3 * S5_G * S5_P + gp];
#pragma unroll 1
    for (int m0 = 0; m0 < n; m0 += 16) { f32x2 xe[16];
#pragma unroll
      for (int k = 0; k < 16; ++k) xe[k] = XEND[(size_t)(((m0 + k < n) ? m0 + k : 0) * S5_G + g) * S5_P + lane];
#pragma unroll
      for (int k = 0; k < 16; ++k) if (m0 + k < n) { const float nr = a64r * xr - a64i * xi + xe[k][0], ni = a64r * xi + a64i * xr + xe[k][1]; xr = nr; xi = ni; } } }
  __syncthreads();
#pragma unroll 1
  for (int slab = 0; slab < 4; ++slab) {
#pragma unroll 2
    for (int tt = 0; tt < 16; ++tt) {
      const float* up = US + (w * 64 + slab * 16 + tt) * 16; float br = 0.f, bi = 0.f;
#pragma unroll
      for (int c = 0; c < 16; c += 4) { const f32x4 u4 = *(const f32x4*)(up + c);
#pragma unroll
        for (int e = 0; e < 4; ++e) { br += bbr[c + e] * u4[e]; bi += bbi[c + e] * u4[e]; } }
      const float nr = ar * xr - ai * xi + br, ni = ar * xi + ai * xr + bi; xr = nr; xi = ni;
      if (OUT) { XR[(w * 16 + tt) * XP + lane] = xr; XI[(w * 16 + tt) * XP + lane] = xi; }
    }
    if (OUT) {
      __syncthreads();
      f32x4 y = f4zero();
#pragma unroll
      for (int kk = 0; kk < 4; ++kk) { const float* xp = ((kk < 2) ? XR : XI) + (w * 16 + fr) * XP + (kk & 1) * 32 + fq * 8;
        const f32x4 x0 = *(const f32x4*)xp, x1 = *(const f32x4*)(xp + 4);
        u32x4 pk; pk[0] = pack2(x0[0], x0[1]); pk[1] = pack2(x0[2], x0[3]); pk[2] = pack2(x1[0], x1[1]); pk[3] = pack2(x1[2], x1[3]); bf16x8 xf; __builtin_memcpy(&xf, &pk, 16);
        y = __builtin_amdgcn_mfma_f32_16x16x32_bf16(cf[kk], xf, y, 0, 0, 0); }
      const int t = n * 64 + slab * 16 + fr;
      const f32x4 u4 = *(const f32x4*)(US + (w * 64 + slab * 16 + fr) * 16 + fq * 4), d4 = *(const f32x4*)(p.s5_d + ((size_t)j * S5_G + g) * 16 + fq * 4);
      y += d4 * u4;
      *(u32x2*)(YS + (size_t)t * S5_CH + g * 16 + fq * 4) = (u32x2){pack2(geluf_(y[0]), geluf_(y[1])), pack2(geluf_(y[2]), geluf_(y[3]))};
      __syncthreads();
    }
  }
  if (!OUT) XEND[(size_t)(n * S5_G + g) * S5_P + lane] = (f32x2){xr, xi};
}

__device__ __forceinline__ void s5_carry(const Params& p, int j, int bid, int nb) {
  const float* C = (const float*)(p.ws + OFF_S5C + j * SZ_S5C1); const f32x2* __restrict__ XEND = (const f32x2*)(p.ws + OFF_XEND); f32x2* __restrict__ CARRY = (f32x2*)(p.ws + OFF_CARRY);
  for (int e = bid * 512 + tid_(); e < S5_G * S5_P; e += nb * 512) {
    const float a64r = C[2 * S5_G * S5_P + e], a64i = C[3 * S5_G * S5_P + e]; float xr = 0.f, xi = 0.f;
#pragma unroll 1
    for (int n0 = 0; n0 < NCH; n0 += 16) { f32x2 xe[16];
#pragma unroll
      for (int k = 0; k < 16; ++k) xe[k] = XEND[(size_t)(n0 + k) * S5_G * S5_P + e];
#pragma unroll
      for (int k = 0; k < 16; ++k) { CARRY[(size_t)(n0 + k) * S5_G * S5_P + e] = (f32x2){xr, xi}; const float nr = a64r * xr - a64i * xi + xe[k][0], ni = a64r * xi + a64i * xr + xe[k][1]; xr = nr; xi = ni; } }
  }
}

__device__ __forceinline__ void glr_pass(const bf16_t* XB, const bf16_t* Wg, float* H32, int bid, int nb) {
  const int w = tid_() >> 6, lane = tid_() & 63, fr = lane & 15, fq = lane >> 4;
  for (int tile = bid * 8 + w; tile < SEQ / 16; tile += nb * 8) {
    const bf16_t* ap = XB + (size_t)(tile * 16 + fr) * DM + fq * 8; const bf16_t* bp = Wg + (size_t)fr * DM + fq * 8;
    f32x4 acc = f4zero();
#pragma unroll 8
    for (int kk = 0; kk < DM / 32; ++kk) { const bf16x8 a = *(const bf16x8*)(ap + kk * 32), b = *(const bf16x8*)(bp + kk * 32); acc = __builtin_amdgcn_mfma_f32_16x16x32_bf16(a, b, acc, 0, 0, 0); }
#pragma unroll
    for (int jj = 0; jj < 4; ++jj) H32[(size_t)(tile * 16 + fq * 4 + jj) * EV_LD + EV_GLR + fr] = acc[jj];
  }
}

#ifndef EMU
__device__ __forceinline__ void subgrid_barrier(unsigned* cnt, unsigned count, unsigned* tmo) {
  asm volatile("s_waitcnt vmcnt(0)" ::: "memory");
  __syncthreads();
  if (threadIdx.x == 0) {
    __builtin_amdgcn_fence(__ATOMIC_RELEASE, "agent");
    asm volatile("s_waitcnt vmcnt(0)" ::: "memory");
    __hip_atomic_fetch_add(cnt, 1u, __ATOMIC_RELAXED, __HIP_MEMORY_SCOPE_AGENT);
    unsigned sp = 0;
    while (__hip_atomic_load(cnt, __ATOMIC_RELAXED, __HIP_MEMORY_SCOPE_AGENT) < count) { __builtin_amdgcn_s_sleep(1);
      if ((++sp & 255u) == 0u) { if (__hip_atomic_load(tmo, __ATOMIC_RELAXED, __HIP_MEMORY_SCOPE_AGENT)) break; if (sp > (1u << 18)) { atomicAdd(tmo, 1u); break; } } }
    __builtin_amdgcn_fence(__ATOMIC_ACQUIRE, "agent");
    asm volatile("s_waitcnt vmcnt(0)" ::: "memory");
  }
  __syncthreads();
}
#else
__device__ __forceinline__ void subgrid_barrier(unsigned*, unsigned, unsigned*) {}
#endif

#ifdef EMU
#define SUBGRID_GLU()
#else
#define SUBGRID_GLU() do { subgrid_barrier((unsigned*)(ws + OFF_BAR) + 3600 + 64 * L, (unsigned)(nb - NSCAN), (unsigned*)(ws + OFF_BAR) + 128); \
    EpiGlu E{(const bf16_t*)(ws + OFF_YS), p.s5_glu_b + (size_t)j * S5_CH, CAT}; run_gemm(smem, (const bf16_t*)(ws + OFF_YS), (const bf16_t*)(ws + OFF_WGLU + j * SZ_WGLU), S5_CH, S5_CH, E, bid - NSCAN, nb - NSCAN); } while (0)
#endif
__device__ __forceinline__ bool run_step(const Params& p, int step, char* smem, int bid, int nb) {
  LAUNDER_S(bid); LAUNDER_S(nb);
  char* ws = p.ws;
  if (step == 0) { step_prep(p, smem, bid, nb); return true; }
  const int L = (step - 1) / STEPS_PER_LAYER, s = (step - 1) % STEPS_PER_LAYER, j = L >> 1; const bool even = (L & 1) == 0;
  bf16_t* XB = (bf16_t*)(ws + OFF_XB); float* X32 = (float*)(ws + OFF_X32); float* Y32 = (float*)(ws + OFF_Y32); float* H32 = (float*)(ws + OFF_H32); bf16_t* CAT = (bf16_t*)(ws + OFF_CAT);
  float* stats_mix = (float*)(ws + OFF_STATS) + (size_t)(L * 2) * SEQ * 2; float* stats_ffn = stats_mix + (size_t)SEQ * 2;
  switch (s) {
    case 0:
      if (even) { EpiEvenIn E{H32, (bf16_t*)(ws + OFF_MQ), (bf16_t*)(ws + OFF_MK), (bf16_t*)(ws + OFF_MVT)}; run_gemm(smem, XB, (const bf16_t*)(ws + OFF_WINE + j * SZ_WINE), EVEN_NMAIN, DM, E, bid, nb);
        glr_pass(XB, (const bf16_t*)(ws + OFF_WINE + j * SZ_WINE) + (size_t)EVEN_NMAIN * DM, H32, bid, nb); }
      else { EpiOddIn E{H32}; run_gemm(smem, XB, (const bf16_t*)(ws + OFF_WINO + j * SZ_WINO), ODD_NP, DM, E, bid, nb); }
      return true;
    case 1:
      if (even) {
        for (int it = bid; it < GLA_H * NCH; it += nb) gla_kv_item(p, j, it % GLA_H, it / GLA_H, smem);
        for (int it = bid; it < MOBA_H * NBLK; it += nb) moba_kmean_item(p, it % MOBA_H, it / MOBA_H, smem);
        if (bid == 0 && tid_() < MOBA_H * NBLK) ((unsigned*)(ws + OFF_MCNT))[tid_()] = 0u;
      } else {
        for (int it = bid; it < GDN_H * NCH; it += nb) gdn_local_item(p, j, it % GDN_H, it / GDN_H, smem);
        for (int it = bid; it < S5_G * (NCH / 8); it += nb) { s5_item<false>(p, j, it % S5_G, it / S5_G, smem); __syncthreads(); }
      }
      return true;
    case 2:
      if (even) {
        gla_scan(p, bid, nb);
        for (int it = nb - 1 - bid; it < MOBA_H * NCH; it += nb) moba_tile<false>(p, it % MOBA_H, NCH - 1 - it / MOBA_H, 0, 0, smem);
      } else {
        constexpr int NSCAN = GDN_H * 4;
        if (nb > 2 * NSCAN) {
          if (bid < NSCAN) gdn_scan_item(p, bid % GDN_H, bid / GDN_H, smem);
          else { for (int it = bid - NSCAN; it < S5_G * (NCH / 8); it += nb - NSCAN) { s5_item<true>(p, j, it % S5_G, it / S5_G, smem); __syncthreads(); }
            SUBGRID_GLU();
            conv_group(p, L, smem, bid - NSCAN, nb - NSCAN); }
        } else {
          for (int it = bid; it < NSCAN; it += nb) gdn_scan_item(p, it % GDN_H, it / GDN_H, smem);
          for (int it = bid; it < S5_G * (NCH / 8); it += nb) { s5_item<true>(p, j, it % S5_G, it / S5_G, smem); __syncthreads(); }
          conv_group(p, L, smem, bid, nb);
        }
      }
      return true;
    case 3:
      if (even) { for (int it = bid; it < GLA_H * NCH; it += nb) gla_out_item(p, j, it % GLA_H, it / GLA_H, smem); moba_gathered(p, smem, bid, nb); }
      else {
        gdn_final(p, j, bid, nb);
      }
      return true;
    case 4:
      if (even) { moba_combine(p, bid, nb); return true; }
      if (GLU_IN_WINDOW && nb > 2 * GDN_H * 4) return false;
      { EpiGlu E{(const bf16_t*)(ws + OFF_YS), p.s5_glu_b + (size_t)j * S5_CH, CAT}; run_gemm(smem, (const bf16_t*)(ws + OFF_YS), (const bf16_t*)(ws + OFF_WGLU + j * SZ_WGLU), S5_CH, S5_CH, E, bid, nb); }
      return true;
    case 5: {
      const float* pst = stats_mix - (size_t)SEQ * 2;
      EpiRes E{L == 0 ? p.x : nullptr, pst, p.ln_ffn_g + (size_t)(L > 0 ? L - 1 : 0) * DM, p.ln_ffn_b + (size_t)(L > 0 ? L - 1 : 0) * DM, Y32, stats_mix};
      if (even) run_gemm(smem, CAT, (const bf16_t*)(ws + OFF_WOUTE + j * SZ_WOUTE), DM, EVEN_OUT, E, bid, nb);
      else run_gemm(smem, CAT, (const bf16_t*)(ws + OFF_WOUTO + j * SZ_WOUTO), DM, ODD_OUT, E, bid, nb);
      return true; }
    case 6: step_ln(Y32, stats_mix, p.ln_mix_g + (size_t)L * DM, p.ln_mix_b + (size_t)L * DM, nullptr, XB, bid, nb); return true;
    case 7: { EpiBf16 E{(bf16_t*)(ws + OFF_H16), 2 * DFF}; run_gemm(smem, XB, (const bf16_t*)(ws + OFF_WUP + L * SZ_WUP), 2 * DFF, DM, E, bid, nb); return true; }
    case 8: step_ffn_conv((const bf16_t*)(ws + OFF_H16), p.ffn_conv_w + (size_t)L * 3 * 2 * DFF, (bf16_t*)(ws + OFF_G16), bid, nb); return true;
    case 9: { EpiRes E{nullptr, stats_mix, p.ln_mix_g + (size_t)L * DM, p.ln_mix_b + (size_t)L * DM, Y32, stats_ffn}; run_gemm(smem, (const bf16_t*)(ws + OFF_G16), (const bf16_t*)(ws + OFF_WDN + L * SZ_WDN), DM, DFF, E, bid, nb); return true; }
    case 10: step_ln(Y32, stats_ffn, p.ln_ffn_g + (size_t)L * DM, p.ln_ffn_b + (size_t)L * DM, (L == DEPTH - 1) ? p.out : nullptr, XB, bid, nb); return true;
  }
  return false;
}

#ifndef EMU
#define XB_TMO      128
#define XB_XCNT(j)  (256  + 64 * (j))
#define XB_XSUB(j)  (1280 + 64 * (j))
#define XB_XGEN(j)  (2304 + 64 * (j))
#define XB_TOP      3328
#define XB_TOPGEN   3392
#define XCD_BAR_WORDS 3456
#define XB_SPIN_CAP (1u << 18)
#define LAS __attribute__((address_space(3)))
__device__ __forceinline__ unsigned xb_ld(unsigned* p)              { return __hip_atomic_load(p, __ATOMIC_RELAXED, __HIP_MEMORY_SCOPE_AGENT); }
__device__ __forceinline__ unsigned xb_add(unsigned* p, unsigned v) { return __hip_atomic_fetch_add(p, v, __ATOMIC_RELAXED, __HIP_MEMORY_SCOPE_AGENT); }
__device__ __forceinline__ unsigned xb_xcc_id() { return (unsigned)__builtin_amdgcn_s_getreg((3 << 11) | 20) & 0xFu; }
#define XB_SPIN(cond, bar) do { unsigned _sp = 0; while (cond) { __builtin_amdgcn_s_sleep(1); \
    if ((++_sp & 255u) == 0u) { if (xb_ld(&(bar)[XB_TMO])) break; if (_sp > XB_SPIN_CAP) { atomicAdd(&(bar)[XB_TMO], 1u); break; } } } } while (0)
__device__ __forceinline__ void xcd_barrier_complete(unsigned* bar, unsigned x, unsigned& nloc, unsigned& nx) {
  const unsigned G = gridDim.x;
  unsigned sum, cnt, mine, sp = 0u;
  for (;;) {
    sum = 0u; cnt = 0u; mine = 0u;
#pragma unroll
    for (unsigned j = 0; j < 16; ++j) { const unsigned c = xb_ld(&bar[XB_XCNT(j)]); sum += c; cnt += (c > 0u) ? 1u : 0u; mine = (j == x) ? c : mine; }
    if (sum == G) break;
    __builtin_amdgcn_s_sleep(1);
    if ((++sp & 255u) == 0u) { if (xb_ld(&bar[XB_TMO])) break; if (sp > XB_SPIN_CAP) { atomicAdd(&bar[XB_TMO], 1u); break; } }
  }
  nloc = mine > 0u ? mine : 1u; nx = cnt > 0u ? cnt : 1u;
}
__device__ __forceinline__ void xcd_barrier(unsigned* bar, volatile LAS unsigned* st) {
  asm volatile("s_waitcnt vmcnt(0)" ::: "memory");
  __syncthreads();
  if (threadIdx.x == 0) {
    const unsigned x = xb_xcc_id();
    __builtin_amdgcn_s_waitcnt(0);
    unsigned nloc = st[0], nx = st[1];
    if (nloc == 0u) { xcd_barrier_complete(bar, x, nloc, nx); st[0] = nloc; st[1] = nx; }
    const unsigned old = xb_add(&bar[XB_XSUB(x)], 1u);
    const unsigned gen = old / nloc;
    if (old + 1u == (gen + 1u) * nloc) {
      __builtin_amdgcn_fence(__ATOMIC_RELEASE, "agent");
      asm volatile("s_waitcnt vmcnt(0)" ::: "memory");
      const unsigned og = xb_add(&bar[XB_TOP], 1u);
      const unsigned tg = og / nx;
      if (og + 1u == (tg + 1u) * nx) xb_add(&bar[XB_TOPGEN], 1u);
      else XB_SPIN(xb_ld(&bar[XB_TOPGEN]) == tg, bar);
      __builtin_amdgcn_fence(__ATOMIC_ACQUIRE, "agent");
      xb_add(&bar[XB_XGEN(x)], 1u);
      asm volatile("s_waitcnt vmcnt(0)" ::: "memory");
    } else {
      XB_SPIN(xb_ld(&bar[XB_XGEN(x)]) == gen, bar);
      __builtin_amdgcn_fence(__ATOMIC_ACQUIRE, "agent");
      asm volatile("s_waitcnt vmcnt(0)" ::: "memory");
    }
  }
  __syncthreads();
}

typedef __attribute__((address_space(4))) const Params* KParamsPtr;
__global__ void __launch_bounds__(512, 2) hybrid_megakernel(Params p_unused) {
  extern __shared__ __attribute__((aligned(16))) char smem[];
  __shared__ uint4 xb_words;
  cg::grid_group grid = cg::this_grid();
  const int bid = blockIdx.x, nb = gridDim.x;
  KParamsPtr q0 = (KParamsPtr)__builtin_amdgcn_kernarg_segment_ptr();
  const int sb = q0->step_begin, se = q0->step_end;
  if (threadIdx.x == 0) { xb_words = make_uint4(0u, 0u, 0u, 0u); (void)xb_add(&((unsigned*)(q0->ws + OFF_BAR))[XB_XCNT(xb_xcc_id())], 1u); }
  __syncthreads();
#ifdef PROBE_MASK
  __shared__ unsigned long long tacc_s[2];
  if (threadIdx.x == 0) tacc_s[0] = 0;
#endif
  for (int s = sb; s < se; ++s) {
    KParamsPtr q = q0; asm volatile("" : "+s"(q));
    Params lp; __builtin_memcpy(&lp, q, sizeof(Params));
#ifdef PROBE_MASK
    const unsigned long long t0 = wall_clock64();
#endif
    const bool did = run_step(lp, s, smem, bid, nb);
#ifdef PROBE_MASK
    const bool more = true;
#else
    const bool more = s + 1 < se;
#endif
    if (did && more) {
      if (se < 0) grid.sync();
      xcd_barrier((unsigned*)(q0->ws + OFF_BAR), (volatile LAS unsigned*)&xb_words);
    }
#ifdef PROBE_MASK
    { const unsigned long long t1 = wall_clock64(); const int bit = (s == 0) ? 22 : (((s - 1) / STEPS_PER_LAYER) & 1) * 11 + (s - 1) % STEPS_PER_LAYER;
      if (((PROBE_MASK >> bit) & 1u) && threadIdx.x == 0) tacc_s[0] += t1 - t0; }
#endif
  }
#ifdef PROBE_MASK
  __syncthreads();
  if (bid == 0) { const unsigned n = (unsigned)(tacc_s[0] / 20); float* out = q0->out;
    for (unsigned i = threadIdx.x; i < n; i += 512) out[((size_t)i * 271) % ((size_t)SEQ * DM)] += 0.1f; }
#endif
}

extern "C" void kernel_launch(void* const* d_in, const int* in_sizes, int n_in, void* d_out, int out_size, void* d_ws, size_t ws_size, hipStream_t stream) {
  static int grid_blocks = 0;
  if (!grid_blocks) {
    int dev = 0, cus = 0, per_cu = 0;
    hipGetDevice(&dev);
    hipDeviceGetAttribute(&cus, hipDeviceAttributeMultiprocessorCount, dev);
    hipFuncSetAttribute((const void*)hybrid_megakernel, hipFuncAttributeMaxDynamicSharedMemorySize, LDS_BYTES);
    hipOccupancyMaxActiveBlocksPerMultiprocessor(&per_cu, hybrid_megakernel, 512, LDS_BYTES);
    if (per_cu < 1) per_cu = 1;
    if (per_cu > 1) per_cu = 1;
    grid_blocks = cus * per_cu;
  }
  if (ws_size < WS_NEEDED) { fprintf(stderr, "workspace too small: %zu < %zu\n", ws_size, (size_t)WS_NEEDED); return; }
  Params p{};
  const float** pp = (const float**)&p;
  for (int i = 0; i < 29; ++i) pp[i] = (const float*)d_in[i];
  p.out = (float*)d_out; p.ws = (char*)d_ws; p.step_begin = 0; p.step_end = N_STEPS;
  hipMemsetAsync((char*)d_ws + OFF_BAR, 0, SZ_BAR, stream);
  void* args[] = {&p};
  hipError_t e = hipLaunchCooperativeKernel((const void*)hybrid_megakernel, dim3(grid_blocks), dim3(512), args, LDS_BYTES, stream);
  if (e != hipSuccess) fprintf(stderr, "cooperative launch failed: %s (grid %d)\n", hipGetErrorString(e), grid_blocks);
}
#endif
```
